# Optimizing an MI355X kernel written in HIP

```python
import math
import jax
import jax.numpy as jnp
from jax import lax
import numpy as np

D_MODEL = 2048
BATCH = 4
SEQ = 2048
DEPTH = 2

GRID_W = 64
CTX_LEN = 256
D_MIX = D_MODEL
N_MIXERS = 4
GROUP_W = D_MIX // N_MIXERS
ROPE_DIM = 64
ROPE_THETA = 10000.0
NORM_EPS = 1e-6
QUERY_BLOCK = 128

POOL_WINDOWS = (2, 4, 8, 16)
POOL_GROUP = GROUP_W // len(POOL_WINDOWS)

DIFF_HEADS = 4
DIFF_HD = ROPE_DIM
DIFF_VD = 2 * DIFF_HD
DIFF_QK_COLS = DIFF_HEADS * 2 * DIFF_HD
DIFF_COLS = 2 * DIFF_QK_COLS + DIFF_HEADS * DIFF_VD

MLA_HEADS = 4
MLA_NOPE = 128
MLA_VD = GROUP_W // MLA_HEADS
MLA_Q_LORA = 384
MLA_KV_LORA = 256
MLA_COLS = MLA_Q_LORA + MLA_KV_LORA + ROPE_DIM

CONV_CH = GROUP_W
CONV_K = 3
CONV_COLS = 3 * CONV_CH

D_FF = 5632
FFN_CONV_K = 3

IN_COLS = GROUP_W + DIFF_COLS + MLA_COLS + CONV_COLS
IN_SPLITS = (GROUP_W, GROUP_W + DIFF_COLS, GROUP_W + DIFF_COLS + MLA_COLS)

kernel_name = "hybrid_pool_diffattn_mla_shortconv_dit"


def rmsnorm(x, g):
    xf = x.astype(jnp.float32)
    y = xf * lax.rsqrt(jnp.mean(xf * xf, axis=-1, keepdims=True) + NORM_EPS)
    return (y * g.astype(jnp.float32)).astype(x.dtype)


def modulate(h, shift, scale):
    return h * (1.0 + scale) + shift


def axial_rope_tables(n_tokens, rot_dim):
    rows = n_tokens // GRID_W
    row = jnp.repeat(jnp.arange(rows), GRID_W).astype(jnp.float32)
    col = jnp.tile(jnp.arange(GRID_W), rows).astype(jnp.float32)
    n_freq = rot_dim // 4
    inv = ROPE_THETA ** (-jnp.arange(n_freq, dtype=jnp.float32) / n_freq)
    ang = jnp.concatenate([row[:, None] * inv, col[:, None] * inv], axis=-1)
    return jnp.cos(ang), jnp.sin(ang)


def apply_rope(x, cos, sin):
    half = x.shape[-1] // 2
    xf = x.astype(jnp.float32)
    x1, x2 = xf[..., :half], xf[..., half:]
    c, s = cos[None, :, None, :], sin[None, :, None, :]
    return jnp.concatenate([x1 * c - x2 * s, x1 * s + x2 * c], axis=-1).astype(x.dtype)


def dwconv_centred(u, w):
    k_w = w.shape[0]
    pad = k_w // 2
    n = u.shape[1]
    up = jnp.pad(u, ((0, 0), (pad, pad), (0, 0)))
    return sum(up[:, k:k + n] * w[k] for k in range(k_w))


def centred_mean_minus_self(u, window):
    n = u.shape[1]
    half = window // 2
    t = jnp.arange(n)
    lo = jnp.clip(t - half, 0, n)
    hi = jnp.clip(t + half, 0, n)
    uf = u.astype(jnp.float32)
    cs = jnp.concatenate([jnp.zeros_like(uf[:, :1]), jnp.cumsum(uf, axis=1)], axis=1)
    cnt = (hi - lo).astype(jnp.float32)[None, :, None]
    mean = (jnp.take(cs, hi, axis=1) - jnp.take(cs, lo, axis=1)) / cnt
    return (mean - uf).astype(u.dtype)


def pool_mixer(u, pool_w, pool_scale):
    b, n, _ = u.shape
    ug = u.reshape(b, n, len(POOL_WINDOWS), POOL_GROUP)
    pooled = jnp.stack([centred_mean_minus_self(ug[:, :, g], w) for g, w in enumerate(POOL_WINDOWS)], axis=2)
    y = jnp.einsum("blgc,gcd->blgd", pooled, pool_w).reshape(b, n, GROUP_W)
    return y * pool_scale


def gated_short_conv(u, conv_w):
    gate_b, gate_c, h = jnp.split(u, 3, axis=-1)
    return gate_b * dwconv_centred(gate_c * h, conv_w)


def attend(q, k, v, scale):
    s = jnp.einsum("bqhd,bkhd->bhqk", q, k).astype(jnp.float32) * scale
    p = jax.nn.softmax(s, axis=-1)
    return jnp.einsum("bhqk,bkhd->bqhd", p.astype(v.dtype), v)


def diff_attend(q1, q2, k1, k2, v, lam, scale):
    s1 = jnp.einsum("bqhd,bkhd->bhqk", q1, k1).astype(jnp.float32) * scale
    s2 = jnp.einsum("bqhd,bkhd->bhqk", q2, k2).astype(jnp.float32) * scale
    a = jax.nn.softmax(s1, axis=-1) - lam * jax.nn.softmax(s2, axis=-1)
    return jnp.einsum("bhqk,bkhd->bqhd", a.astype(v.dtype), v)


def sweep_query_blocks(fn, qs):
    b, n = qs[0].shape[:2]
    nb = n // QUERY_BLOCK
    blocks = tuple(q.reshape(b, nb, QUERY_BLOCK, *q.shape[2:]).swapaxes(0, 1) for q in qs)
    out = lax.map(lambda qb: fn(*qb), blocks)
    out = out.swapaxes(0, 1)
    return out.reshape(b, n, *out.shape[3:])


def diff_lambda_init(layer_idx):
    return 0.8 - 0.6 * math.exp(-0.3 * layer_idx)


def diff_attention_mixer(z_x, z_c, lam_params, subln_g, lam_init, cos, sin, last):
    lq1, lk1, lq2, lk2 = (lam_params[j].astype(jnp.float32) for j in range(4))
    lam = jnp.exp(jnp.sum(lq1 * lk1)) - jnp.exp(jnp.sum(lq2 * lk2)) + lam_init
    scale = DIFF_HD ** -0.5

    def split_qkv(z):
        b, n, _ = z.shape
        q, k, v = jnp.split(z, [DIFF_QK_COLS, 2 * DIFF_QK_COLS], axis=-1)
        q = q.reshape(b, n, DIFF_HEADS, 2, DIFF_HD)
        k = k.reshape(b, n, DIFF_HEADS, 2, DIFF_HD)
        return q[..., 0, :], q[..., 1, :], k[..., 0, :], k[..., 1, :], v.reshape(b, n, DIFF_HEADS, DIFF_VD)

    def post(o):
        b, n = o.shape[:2]
        return (rmsnorm(o, subln_g) * (1.0 - lam_init)).reshape(b, n, GROUP_W)

    q1x, q2x, k1x, k2x, vx = split_qkv(z_x)
    q1x, q2x, k1x, k2x = (apply_rope(t, cos, sin) for t in (q1x, q2x, k1x, k2x))
    q1c, q2c, k1c, k2c, vc = split_qkv(z_c)
    k1 = jnp.concatenate([k1x, k1c], axis=1)
    k2 = jnp.concatenate([k2x, k2c], axis=1)
    v = jnp.concatenate([vx, vc], axis=1)
    ox = sweep_query_blocks(lambda a, b_: diff_attend(a, b_, k1, k2, v, lam, scale), (q1x, q2x))
    oc = None if last else post(diff_attend(q1c, q2c, k1c, k2c, vc, lam, scale))
    return post(ox), oc


def mla_mixer(z_x, z_c, gq, w_uq, gkv, w_ukv, cos, sin, last):
    def project(z, rotate):
        b, n, _ = z.shape
        c_q, c_kv, k_rope = jnp.split(z, [MLA_Q_LORA, MLA_Q_LORA + MLA_KV_LORA], axis=-1)
        q = (rmsnorm(c_q, gq) @ w_uq).reshape(b, n, MLA_HEADS, MLA_NOPE + ROPE_DIM)
        kv = (rmsnorm(c_kv, gkv) @ w_ukv).reshape(b, n, MLA_HEADS, MLA_NOPE + MLA_VD)
        q_nope, q_rope = q[..., :MLA_NOPE], q[..., MLA_NOPE:]
        k_rope = k_rope[:, :, None, :]
        if rotate:
            q_rope = apply_rope(q_rope, cos, sin)
            k_rope = apply_rope(k_rope, cos, sin)
        q = jnp.concatenate([q_nope, q_rope], axis=-1)
        k = jnp.concatenate([kv[..., :MLA_NOPE], jnp.broadcast_to(k_rope, (b, n, MLA_HEADS, ROPE_DIM))], axis=-1)
        return q, k, kv[..., MLA_NOPE:]

    def merge(o):
        return o.reshape(o.shape[0], o.shape[1], GROUP_W)

    scale = (MLA_NOPE + ROPE_DIM) ** -0.5
    qx, kx, vx = project(z_x, True)
    qc, kc, vc = project(z_c, False)
    k = jnp.concatenate([kx, kc], axis=1)
    v = jnp.concatenate([vx, vc], axis=1)
    ox = sweep_query_blocks(lambda qb: attend(qb, k, v, scale), (qx,))
    oc = None if last else merge(attend(qc, kc, vc, scale))
    return merge(ox), oc


def conv_ffn(h, w_up, conv_w, w_down):
    u = dwconv_centred(h @ w_up, conv_w)
    gate, val = jnp.split(u, 2, axis=-1)
    return (jax.nn.silu(gate) * val) @ w_down


def trunk_layer(x, ctx, c, c_ctx, p, layer_idx, cos, sin, last):
    mod_x = (jax.nn.silu(c) @ p["ada_w"] + p["ada_b"])[:, None, :]
    mod_c = (jax.nn.silu(c_ctx) @ p["ada_w"] + p["ada_b"])[None, None, :]
    sh1x, sc1x, g1x, sh2x, sc2x, g2x = jnp.split(mod_x, 6, axis=-1)
    sh1c, sc1c, g1c, sh2c, sc2c, g2c = jnp.split(mod_c, 6, axis=-1)

    zx = modulate(rmsnorm(x, p["g_pre_mix"]), sh1x, sc1x) @ p["w_in"]
    zc = modulate(rmsnorm(ctx, p["g_pre_mix"]), sh1c, sc1c) @ p["w_in"]
    za_x, zb_x, zm_x, zd_x = jnp.split(zx, IN_SPLITS, axis=-1)
    za_c, zb_c, zm_c, zd_c = jnp.split(zc, IN_SPLITS, axis=-1)
    yb_x, yb_c = diff_attention_mixer(zb_x, zb_c, p["diff_lambda"], p["diff_subln_g"],
                                      diff_lambda_init(layer_idx), cos, sin, last)
    ym_x, ym_c = mla_mixer(zm_x, zm_c, p["mla_gq"], p["mla_w_uq"], p["mla_gkv"], p["mla_w_ukv"],
                           cos, sin, last)
    mix_x = jnp.concatenate([pool_mixer(za_x, p["pool_w"], p["pool_scale"]), yb_x, ym_x,
                             gated_short_conv(zd_x, p["conv_w"])], axis=-1)
    x = x + g1x * rmsnorm(mix_x @ p["w_out"], p["g_post_mix"])
    hx = modulate(rmsnorm(x, p["g_pre_ffn"]), sh2x, sc2x)
    x = x + g2x * rmsnorm(conv_ffn(hx, p["ffn_w_up"], p["ffn_conv_w"], p["ffn_w_down"]), p["g_post_ffn"])
    if last:
        return x, None
    mix_c = jnp.concatenate([pool_mixer(za_c, p["pool_w"], p["pool_scale"]), yb_c, ym_c,
                             gated_short_conv(zd_c, p["conv_w"])], axis=-1)
    ctx = ctx + g1c * rmsnorm(mix_c @ p["w_out"], p["g_post_mix"])
    hc = modulate(rmsnorm(ctx, p["g_pre_ffn"]), sh2c, sc2c)
    ctx = ctx + g2c * rmsnorm(conv_ffn(hc, p["ffn_w_up"], p["ffn_conv_w"], p["ffn_w_down"]), p["g_post_ffn"])
    return x, ctx


def setup_inputs(seed: int = 0) -> dict:
    key = jax.random.key(seed)
    ks = jax.random.split(key, 26)
    f32 = jnp.float32

    def nrm(k, shape, s):
        return jax.random.normal(k, shape, f32) * s

    def gain(k, shape):
        return 1.0 + 0.1 * jax.random.normal(k, shape, f32)

    return {
        "x": nrm(ks[0], (BATCH, SEQ, D_MODEL), 1.0),
        "c": nrm(ks[1], (BATCH, D_MODEL), 1.0),
        "ctx": nrm(ks[2], (BATCH, CTX_LEN, D_MODEL), 1.0),
        "c_ctx": nrm(ks[3], (D_MODEL,), 1.0),
        "ada_w": nrm(ks[4], (DEPTH, D_MODEL, 6 * D_MODEL), 0.5 * D_MODEL ** -0.5),
        "ada_b": nrm(ks[5], (DEPTH, 6 * D_MODEL), 0.05),
        "g_pre_mix": gain(ks[6], (DEPTH, D_MODEL)),
        "g_post_mix": gain(ks[7], (DEPTH, D_MODEL)),
        "g_pre_ffn": gain(ks[8], (DEPTH, D_MODEL)),
        "g_post_ffn": gain(ks[9], (DEPTH, D_MODEL)),
        "w_in": nrm(ks[10], (DEPTH, D_MODEL, IN_COLS), D_MODEL ** -0.5),
        "pool_w": nrm(ks[11], (DEPTH, len(POOL_WINDOWS), POOL_GROUP, POOL_GROUP), POOL_GROUP ** -0.5),
        "pool_scale": gain(ks[12], (DEPTH, GROUP_W)),
        "diff_lambda": nrm(ks[13], (DEPTH, 4, DIFF_HD), 0.1),
        "diff_subln_g": gain(ks[14], (DEPTH, DIFF_VD)),
        "mla_gq": gain(ks[15], (DEPTH, MLA_Q_LORA)),
        "mla_w_uq": nrm(ks[16], (DEPTH, MLA_Q_LORA, MLA_HEADS * (MLA_NOPE + ROPE_DIM)), MLA_Q_LORA ** -0.5),
        "mla_gkv": gain(ks[17], (DEPTH, MLA_KV_LORA)),
        "mla_w_ukv": nrm(ks[18], (DEPTH, MLA_KV_LORA, MLA_HEADS * (MLA_NOPE + MLA_VD)), MLA_KV_LORA ** -0.5),
        "conv_w": nrm(ks[19], (DEPTH, CONV_K, CONV_CH), CONV_K ** -0.5),
        "w_out": nrm(ks[20], (DEPTH, D_MIX, D_MODEL), D_MIX ** -0.5),
        "ffn_w_up": nrm(ks[21], (DEPTH, D_MODEL, 2 * D_FF), D_MODEL ** -0.5),
        "ffn_conv_w": nrm(ks[22], (DEPTH, FFN_CONV_K, 2 * D_FF), FFN_CONV_K ** -0.5),
        "ffn_w_down": nrm(ks[23], (DEPTH, D_FF, D_MODEL), D_FF ** -0.5),
    }


def reference(x, c, ctx, c_ctx, ada_w, ada_b, g_pre_mix, g_post_mix, g_pre_ffn, g_post_ffn, w_in,
              pool_w, pool_scale, diff_lambda, diff_subln_g, mla_gq, mla_w_uq, mla_gkv, mla_w_ukv,
              conv_w, w_out, ffn_w_up, ffn_conv_w, ffn_w_down):
    cos, sin = axial_rope_tables(x.shape[1], ROPE_DIM)
    for i in range(DEPTH):
        params = {
            "ada_w": ada_w[i], "ada_b": ada_b[i],
            "g_pre_mix": g_pre_mix[i], "g_post_mix": g_post_mix[i],
            "g_pre_ffn": g_pre_ffn[i], "g_post_ffn": g_post_ffn[i],
            "w_in": w_in[i], "pool_w": pool_w[i], "pool_scale": pool_scale[i],
            "diff_lambda": diff_lambda[i], "diff_subln_g": diff_subln_g[i],
            "mla_gq": mla_gq[i], "mla_w_uq": mla_w_uq[i], "mla_gkv": mla_gkv[i], "mla_w_ukv": mla_w_ukv[i],
            "conv_w": conv_w[i], "w_out": w_out[i],
            "ffn_w_up": ffn_w_up[i], "ffn_conv_w": ffn_conv_w[i], "ffn_w_down": ffn_w_down[i],
        }
        x, ctx = trunk_layer(x, ctx, c, c_ctx, params, i, cos, sin, i == DEPTH - 1)
    return x
```

```cpp
#include <hip/hip_runtime.h>
#include <cstdint>
#include <cstdio>
#include <cmath>

namespace nv {
constexpr int D = 2048, NB = 4, SEQ = 2048, CTX = 256, GRIDW = 64;
constexpr int RX = NB * SEQ, RC = NB * CTX, R = RX + RC;
constexpr int INC = 4288, DFF = 5632, MODW = 6 * D;
constexpr float EPS = 1e-6f;
constexpr int Z_POOL = 0, Z_Q = 512, Z_K = 1024, Z_V = 1536, Z_CQ = 2048, Z_CKV = 2432, Z_KR = 2688, Z_GB = 2752, Z_GC = 3264, Z_H = 3776;

__device__ __forceinline__ void rowinfo(int r, int& b, int& t, int& L, int& isc) {
    if (r < RX) { b = r / SEQ; t = r % SEQ; L = SEQ; isc = 0; } else { const int rc = r - RX; b = rc / CTX; t = rc % CTX; L = CTX; isc = 1; }
}
__device__ __forceinline__ float wave_sum(float v) {
#pragma unroll
    for (int o = 1; o < 64; o <<= 1) v += __shfl_xor(v, o);
    return v;
}
__device__ __forceinline__ float wave_max(float v) {
#pragma unroll
    for (int o = 1; o < 64; o <<= 1) v = fmaxf(v, __shfl_xor(v, o));
    return v;
}

__global__ __launch_bounds__(256) void k_mod(const float* __restrict__ c, const float* __restrict__ c_ctx, const float* __restrict__ ada_w, const float* __restrict__ ada_b, float* __restrict__ mod) {
    __shared__ float s[5][128];
    const int kc = blockIdx.y, k0 = kc * 128;
    for (int i = threadIdx.x; i < 5 * 128; i += 256) { const int row = i / 128, k = i % 128; const float v = row < 4 ? c[row * D + k0 + k] : c_ctx[k0 + k]; s[row][k] = v / (1.f + expf(-v)); }
    __syncthreads();
    const int gn = blockIdx.x * 256 + threadIdx.x;
    const int l = gn / MODW, n = gn % MODW;
    float acc[5];
#pragma unroll
    for (int i = 0; i < 5; ++i) acc[i] = (kc == 0) ? ada_b[l * MODW + n] : 0.f;
    const float* w = ada_w + ((size_t)l * D + k0) * MODW + n;
#pragma unroll 8
    for (int k = 0; k < 128; ++k) { const float wv = w[(size_t)k * MODW];
#pragma unroll
        for (int i = 0; i < 5; ++i) acc[i] += s[i][k] * wv; }
#pragma unroll
    for (int i = 0; i < 5; ++i) atomicAdd(&mod[((size_t)l * 5 + i) * MODW + n], acc[i]);
}

__global__ void k_rope_table(float2* __restrict__ cs) {
    const int idx = blockIdx.x * blockDim.x + threadIdx.x; if (idx >= SEQ * 32) return;
    const int t = idx / 32, i = idx % 32;
    const int f = i & 15; const double inv = pow(10000.0, -(double)f / 16.0);
    const double pos = (i < 16) ? (double)(t / GRIDW) : (double)(t % GRIDW);
    const double ang = pos * inv;
    cs[idx] = make_float2((float)cos(ang), (float)sin(ang));
}

__global__ __launch_bounds__(256) void k_rowpass(float* __restrict__ xr, const float* __restrict__ y, const float* __restrict__ ygain, const float* __restrict__ modl, int gate_off,
                                                 const float* __restrict__ ngain, int shift_off, int scale_off, float* __restrict__ hout, int nrows) {
    const int r = blockIdx.x * 4 + (threadIdx.x >> 6), lane = threadIdx.x & 63;
    if (r >= nrows) return;
    int b, t, L, isc; rowinfo(r, b, t, L, isc); const int mi = isc ? 4 : b;
    const float* mrow = modl + (size_t)mi * MODW;
    float xv[32];
    float* xp = xr + (size_t)r * D;
#pragma unroll
    for (int j = 0; j < 8; ++j) { const float4 v = *(const float4*)(xp + j * 256 + lane * 4); xv[4 * j] = v.x; xv[4 * j + 1] = v.y; xv[4 * j + 2] = v.z; xv[4 * j + 3] = v.w; }
    if (y) {
        float yv[32]; float ss = 0.f; const float* yp = y + (size_t)r * D;
#pragma unroll
        for (int j = 0; j < 8; ++j) { const float4 v = *(const float4*)(yp + j * 256 + lane * 4); yv[4 * j] = v.x; yv[4 * j + 1] = v.y; yv[4 * j + 2] = v.z; yv[4 * j + 3] = v.w; }
#pragma unroll
        for (int i = 0; i < 32; ++i) ss += yv[i] * yv[i];
        ss = wave_sum(ss); const float rs = 1.0f / sqrtf(ss / D + EPS);
#pragma unroll
        for (int j = 0; j < 8; ++j)
#pragma unroll
            for (int e = 0; e < 4; ++e) { const int col = j * 256 + lane * 4 + e; xv[4 * j + e] += mrow[gate_off + col] * (yv[4 * j + e] * rs * ygain[col]); }
#pragma unroll
        for (int j = 0; j < 8; ++j) *(float4*)(xp + j * 256 + lane * 4) = make_float4(xv[4 * j], xv[4 * j + 1], xv[4 * j + 2], xv[4 * j + 3]);
    }
    if (hout) {
        float ss = 0.f;
#pragma unroll
        for (int i = 0; i < 32; ++i) ss += xv[i] * xv[i];
        ss = wave_sum(ss); const float rs = 1.0f / sqrtf(ss / D + EPS);
        float* hp = hout + (size_t)r * D;
#pragma unroll
        for (int j = 0; j < 8; ++j) { float o[4];
#pragma unroll
            for (int e = 0; e < 4; ++e) { const int col = j * 256 + lane * 4 + e; o[e] = (xv[4 * j + e] * rs * ngain[col]) * (1.f + mrow[scale_off + col]) + mrow[shift_off + col]; }
            *(float4*)(hp + j * 256 + lane * 4) = make_float4(o[0], o[1], o[2], o[3]); }
    }
}

__global__ __launch_bounds__(256) void k_gemm(const float* __restrict__ A, int lda, const float* __restrict__ Bm, int ldb, float* __restrict__ C, int ldc, int M, int N, int K) {
    __shared__ float As[8][132]; __shared__ float Bs[8][132];
    const int tid = threadIdx.x, tx = tid & 15, ty = tid >> 4;
    const int m0 = blockIdx.y * 128, n0 = blockIdx.x * 128;
    float acc[8][8];
#pragma unroll
    for (int i = 0; i < 8; ++i)
#pragma unroll
        for (int j = 0; j < 8; ++j) acc[i][j] = 0.f;
    const int ar = tid >> 1, ak = (tid & 1) * 4;
    const int bk = tid >> 5, bc = (tid & 31) * 4;
    for (int k0 = 0; k0 < K; k0 += 8) {
        const float4 av = *(const float4*)(A + (size_t)(m0 + ar) * lda + k0 + ak);
        float4 bv = make_float4(0.f, 0.f, 0.f, 0.f);
        if (n0 + bc < N) bv = *(const float4*)(Bm + (size_t)(k0 + bk) * ldb + n0 + bc);
        __syncthreads();
        As[ak][ar] = av.x; As[ak + 1][ar] = av.y; As[ak + 2][ar] = av.z; As[ak + 3][ar] = av.w;
        *(float4*)&Bs[bk][bc] = bv;
        __syncthreads();
#pragma unroll
        for (int k = 0; k < 8; ++k) {
            float a[8], b[8];
            const float4 a0 = *(const float4*)&As[k][ty * 8], a1 = *(const float4*)&As[k][ty * 8 + 4];
            const float4 b0 = *(const float4*)&Bs[k][tx * 8], b1 = *(const float4*)&Bs[k][tx * 8 + 4];
            a[0] = a0.x; a[1] = a0.y; a[2] = a0.z; a[3] = a0.w; a[4] = a1.x; a[5] = a1.y; a[6] = a1.z; a[7] = a1.w;
            b[0] = b0.x; b[1] = b0.y; b[2] = b0.z; b[3] = b0.w; b[4] = b1.x; b[5] = b1.y; b[6] = b1.z; b[7] = b1.w;
#pragma unroll
            for (int i = 0; i < 8; ++i)
#pragma unroll
                for (int j = 0; j < 8; ++j) acc[i][j] += a[i] * b[j];
        }
    }
#pragma unroll
    for (int i = 0; i < 8; ++i) {
        float* cp = C + (size_t)(m0 + ty * 8 + i) * ldc + n0 + tx * 8;
        if (n0 + tx * 8 < N) *(float4*)cp = make_float4(acc[i][0], acc[i][1], acc[i][2], acc[i][3]);
        if (n0 + tx * 8 + 4 < N) *(float4*)(cp + 4) = make_float4(acc[i][4], acc[i][5], acc[i][6], acc[i][7]);
    }
}

__global__ void k_rope_z(float* __restrict__ Z, const float2* __restrict__ cs) {
    const int idx = blockIdx.x * blockDim.x + threadIdx.x; if (idx >= RX * 17 * 32) return;
    const int i = idx % 32, vec = (idx / 32) % 17, r = idx / (32 * 17);
    const int t = r % SEQ;
    const int col = vec < 8 ? Z_Q + vec * 64 : (vec < 16 ? Z_K + (vec - 8) * 64 : Z_KR);
    float* p = Z + (size_t)r * INC + col;
    const float2 c = cs[t * 32 + i]; const float x1 = p[i], x2 = p[i + 32];
    p[i] = x1 * c.x - x2 * c.y; p[i + 32] = x1 * c.y + x2 * c.x;
}
__global__ void k_rope_qm(float* __restrict__ Qm, const float2* __restrict__ cs) {
    const int idx = blockIdx.x * blockDim.x + threadIdx.x; if (idx >= RX * 4 * 32) return;
    const int i = idx % 32, h = (idx / 32) % 4, r = idx / 128; const int t = r % SEQ;
    float* p = Qm + (size_t)r * 768 + h * 192 + 128;
    const float2 c = cs[t * 32 + i]; const float x1 = p[i], x2 = p[i + 32];
    p[i] = x1 * c.x - x2 * c.y; p[i + 32] = x1 * c.y + x2 * c.x;
}
__global__ __launch_bounds__(256) void k_rms_slice(const float* __restrict__ Z, int col0, int n, const float* __restrict__ g, float* __restrict__ out) {
    const int r = blockIdx.x * 4 + (threadIdx.x >> 6), lane = threadIdx.x & 63; if (r >= R) return;
    const float* p = Z + (size_t)r * INC + col0; float ss = 0.f;
    for (int j = lane; j < n; j += 64) ss += p[j] * p[j];
    ss = wave_sum(ss); const float rs = 1.0f / sqrtf(ss / n + EPS);
    for (int j = lane; j < n; j += 64) out[(size_t)r * n + j] = p[j] * rs * g[j];
}
__global__ void k_pool(const float* __restrict__ Z, float* __restrict__ P) {
    const int idx = blockIdx.x * blockDim.x + threadIdx.x; if (idx >= R * 512) return;
    const int col = idx % 512, r = idx / 512; int b, t, L, isc; rowinfo(r, b, t, L, isc);
    const int g = col / 128, half = 1 << g;
    int lo = t - half; if (lo < 0) lo = 0; int hi = t + half; if (hi > L) hi = L;
    float s = 0.f; for (int tt = lo; tt < hi; ++tt) s += Z[(size_t)(r - t + tt) * INC + Z_POOL + col];
    P[idx] = s / (float)(hi - lo) - Z[(size_t)r * INC + Z_POOL + col];
}
__global__ void k_scale_cols(float* __restrict__ M_, int ld, int col0, int n, const float* __restrict__ sc) {
    const int idx = blockIdx.x * blockDim.x + threadIdx.x; if (idx >= R * n) return;
    const int j = idx % n, r = idx / n; M_[(size_t)r * ld + col0 + j] *= sc[j];
}
__global__ void k_sconv(const float* __restrict__ Z, const float* __restrict__ cw, float* __restrict__ MIX) {
    const int idx = blockIdx.x * blockDim.x + threadIdx.x; if (idx >= R * 512) return;
    const int c = idx % 512, r = idx / 512; int b, t, L, isc; rowinfo(r, b, t, L, isc);
    float s = 0.f;
#pragma unroll
    for (int k = 0; k < 3; ++k) { const int tt = t + k - 1; if (tt >= 0 && tt < L) { const float* zr = Z + (size_t)(r - t + tt) * INC; s += cw[k * 512 + c] * zr[Z_GC + c] * zr[Z_H + c]; } }
    MIX[(size_t)r * D + 1536 + c] = Z[(size_t)r * INC + Z_GB + c] * s;
}

constexpr int NKMAX = SEQ + CTX;
__global__ __launch_bounds__(128) void k_attn_diff(const float* __restrict__ Z, const float* __restrict__ lamp, const float* __restrict__ subg, float lam_init, float* __restrict__ MIX, int row0, int nrows) {
    __shared__ float S1[2][NKMAX], S2[2][NKMAX], Q[2][128];
    const int w = threadIdx.x >> 6, lane = threadIdx.x & 63;
    const int item = blockIdx.x * 2 + w; const int h = item & 3, r = row0 + (item >> 2);
    int b, t, L, isc; rowinfo(r, b, t, L, isc);
    const int nk = isc ? CTX : SEQ + CTX;
    float l1 = lamp[lane] * lamp[64 + lane], l2 = lamp[128 + lane] * lamp[192 + lane];
    l1 = wave_sum(l1); l2 = wave_sum(l2); const float lam = expf(l1) - expf(l2) + lam_init;
    Q[w][lane] = Z[(size_t)r * INC + Z_Q + h * 128 + lane]; Q[w][64 + lane] = Z[(size_t)r * INC + Z_Q + h * 128 + 64 + lane];
    __syncthreads();
    float m1 = -1e30f, m2 = -1e30f;
    for (int j0 = 0; j0 < nk; j0 += 64) { const int j = j0 + lane;
        const int kr = isc ? (RX + b * CTX + j) : (j < SEQ ? b * SEQ + j : RX + b * CTX + (j - SEQ));
        const float* kp = Z + (size_t)kr * INC + Z_K + h * 128; float s1 = 0.f, s2 = 0.f;
        for (int d = 0; d < 64; ++d) { s1 += Q[w][d] * kp[d]; s2 += Q[w][64 + d] * kp[64 + d]; }
        s1 *= 0.125f; s2 *= 0.125f; S1[w][j] = s1; S2[w][j] = s2; m1 = fmaxf(m1, s1); m2 = fmaxf(m2, s2); }
    m1 = wave_max(m1); m2 = wave_max(m2);
    float e1 = 0.f, e2 = 0.f;
    for (int j = lane; j < nk; j += 64) { const float p1 = expf(S1[w][j] - m1), p2 = expf(S2[w][j] - m2); S1[w][j] = p1; S2[w][j] = p2; e1 += p1; e2 += p2; }
    e1 = wave_sum(e1); e2 = wave_sum(e2);
    const float i1 = 1.f / e1, i2 = lam / e2;
    __syncthreads();
    float o0 = 0.f, o1 = 0.f;
    for (int j = 0; j < nk; ++j) { const int kr = isc ? (RX + b * CTX + j) : (j < SEQ ? b * SEQ + j : RX + b * CTX + (j - SEQ));
        const float a = S1[w][j] * i1 - S2[w][j] * i2; const float* vp = Z + (size_t)kr * INC + Z_V + h * 128;
        o0 += a * vp[lane]; o1 += a * vp[64 + lane]; }
    float ss = wave_sum(o0 * o0 + o1 * o1); const float rs = 1.0f / sqrtf(ss / 128.f + EPS);
    float* mp = MIX + (size_t)r * D + 512 + h * 128;
    mp[lane] = o0 * rs * subg[lane] * (1.f - lam_init); mp[64 + lane] = o1 * rs * subg[64 + lane] * (1.f - lam_init);
}
__global__ __launch_bounds__(128) void k_attn_mla(const float* __restrict__ Qm, const float* __restrict__ KVm, const float* __restrict__ Z, float* __restrict__ MIX, int row0, int nrows) {
    __shared__ float S1[2][NKMAX], Q[2][192];
    const int w = threadIdx.x >> 6, lane = threadIdx.x & 63;
    const int item = blockIdx.x * 2 + w; const int h = item & 3, r = row0 + (item >> 2);
    int b, t, L, isc; rowinfo(r, b, t, L, isc);
    const int nk = isc ? CTX : SEQ + CTX;
    for (int d = lane; d < 192; d += 64) Q[w][d] = Qm[(size_t)r * 768 + h * 192 + d];
    __syncthreads();
    const float scale = 0.07216878364870322f;
    float m1 = -1e30f;
    for (int j0 = 0; j0 < nk; j0 += 64) { const int j = j0 + lane;
        const int kr = isc ? (RX + b * CTX + j) : (j < SEQ ? b * SEQ + j : RX + b * CTX + (j - SEQ));
        const float* kp = KVm + (size_t)kr * 1024 + h * 256; const float* krp = Z + (size_t)kr * INC + Z_KR; float s1 = 0.f;
        for (int d = 0; d < 128; ++d) s1 += Q[w][d] * kp[d];
        for (int d = 0; d < 64; ++d) s1 += Q[w][128 + d] * krp[d];
        s1 *= scale; S1[w][j] = s1; m1 = fmaxf(m1, s1); }
    m1 = wave_max(m1);
    float e1 = 0.f;
    for (int j = lane; j < nk; j += 64) { const float p1 = expf(S1[w][j] - m1); S1[w][j] = p1; e1 += p1; }
    e1 = wave_sum(e1); const float i1 = 1.f / e1;
    __syncthreads();
    float o0 = 0.f, o1 = 0.f;
    for (int j = 0; j < nk; ++j) { const int kr = isc ? (RX + b * CTX + j) : (j < SEQ ? b * SEQ + j : RX + b * CTX + (j - SEQ));
        const float a = S1[w][j] * i1; const float* vp = KVm + (size_t)kr * 1024 + h * 256 + 128;
        o0 += a * vp[lane]; o1 += a * vp[64 + lane]; }
    float* mp = MIX + (size_t)r * D + 1024 + h * 128;
    mp[lane] = o0; mp[64 + lane] = o1;
}
__global__ void k_ffn_act(const float* __restrict__ U, const float* __restrict__ cw, float* __restrict__ ACT, int row0, int nrows) {
    const size_t idx = (size_t)blockIdx.x * blockDim.x + threadIdx.x; if (idx >= (size_t)nrows * DFF) return;
    const int j = (int)(idx % DFF), r = (int)(idx / DFF); int b, t, L, isc; rowinfo(row0 + r, b, t, L, isc);
    float g = 0.f, v = 0.f;
#pragma unroll
    for (int k = 0; k < 3; ++k) { const int tt = t + k - 1; if (tt >= 0 && tt < L) { const float* ur = U + (size_t)(r - t + tt) * (2 * DFF); g += cw[k * 2 * DFF + j] * ur[j]; v += cw[k * 2 * DFF + DFF + j] * ur[DFF + j]; } }
    ACT[idx] = g / (1.f + expf(-g)) * v;
}
__global__ void k_copy_out(const float* __restrict__ xr, float* __restrict__ out, int n4) {
    const int idx = blockIdx.x * blockDim.x + threadIdx.x; if (idx < n4) ((float4*)out)[idx] = ((const float4*)xr)[idx];
}
}

extern "C" void kernel_launch(void* const* d_in, const int* in_sizes, int n_in, void* d_out, int out_size, void* d_ws, size_t ws_size, hipStream_t stream) {
    using namespace nv;
    const float* x = (const float*)d_in[0]; const float* c = (const float*)d_in[1]; const float* ctx = (const float*)d_in[2]; const float* c_ctx = (const float*)d_in[3];
    const float* ada_w = (const float*)d_in[4]; const float* ada_b = (const float*)d_in[5];
    const float* g_pre_mix = (const float*)d_in[6]; const float* g_post_mix = (const float*)d_in[7]; const float* g_pre_ffn = (const float*)d_in[8]; const float* g_post_ffn = (const float*)d_in[9];
    const float* w_in = (const float*)d_in[10]; const float* pool_w = (const float*)d_in[11]; const float* pool_scale = (const float*)d_in[12];
    const float* diff_lambda = (const float*)d_in[13]; const float* diff_subln_g = (const float*)d_in[14];
    const float* mla_gq = (const float*)d_in[15]; const float* mla_w_uq = (const float*)d_in[16]; const float* mla_gkv = (const float*)d_in[17]; const float* mla_w_ukv = (const float*)d_in[18];
    const float* conv_w = (const float*)d_in[19]; const float* w_out = (const float*)d_in[20]; const float* ffn_w_up = (const float*)d_in[21]; const float* ffn_conv_w = (const float*)d_in[22]; const float* ffn_w_down = (const float*)d_in[23];
    char* ws = (char*)d_ws; size_t off = 0;
    auto take = [&](size_t bytes) { char* p = ws + off; off += (bytes + 255) / 256 * 256; return p; };
    float* mod = (float*)take((size_t)2 * 5 * MODW * 4);
    float2* cs = (float2*)take((size_t)SEQ * 32 * 8);
    float* XR = (float*)take((size_t)R * D * 4);
    float* H = (float*)take((size_t)R * D * 4);
    float* Ubase = (float*)(ws + off);
    float* Z = (float*)take((size_t)R * INC * 4);
    float* QM = (float*)take((size_t)R * 768 * 4);
    float* KVM = (float*)take((size_t)R * 1024 * 4);
    float* MIX = (float*)take((size_t)R * D * 4);
    float* TMP = (float*)take((size_t)R * 512 * 4);
    const size_t u_end = (size_t)((char*)Ubase - ws) + (size_t)SEQ * 2 * DFF * 4;
    if (off < u_end) off = (u_end + 255) / 256 * 256;
    float* Y = (float*)take((size_t)R * D * 4);
    float* ACT = (float*)take((size_t)SEQ * DFF * 4);
    if (off > ws_size) { fprintf(stderr, "workspace too small: need %zu have %zu\n", off, ws_size); return; }
    float* U = Ubase;

    hipMemsetAsync(mod, 0, (size_t)2 * 5 * MODW * 4, stream);
    hipLaunchKernelGGL(k_mod, dim3(96, 16), dim3(256), 0, stream, c, c_ctx, ada_w, ada_b, mod);
    hipLaunchKernelGGL(k_rope_table, dim3(SEQ * 32 / 256), dim3(256), 0, stream, cs);
    hipMemcpyAsync(XR, x, (size_t)RX * D * 4, hipMemcpyDeviceToDevice, stream);
    hipMemcpyAsync(XR + (size_t)RX * D, ctx, (size_t)RC * D * 4, hipMemcpyDeviceToDevice, stream);

    for (int l = 0; l < 2; ++l) {
        const bool last = (l == 1);
        const float* modl = mod + (size_t)l * 5 * MODW;
        const float lam_init = (float)(0.8 - 0.6 * exp(-0.3 * l));
        const int nr = last ? RX : R;
        hipLaunchKernelGGL(k_rowpass, dim3(R / 4), dim3(256), 0, stream, XR, (const float*)nullptr, (const float*)nullptr, modl, 0, g_pre_mix + l * D, 0 * D, 1 * D, H, R);
        hipLaunchKernelGGL(k_gemm, dim3((INC + 127) / 128, R / 128), dim3(256), 0, stream, H, D, w_in + (size_t)l * D * INC, INC, Z, INC, R, INC, D);
        hipLaunchKernelGGL(k_rope_z, dim3((RX * 17 * 32 + 255) / 256), dim3(256), 0, stream, Z, cs);
        hipLaunchKernelGGL(k_rms_slice, dim3(R / 4), dim3(256), 0, stream, Z, Z_CQ, 384, mla_gq + l * 384, TMP);
        hipLaunchKernelGGL(k_gemm, dim3(768 / 128, R / 128), dim3(256), 0, stream, TMP, 384, mla_w_uq + (size_t)l * 384 * 768, 768, QM, 768, R, 768, 384);
        hipLaunchKernelGGL(k_rope_qm, dim3(RX * 128 / 256), dim3(256), 0, stream, QM, cs);
        hipLaunchKernelGGL(k_rms_slice, dim3(R / 4), dim3(256), 0, stream, Z, Z_CKV, 256, mla_gkv + l * 256, TMP);
        hipLaunchKernelGGL(k_gemm, dim3(1024 / 128, R / 128), dim3(256), 0, stream, TMP, 256, mla_w_ukv + (size_t)l * 256 * 1024, 1024, KVM, 1024, R, 1024, 256);
        hipLaunchKernelGGL(k_pool, dim3(R * 512 / 256), dim3(256), 0, stream, Z, TMP);
        for (int g = 0; g < 4; ++g)
            hipLaunchKernelGGL(k_gemm, dim3(1, R / 128), dim3(256), 0, stream, TMP + g * 128, 512, pool_w + ((size_t)l * 4 + g) * 128 * 128, 128, MIX + g * 128, D, R, 128, 128);
        hipLaunchKernelGGL(k_scale_cols, dim3(R * 512 / 256), dim3(256), 0, stream, MIX, D, 0, 512, pool_scale + l * 512);
        hipLaunchKernelGGL(k_sconv, dim3(R * 512 / 256), dim3(256), 0, stream, Z, conv_w + (size_t)l * 3 * 512, MIX);
        hipLaunchKernelGGL(k_attn_diff, dim3(nr * 4 / 2), dim3(128), 0, stream, Z, diff_lambda + l * 256, diff_subln_g + l * 128, lam_init, MIX, 0, nr);
        hipLaunchKernelGGL(k_attn_mla, dim3(nr * 4 / 2), dim3(128), 0, stream, QM, KVM, Z, MIX, 0, nr);
        hipLaunchKernelGGL(k_gemm, dim3(D / 128, nr / 128), dim3(256), 0, stream, MIX, D, w_out + (size_t)l * D * D, D, Y, D, nr, D, D);
        hipLaunchKernelGGL(k_rowpass, dim3(nr / 4), dim3(256), 0, stream, XR, Y, g_post_mix + l * D, modl, 2 * D, g_pre_ffn + l * D, 3 * D, 4 * D, H, nr);
        for (int r0 = 0; r0 < nr; r0 += SEQ) {
            const int n = (nr - r0 < SEQ) ? (nr - r0) : SEQ;
            hipLaunchKernelGGL(k_gemm, dim3(2 * DFF / 128, n / 128), dim3(256), 0, stream, H + (size_t)r0 * D, D, ffn_w_up + (size_t)l * D * 2 * DFF, 2 * DFF, U, 2 * DFF, n, 2 * DFF, D);
            hipLaunchKernelGGL(k_ffn_act, dim3((unsigned)(((size_t)n * DFF + 255) / 256)), dim3(256), 0, stream, U, ffn_conv_w + (size_t)l * 3 * 2 * DFF, ACT, r0, n);
            hipLaunchKernelGGL(k_gemm, dim3(D / 128, n / 128), dim3(256), 0, stream, ACT, DFF, ffn_w_down + (size_t)l * DFF * D, D, Y + (size_t)r0 * D, D, n, D, DFF);
        }
        hipLaunchKernelGGL(k_rowpass, dim3(nr / 4), dim3(256), 0, stream, XR, Y, g_post_ffn + l * D, modl, 5 * D, (const float*)nullptr, 0, 0, (float*)nullptr, nr);
    }
    hipLaunchKernelGGL(k_copy_out, dim3(RX * D / 4 / 256), dim3(256), 0, stream, XR, (float*)d_out, RX * D / 4);
}
```

```cpp
#include <hip/hip_runtime.h>
#include <hip/hip_cooperative_groups.h>
#include <cstdint>
#include <cstdio>
#include <cmath>
namespace cg = cooperative_groups;

#define LAS __attribute__((address_space(3)))
typedef unsigned short bf16_t;
typedef short bf16x8 __attribute__((ext_vector_type(8)));
typedef short s16x4 __attribute__((ext_vector_type(4)));
typedef float f32x4 __attribute__((ext_vector_type(4)));
typedef float f32x2 __attribute__((ext_vector_type(2)));
typedef float f32x16 __attribute__((ext_vector_type(16)));
typedef unsigned u32x4 __attribute__((ext_vector_type(4)));
typedef unsigned u32x2 __attribute__((ext_vector_type(2)));

constexpr int D = 2048, NB = 4, SEQ = 2048, CTX = 256, GRIDW = 64;
constexpr int RX = NB * SEQ, RC = NB * CTX, R = RX + RC;
constexpr int INC = 4288, ZLD = 4352, DFF = 5632, UFF = 2 * DFF, MODW = 6 * D;
constexpr float EPS = 1e-6f;
constexpr int Z_POOL = 0, Z_Q = 512, Z_K = 1024, Z_V = 1536, Z_CQ = 2048, Z_CKV = 2432, Z_KR = 2688, Z_GB = 2752, Z_GC = 3264, Z_H = 3776;
constexpr int NWAVES = 8, NTHR = 512;

constexpr size_t MiB = 1u << 20;
constexpr size_t WS_CTL = 0, CTL_BYTES = 1 * MiB;
constexpr size_t WS_RSQ = 64 * 1024;
constexpr size_t WS_MOD = 1 * MiB;
constexpr size_t WS_CS = 2 * MiB;
constexpr size_t WS_POOLW = 3 * MiB;
constexpr size_t WS_WUQ = 4 * MiB;
constexpr size_t WS_WUKV = 6 * MiB;
constexpr size_t WS_WIN = 8 * MiB;
constexpr size_t WS_WOUT = 42 * MiB;
constexpr size_t WS_WUP = 58 * MiB;
constexpr size_t WS_WDOWN = 146 * MiB;
constexpr size_t WS_XR = 190 * MiB;
constexpr size_t WS_H = 262 * MiB;
constexpr size_t WS_BIG = 298 * MiB;
constexpr size_t WS_Z = WS_BIG;
constexpr size_t WS_QM = WS_BIG + 77 * MiB;
constexpr size_t WS_KN = WS_BIG + 91 * MiB;
constexpr size_t WS_VM = WS_BIG + 100 * MiB;
constexpr size_t WS_KR = WS_BIG + 109 * MiB;
constexpr size_t WS_MIX = WS_BIG + 111 * MiB;
constexpr size_t WS_Y = WS_BIG + 147 * MiB;
constexpr size_t WS_U = WS_BIG;
constexpr size_t WS_ACT = WS_BIG + 219 * MiB;
constexpr size_t WS_O1 = WS_ACT + 99 * MiB;
constexpr size_t WS_END = WS_O1 + 32 * MiB;
static_assert(WS_U + (size_t)R * UFF * 2 <= WS_ACT, "U overlay");
static_assert(WS_RSQ + (size_t)2 * R * 2 * 4 <= CTL_BYTES, "rsq in ctl");

struct Params {
    const float* in[24];
    float* out;
    unsigned char* ws;
    int ph_lo, ph_hi;
    int mask, pad;
};
enum { IN_X = 0, IN_C, IN_CTX, IN_CCTX, IN_ADAW, IN_ADAB, IN_GPREMIX, IN_GPOSTMIX, IN_GPREFFN, IN_GPOSTFFN, IN_WIN, IN_POOLW, IN_POOLSCALE, IN_DIFFLAM, IN_SUBLN,
       IN_GQ, IN_WUQ, IN_GKV, IN_WUKV, IN_CONVW, IN_WOUT, IN_WUP, IN_FFNCONVW, IN_WDOWN };
enum { PH_PRO = 0, PH_ROWA = 1, PH_L0 = 2, PHL_WIN = 0, PHL_PRE = 1, PHL_ATTN = 2, PHL_WOUT = 3, PHL_ROWB = 4, PHL_UP = 5, PHL_ACT = 6, PHL_DOWN = 7, PHL_ROWC = 8, PH_PER_LAYER = 9, PH_TOTAL = 2 + 2 * 9 };

__device__ __forceinline__ void rowinfo(int r, int& b, int& t, int& L, int& isc) {
    if (r < RX) { b = r / SEQ; t = r % SEQ; L = SEQ; isc = 0; } else { const int rc = r - RX; b = rc / CTX; t = rc % CTX; L = CTX; isc = 1; }
}
__device__ __forceinline__ float wave_sum(float v) {
#pragma unroll
    for (int o = 1; o < 64; o <<= 1) v += __shfl_xor(v, o);
    return v;
}
__device__ __forceinline__ float wave_max(float v) {
#pragma unroll
    for (int o = 1; o < 64; o <<= 1) v = fmaxf(v, __shfl_xor(v, o));
    return v;
}
__device__ __forceinline__ unsigned cvt_pk_bf16(float lo, float hi) { unsigned r; asm volatile("v_cvt_pk_bf16_f32 %0, %1, %2" : "=v"(r) : "v"(lo), "v"(hi)); return r; }
__device__ __forceinline__ bf16_t f2bf(float f) { return (bf16_t)(cvt_pk_bf16(f, 0.f) & 0xffffu); }
__device__ __forceinline__ float bf2f(bf16_t h) { return __uint_as_float(((unsigned)h) << 16); }
__device__ __forceinline__ void unpack8(const u32x4 w, float* f) {
    f[0] = __uint_as_float(w.x << 16); f[1] = __uint_as_float(w.x & 0xffff0000u); f[2] = __uint_as_float(w.y << 16); f[3] = __uint_as_float(w.y & 0xffff0000u);
    f[4] = __uint_as_float(w.z << 16); f[5] = __uint_as_float(w.z & 0xffff0000u); f[6] = __uint_as_float(w.w << 16); f[7] = __uint_as_float(w.w & 0xffff0000u);
}
__device__ __forceinline__ u32x4 pack8(const float* f) { u32x4 w; w.x = cvt_pk_bf16(f[0], f[1]); w.y = cvt_pk_bf16(f[2], f[3]); w.z = cvt_pk_bf16(f[4], f[5]); w.w = cvt_pk_bf16(f[6], f[7]); return w; }
__device__ __forceinline__ u32x4 ld16(const bf16_t* p) { return *(const u32x4*)p; }
__device__ __forceinline__ void st16(bf16_t* p, u32x4 v) { *(u32x4*)p = v; }

__host__ __device__ __forceinline__ int uq_pos(int n) { const int h = n / 192, j = n % 192; if (j < 128) return (h >> 1) * 256 + (h & 1) * 128 + j; const int jj = j - 128; return jj < 32 ? 512 + h * 32 + jj : 640 + h * 32 + (jj - 32); }

template <int MAP>
__device__ __forceinline__ void tr_item(const float* __restrict__ W, int K, int N, bf16_t* __restrict__ WT, int ldt, const float* __restrict__ ks, const float* __restrict__ ns, LAS float* scr, int item, int lane) {
    const int nblk = N / 32, kb = item / nblk, nb = item % nblk, k0 = 64 * kb, n0 = 32 * nb;
    const float nsv = ns ? ns[n0 + (lane & 31)] : 1.f;
#pragma unroll 8
    for (int i = 0; i < 32; ++i) { const int kk = 2 * i + (lane >> 5); float v = W[(size_t)(k0 + kk) * N + n0 + (lane & 31)]; if (ks) v *= ks[k0 + kk]; scr[kk * 33 + (lane & 31)] = v * nsv; }
    asm volatile("s_waitcnt lgkmcnt(0)" ::: "memory");
    const int c = lane & 7;
#pragma unroll
    for (int j = 0; j < 4; ++j) { const int n = (lane >> 3) + 8 * j; const LAS float* s = scr + (8 * c) * 33 + n;
        u32x4 o; o.x = cvt_pk_bf16(s[0 * 33], s[1 * 33]); o.y = cvt_pk_bf16(s[2 * 33], s[3 * 33]); o.z = cvt_pk_bf16(s[4 * 33], s[5 * 33]); o.w = cvt_pk_bf16(s[6 * 33], s[7 * 33]);
        const int nn = n0 + n; const int dst = (MAP == 1) ? uq_pos(nn) : nn;
        *(u32x4*)(WT + (size_t)dst * ldt + k0 + 8 * c) = o; }
    asm volatile("s_waitcnt lgkmcnt(0)" ::: "memory");
}

__device__ __forceinline__ void phase_prologue(const Params& P, unsigned char* ws, int tid_, LAS unsigned char* lds, int vcu, int G) {
    const int tid = tid_, lane = tid & 63, wave = tid >> 6;
    {
        LAS float* red = (LAS float*)lds;
        float* MOD = (float*)(ws + WS_MOD);
        for (int cb = vcu; cb < 256; cb += G) {
            const int gn0 = cb * 96, l = gn0 / MODW, n0 = gn0 % MODW;
            if (tid < 384) {
                const int cq = tid % 24, kg = tid / 24;
                const float* w = P.in[IN_ADAW] + ((size_t)l * D + kg * 128) * MODW + n0 + cq * 4;
                f32x4 acc[5];
#pragma unroll
                for (int i = 0; i < 5; ++i) acc[i] = (f32x4){0.f, 0.f, 0.f, 0.f};
#pragma unroll 4
                for (int k = 0; k < 128; ++k) { const f32x4 wv = *(const f32x4*)(w + (size_t)k * MODW); const int kk = kg * 128 + k;
#pragma unroll
                    for (int i = 0; i < 5; ++i) { const float v = (i < 4) ? P.in[IN_C][i * D + kk] : P.in[IN_CCTX][kk]; const float s = v / (1.f + __expf(-v)); acc[i] += wv * s; } }
#pragma unroll
                for (int i = 0; i < 5; ++i)
#pragma unroll
                    for (int e = 0; e < 4; ++e) red[(kg * 5 + i) * 96 + cq * 4 + e] = acc[i][e];
            }
            __syncthreads();
            if (tid < 480) { const int i = tid / 96, cn = tid % 96; float s = P.in[IN_ADAB][l * MODW + n0 + cn];
#pragma unroll
                for (int kg = 0; kg < 16; ++kg) s += red[(kg * 5 + i) * 96 + cn];
                MOD[((size_t)l * 5 + i) * MODW + n0 + cn] = s; }
            __syncthreads();
        }
    }
    {
        float2* cs = (float2*)(ws + WS_CS);
        for (int idx = vcu * NTHR + tid; idx < SEQ * 32; idx += G * NTHR) {
            const int t = idx / 32, i = idx % 32, f = i & 15;
            const float base = ((f & 3) == 0) ? 1.0f : ((f & 3) == 1) ? 0.5623413251903491f : ((f & 3) == 2) ? 0.31622776601683794f : 0.1778279410038923f;
            const float dec = ((f >> 2) == 0) ? 1.0f : ((f >> 2) == 1) ? 0.1f : ((f >> 2) == 2) ? 0.01f : 0.001f;
            const float pos = (i < 16) ? (float)(t / GRIDW) : (float)(t % GRIDW);
            const float ang = pos * (base * dec);
            cs[idx] = make_float2(cosf(ang), sinf(ang));
        }
    }
    {
        for (int idx = vcu * NTHR + tid; idx < 2 * 64 * 256; idx += G * NTHR) { const int l = idx / (64 * 256), rem = idx % (64 * 256), row = INC + rem / 256, ch = rem % 256;
            *(u32x4*)((bf16_t*)(ws + WS_WIN) + ((size_t)l * ZLD + row) * D + ch * 8) = (u32x4){0u, 0u, 0u, 0u}; }
    }
    {
        LAS float* scr = (LAS float*)(lds + 32768) + wave * (64 * 33);
        constexpr int I_IN = 32 * 134, I_OUT = 32 * 64, I_UP = 32 * 352, I_DOWN = 88 * 64, I_UQ = 6 * 24, I_UKV = 4 * 32, I_POOL = 4 * 8;
        constexpr int I_LAYER = I_IN + I_OUT + I_UP + I_DOWN + I_UQ + I_UKV + I_POOL;
        const int gw = vcu * NWAVES + wave, NGW = G * NWAVES;
        for (int it = gw; it < 2 * I_LAYER; it += NGW) {
            const int l = it / I_LAYER; int r = it % I_LAYER;
            if (r < I_IN) { tr_item<0>(P.in[IN_WIN] + (size_t)l * D * INC, D, INC, (bf16_t*)(ws + WS_WIN) + (size_t)l * ZLD * D, D, nullptr, nullptr, scr, r, lane); continue; } r -= I_IN;
            if (r < I_OUT) { tr_item<0>(P.in[IN_WOUT] + (size_t)l * D * D, D, D, (bf16_t*)(ws + WS_WOUT) + (size_t)l * D * D, D, nullptr, nullptr, scr, r, lane); continue; } r -= I_OUT;
            if (r < I_UP) { tr_item<0>(P.in[IN_WUP] + (size_t)l * D * UFF, D, UFF, (bf16_t*)(ws + WS_WUP) + (size_t)l * UFF * D, D, nullptr, nullptr, scr, r, lane); continue; } r -= I_UP;
            if (r < I_DOWN) { tr_item<0>(P.in[IN_WDOWN] + (size_t)l * DFF * D, DFF, D, (bf16_t*)(ws + WS_WDOWN) + (size_t)l * D * DFF, DFF, nullptr, nullptr, scr, r, lane); continue; } r -= I_DOWN;
            if (r < I_UQ) { tr_item<1>(P.in[IN_WUQ] + (size_t)l * 384 * 768, 384, 768, (bf16_t*)(ws + WS_WUQ) + (size_t)l * 768 * 384, 384, P.in[IN_GQ] + l * 384, nullptr, scr, r, lane); continue; } r -= I_UQ;
            if (r < I_UKV) { tr_item<0>(P.in[IN_WUKV] + (size_t)l * 256 * 1024, 256, 1024, (bf16_t*)(ws + WS_WUKV) + (size_t)l * 1024 * 256, 256, P.in[IN_GKV] + l * 256, nullptr, scr, r, lane); continue; } r -= I_UKV;
            { const int g = r / 8, rr = r % 8;
              tr_item<0>(P.in[IN_POOLW] + ((size_t)l * 4 + g) * 128 * 128, 128, 128, (bf16_t*)(ws + WS_POOLW) + ((size_t)l * 4 + g) * 128 * 128, 128, nullptr, P.in[IN_POOLSCALE] + l * 512 + g * 128, scr, rr, lane); }
        }
    }
}

__device__ __forceinline__ void rowpass_row(const float* __restrict__ xin, const float* __restrict__ y, const float* __restrict__ ygain, const float* __restrict__ gate, float* __restrict__ xout,
                                            const float* __restrict__ ngain, const float* __restrict__ shift, const float* __restrict__ scale, bf16_t* __restrict__ hout, int lane) {
    f32x4 xv[8];
#pragma unroll
    for (int j = 0; j < 8; ++j) xv[j] = *(const f32x4*)(xin + j * 256 + lane * 4);
    if (y) {
        f32x4 yv[8]; float ss = 0.f;
#pragma unroll
        for (int j = 0; j < 8; ++j) { yv[j] = *(const f32x4*)(y + j * 256 + lane * 4); ss += (yv[j].x * yv[j].x + yv[j].y * yv[j].y) + (yv[j].z * yv[j].z + yv[j].w * yv[j].w); }
        ss = wave_sum(ss); const float rs = 1.0f / sqrtf(ss * (1.f / D) + EPS);
#pragma unroll
        for (int j = 0; j < 8; ++j) { const f32x4 gg = *(const f32x4*)(gate + j * 256 + lane * 4), yg = *(const f32x4*)(ygain + j * 256 + lane * 4); xv[j] += gg * (yv[j] * rs * yg); }
    }
    if (xout) {
#pragma unroll
        for (int j = 0; j < 8; ++j) *(f32x4*)(xout + j * 256 + lane * 4) = xv[j];
    }
    if (hout) {
        float ss = 0.f;
#pragma unroll
        for (int j = 0; j < 8; ++j) ss += (xv[j].x * xv[j].x + xv[j].y * xv[j].y) + (xv[j].z * xv[j].z + xv[j].w * xv[j].w);
        ss = wave_sum(ss); const float rs = 1.0f / sqrtf(ss * (1.f / D) + EPS);
#pragma unroll
        for (int j = 0; j < 8; ++j) { const f32x4 ng = *(const f32x4*)(ngain + j * 256 + lane * 4), sc = *(const f32x4*)(scale + j * 256 + lane * 4), sh = *(const f32x4*)(shift + j * 256 + lane * 4);
            const f32x4 o = (xv[j] * rs * ng) * (sc + 1.f) + sh; u32x2 w; w.x = cvt_pk_bf16(o.x, o.y); w.y = cvt_pk_bf16(o.z, o.w);
            *(u32x2*)(hout + j * 256 + lane * 4) = w; }
    }
}
__device__ __forceinline__ void phase_rowpass(const Params& P, unsigned char* ws, int tid_, int kind, int l, int vcu, int G) {
    const int lane = tid_ & 63, wave = tid_ >> 6;
    const float* MOD = (const float*)(ws + WS_MOD);
    float* XR = (float*)(ws + WS_XR); const float* Y = (const float*)(ws + WS_Y); bf16_t* H = (bf16_t*)(ws + WS_H);
    const bool last = (l == 1);
    const int nrows = (kind == 0) ? R : (last ? RX : R);
    for (int r = vcu * NWAVES + wave; r < nrows; r += G * NWAVES) {
        int b, t, L, isc; rowinfo(r, b, t, L, isc); const int mi = isc ? 4 : b;
        const float* m = MOD + ((size_t)l * 5 + mi) * MODW;
        const float* xin0 = isc ? P.in[IN_CTX] + (size_t)(r - RX) * D : P.in[IN_X] + (size_t)r * D;
        if (kind == 0) {
            rowpass_row(xin0, nullptr, nullptr, nullptr, nullptr, P.in[IN_GPREMIX], m + 0 * D, m + 1 * D, H + (size_t)r * D, lane);
        } else if (kind == 1) {
            const float* xin = (l == 0) ? xin0 : XR + (size_t)r * D;
            rowpass_row(xin, Y + (size_t)r * D, P.in[IN_GPOSTMIX] + l * D, m + 2 * D, XR + (size_t)r * D, P.in[IN_GPREFFN] + l * D, m + 3 * D, m + 4 * D, H + (size_t)r * D, lane);
        } else {
            if (!last) { const float* m1 = MOD + ((size_t)1 * 5 + mi) * MODW;
                rowpass_row(XR + (size_t)r * D, Y + (size_t)r * D, P.in[IN_GPOSTFFN] + l * D, m + 5 * D, XR + (size_t)r * D, P.in[IN_GPREMIX] + 1 * D, m1 + 0 * D, m1 + 1 * D, H + (size_t)r * D, lane);
            } else {
                rowpass_row(XR + (size_t)r * D, Y + (size_t)r * D, P.in[IN_GPOSTFFN] + l * D, m + 5 * D, P.out + (size_t)r * D, nullptr, nullptr, nullptr, nullptr, lane);
            }
        }
    }
}

__device__ __forceinline__ void pre_rope(const Params& P, unsigned char* ws, int tid_, int vcu, int G) {
    bf16_t* Z = (bf16_t*)(ws + WS_Z); bf16_t* KR = (bf16_t*)(ws + WS_KR); const float2* cs = (const float2*)(ws + WS_CS);
    const int gt = vcu * NTHR + tid_, NGT = G * NTHR;
    for (int idx = gt; idx < RX * 68; idx += NGT) {
        const int ic = idx & 3, v = (idx >> 2) % 17, r = idx / 68, t = r % SEQ;
        const int col = (v < 16) ? Z_Q + v * 64 : Z_KR;
        const bf16_t* src = Z + (size_t)r * ZLD + col + ic * 8;
        float x1[8], x2[8], o1[8], o2[8]; unpack8(ld16(src), x1); unpack8(ld16(src + 32), x2);
        const f32x4* cp = (const f32x4*)(cs + t * 32 + ic * 8);
#pragma unroll
        for (int q = 0; q < 4; ++q) { const f32x4 c2 = cp[q];
            o1[2 * q] = x1[2 * q] * c2.x - x2[2 * q] * c2.y; o2[2 * q] = x1[2 * q] * c2.y + x2[2 * q] * c2.x;
            o1[2 * q + 1] = x1[2 * q + 1] * c2.z - x2[2 * q + 1] * c2.w; o2[2 * q + 1] = x1[2 * q + 1] * c2.w + x2[2 * q + 1] * c2.z; }
        bf16_t* dst = (v < 16) ? Z + (size_t)r * ZLD + col + ic * 8 : KR + (size_t)r * 64 + ic * 8;
        st16(dst, pack8(o1)); st16(dst + 32, pack8(o2));
    }
    for (int idx = gt; idx < RC * 8; idx += NGT) { const int r = RX + idx / 8, ch = idx % 8; st16(KR + (size_t)r * 64 + ch * 8, ld16(Z + (size_t)r * ZLD + Z_KR + ch * 8)); }
}
__device__ __forceinline__ void pre_conv(const Params& P, unsigned char* ws, int tid_, int l, int vcu, int G) {
    const bf16_t* Z = (const bf16_t*)(ws + WS_Z); bf16_t* MIX = (bf16_t*)(ws + WS_MIX);
    const float* cw = P.in[IN_CONVW] + (size_t)l * 3 * 512;
    const int gt = vcu * NTHR + tid_, NGT = G * NTHR;
    for (int idx = gt; idx < R * 64; idx += NGT) {
        const int ch = idx & 63, r = idx >> 6, c0 = ch * 8; int b, t, L, isc; rowinfo(r, b, t, L, isc);
        float s[8];
#pragma unroll
        for (int e = 0; e < 8; ++e) s[e] = 0.f;
#pragma unroll
        for (int k = 0; k < 3; ++k) { const int tt = t + k - 1;
            if (tt >= 0 && tt < L) { const bf16_t* zr = Z + (size_t)(r + k - 1) * ZLD; float gc[8], hh[8]; unpack8(ld16(zr + Z_GC + c0), gc); unpack8(ld16(zr + Z_H + c0), hh);
                const f32x4 w0 = *(const f32x4*)(cw + k * 512 + c0), w1 = *(const f32x4*)(cw + k * 512 + c0 + 4);
                s[0] += w0.x * gc[0] * hh[0]; s[1] += w0.y * gc[1] * hh[1]; s[2] += w0.z * gc[2] * hh[2]; s[3] += w0.w * gc[3] * hh[3];
                s[4] += w1.x * gc[4] * hh[4]; s[5] += w1.y * gc[5] * hh[5]; s[6] += w1.z * gc[6] * hh[6]; s[7] += w1.w * gc[7] * hh[7]; } }
        float gb[8]; unpack8(ld16(Z + (size_t)r * ZLD + Z_GB + c0), gb);
#pragma unroll
        for (int e = 0; e < 8; ++e) s[e] *= gb[e];
        st16(MIX + (size_t)r * D + 1536 + c0, pack8(s));
    }
}
__device__ __forceinline__ void pre_pool(const Params& P, unsigned char* ws, int tid_, int l, int vcu, int G) {
    const bf16_t* Z = (const bf16_t*)(ws + WS_Z); bf16_t* MIX = (bf16_t*)(ws + WS_MIX);
    const bf16_t* PW = (const bf16_t*)(ws + WS_POOLW) + (size_t)l * 4 * 128 * 128;
    const int lane = tid_ & 63, wave = tid_ >> 6, fr = lane & 15, fq = lane >> 4;
    for (int item = vcu * NWAVES + wave; item < (R / 16) * 4; item += G * NWAVES) {
        const int g = item & 3, rt = item >> 2, r = rt * 16 + fr; int b, t, L, isc; rowinfo(r, b, t, L, isc);
        const int half = 1 << g; int lo = t - half; if (lo < 0) lo = 0; int hi = t + half; if (hi > L) hi = L;
        const float inv = 1.0f / (float)(hi - lo);
        float acc[4][8];
#pragma unroll
        for (int kk = 0; kk < 4; ++kk)
#pragma unroll
            for (int e = 0; e < 8; ++e) acc[kk][e] = 0.f;
        const bf16_t* zc = Z + Z_POOL + g * 128 + fq * 8;
        for (int tt = lo; tt < hi; ++tt) { const bf16_t* zr = zc + (size_t)(r - t + tt) * ZLD;
#pragma unroll
            for (int kk = 0; kk < 4; ++kk) { float v[8]; unpack8(ld16(zr + kk * 32), v);
#pragma unroll
                for (int e = 0; e < 8; ++e) acc[kk][e] += v[e]; } }
        bf16x8 a[4];
#pragma unroll
        for (int kk = 0; kk < 4; ++kk) { float v[8]; unpack8(ld16(zc + (size_t)r * ZLD + kk * 32), v);
#pragma unroll
            for (int e = 0; e < 8; ++e) v[e] = acc[kk][e] * inv - v[e];
            const u32x4 w = pack8(v); a[kk] = *(const bf16x8*)&w; }
        const bf16_t* pw = PW + (size_t)g * 128 * 128;
#pragma unroll
        for (int n = 0; n < 8; ++n) { f32x4 c = (f32x4){0.f, 0.f, 0.f, 0.f};
#pragma unroll
            for (int kk = 0; kk < 4; ++kk) { const u32x4 bw = ld16(pw + (size_t)(16 * n + fr) * 128 + kk * 32 + fq * 8); c = __builtin_amdgcn_mfma_f32_16x16x32_bf16(*(const bf16x8*)&bw, a[kk], c, 0, 0, 0); }
            u32x2 w; w.x = cvt_pk_bf16(c[0], c[1]); w.y = cvt_pk_bf16(c[2], c[3]);
            *(u32x2*)(MIX + (size_t)r * D + g * 128 + 16 * n + 4 * fq) = w; }
    }
}
__device__ __forceinline__ void phase_act(const Params& P, unsigned char* ws, int tid_, int l, int vcu, int G) {
    const bf16_t* U = (const bf16_t*)(ws + WS_U); bf16_t* ACT = (bf16_t*)(ws + WS_ACT);
    const float* cw = P.in[IN_FFNCONVW] + (size_t)l * 3 * UFF;
    const int nrows = (l == 1) ? RX : R;
    const int gt = vcu * NTHR + tid_, NGT = G * NTHR;
    for (int idx = gt; idx < (nrows / 16) * 704; idx += NGT) {
        const int chn = idx % 704, strip = idx / 704, r0 = strip * 16, j0 = chn * 8; int b, t0, L, isc; rowinfo(r0, b, t0, L, isc);
        float wg[3][8], wv[3][8];
#pragma unroll
        for (int k = 0; k < 3; ++k) { const f32x4 a0 = *(const f32x4*)(cw + k * UFF + j0), a1 = *(const f32x4*)(cw + k * UFF + j0 + 4), b0 = *(const f32x4*)(cw + k * UFF + DFF + j0), b1 = *(const f32x4*)(cw + k * UFF + DFF + j0 + 4);
            wg[k][0] = a0.x; wg[k][1] = a0.y; wg[k][2] = a0.z; wg[k][3] = a0.w; wg[k][4] = a1.x; wg[k][5] = a1.y; wg[k][6] = a1.z; wg[k][7] = a1.w;
            wv[k][0] = b0.x; wv[k][1] = b0.y; wv[k][2] = b0.z; wv[k][3] = b0.w; wv[k][4] = b1.x; wv[k][5] = b1.y; wv[k][6] = b1.z; wv[k][7] = b1.w; }
        float pg[8], pv[8], cg_[8], cv[8], ng[8], nv[8];
        const bf16_t* ub = U + (size_t)r0 * UFF + j0;
        if (t0 > 0) { unpack8(ld16(ub - UFF), pg); unpack8(ld16(ub - UFF + DFF), pv); } else {
#pragma unroll
            for (int e = 0; e < 8; ++e) { pg[e] = 0.f; pv[e] = 0.f; } }
        unpack8(ld16(ub), cg_); unpack8(ld16(ub + DFF), cv);
#pragma unroll 1
        for (int i = 0; i < 16; ++i) {
            if (t0 + i + 1 < L) { unpack8(ld16(ub + (size_t)(i + 1) * UFF), ng); unpack8(ld16(ub + (size_t)(i + 1) * UFF + DFF), nv); } else {
#pragma unroll
                for (int e = 0; e < 8; ++e) { ng[e] = 0.f; nv[e] = 0.f; } }
            float o[8];
#pragma unroll
            for (int e = 0; e < 8; ++e) { const float gsum = wg[0][e] * pg[e] + wg[1][e] * cg_[e] + wg[2][e] * ng[e]; const float vsum = wv[0][e] * pv[e] + wv[1][e] * cv[e] + wv[2][e] * nv[e];
                o[e] = gsum * __builtin_amdgcn_rcpf(1.f + __expf(-gsum)) * vsum; }
            st16(ACT + (size_t)(r0 + i) * DFF + j0, pack8(o));
#pragma unroll
            for (int e = 0; e < 8; ++e) { pg[e] = cg_[e]; pv[e] = cv[e]; cg_[e] = ng[e]; cv[e] = nv[e]; }
        }
    }
}

constexpr int LDS_BYTES = 147456;
__global__ void __launch_bounds__(NTHR, 2) mk_fwd(Params P) {
    extern __shared__ __attribute__((aligned(16))) unsigned char lds_raw[];
    LAS unsigned char* lds = (LAS unsigned char*)lds_raw;
    const int G = gridDim.x, bx = blockIdx.x;
    const int vcu = (G % 8 == 0) ? (bx % 8) * (G / 8) + bx / 8 : bx;
    for (int ph = P.ph_lo; ph < P.ph_hi; ++ph) {
        if (ph != P.ph_lo) cg::this_grid().sync();
        int tid_ = __builtin_amdgcn_workitem_id_x(); asm volatile("" : "+v"(tid_));
        unsigned char* ws = P.ws; asm volatile("" : "+s"(ws));
        if (ph == PH_PRO) { phase_prologue(P, ws, tid_, lds, vcu, G); continue; }
        if (ph == PH_ROWA) { phase_rowpass(P, ws, tid_, 0, 0, vcu, G); continue; }
        const int l = (ph - PH_L0) / PH_PER_LAYER, sub = (ph - PH_L0) % PH_PER_LAYER;
        if (sub == PHL_PRE) {
            if (P.mask & 2) pre_rope(P, ws, tid_, vcu, G);
            if (P.mask & 4) pre_pool(P, ws, tid_, l, vcu, G);
            if (P.mask & 8) pre_conv(P, ws, tid_, l, vcu, G);
        } else if (sub == PHL_ROWB) phase_rowpass(P, ws, tid_, 1, l, vcu, G);
        else if (sub == PHL_ACT) phase_act(P, ws, tid_, l, vcu, G);
        else if (sub == PHL_ROWC) phase_rowpass(P, ws, tid_, 2, l, vcu, G);
    }
}

namespace slow {
struct EpiZ { bf16_t* Z; __device__ void operator()(int r, int n, float v) const { Z[(size_t)r * ZLD + n] = f2bf(v); } };
struct EpiQ { bf16_t* QM; const float* rsq; __device__ void operator()(int r, int p, float v) const {
        int nat; if (p < 512) { const int h = (p >> 8) * 2 + ((p >> 7) & 1); nat = h * 192 + (p & 127); } else { const int q = p - 512, half = q >> 7, h = (q & 127) >> 5, i = q & 31; nat = h * 192 + 128 + half * 32 + i; }
        const float rs = 1.0f / sqrtf(rsq[r * 2 + 0] * (1.f / 384.f) + EPS); QM[(size_t)r * 768 + nat] = f2bf(v * rs); } };
struct EpiKV { bf16_t* KN; bf16_t* VM; const float* rsq; __device__ void operator()(int r, int n, float v) const {
        const int h = n >> 8, j = n & 255; const float rs = 1.0f / sqrtf(rsq[r * 2 + 1] * (1.f / 256.f) + EPS);
        if (j < 128) KN[(size_t)r * 512 + h * 128 + j] = f2bf(v * rs); else VM[(size_t)r * 512 + h * 128 + j - 128] = f2bf(v * rs); } };
struct EpiY { float* Y; __device__ void operator()(int r, int n, float v) const { Y[(size_t)r * D + n] = v; } };
struct EpiU { bf16_t* U; __device__ void operator()(int r, int n, float v) const { U[(size_t)r * UFF + n] = f2bf(v); } };
struct EpiPool { bf16_t* MIX; int g; __device__ void operator()(int r, int n, float v) const { MIX[(size_t)r * D + g * 128 + n] = f2bf(v); } };

template <class Epi>
__global__ __launch_bounds__(256) void k_sgemm(const bf16_t* __restrict__ A, int lda, const bf16_t* __restrict__ Bt, int ldb, int K, Epi E) {
    __shared__ float As[32][68]; __shared__ float Bs[32][68];
    const int tid = threadIdx.x, tx = tid & 15, ty = tid >> 4; const int m0 = blockIdx.y * 64, n0 = blockIdx.x * 64;
    float acc[4][4];
#pragma unroll
    for (int i = 0; i < 4; ++i)
#pragma unroll
        for (int j = 0; j < 4; ++j) acc[i][j] = 0.f;
    const int lr = tid >> 2, lk = (tid & 3) * 8;
    for (int k0 = 0; k0 < K; k0 += 32) {
        float av[8], bv[8]; unpack8(ld16(A + (size_t)(m0 + lr) * lda + k0 + lk), av); unpack8(ld16(Bt + (size_t)(n0 + lr) * ldb + k0 + lk), bv);
        __syncthreads();
#pragma unroll
        for (int e = 0; e < 8; ++e) { As[lk + e][lr] = av[e]; Bs[lk + e][lr] = bv[e]; }
        __syncthreads();
#pragma unroll
        for (int k = 0; k < 32; ++k) { const f32x4 a = *(const f32x4*)&As[k][ty * 4], b = *(const f32x4*)&Bs[k][tx * 4];
#pragma unroll
            for (int i = 0; i < 4; ++i)
#pragma unroll
                for (int j = 0; j < 4; ++j) acc[i][j] += a[i] * b[j]; }
    }
#pragma unroll
    for (int i = 0; i < 4; ++i)
#pragma unroll
        for (int j = 0; j < 4; ++j) E(m0 + ty * 4 + i, n0 + tx * 4 + j, acc[i][j]);
}
__global__ __launch_bounds__(256) void k_rsq(const bf16_t* __restrict__ Z, float* __restrict__ rsq) {
    const int r = blockIdx.x * 4 + (threadIdx.x >> 6), lane = threadIdx.x & 63; if (r >= R) return;
    float s0 = 0.f, s1 = 0.f;
    for (int j = lane; j < 384; j += 64) { const float v = bf2f(Z[(size_t)r * ZLD + Z_CQ + j]); s0 += v * v; }
    for (int j = lane; j < 256; j += 64) { const float v = bf2f(Z[(size_t)r * ZLD + Z_CKV + j]); s1 += v * v; }
    s0 = wave_sum(s0); s1 = wave_sum(s1); if (lane == 0) { rsq[r * 2] = s0; rsq[r * 2 + 1] = s1; }
}
__global__ void k_rope_qm(bf16_t* __restrict__ QM, const float2* __restrict__ cs) {
    const int idx = blockIdx.x * blockDim.x + threadIdx.x; if (idx >= RX * 4 * 32) return;
    const int i = idx % 32, h = (idx / 32) % 4, r = idx / 128, t = r % SEQ;
    bf16_t* p = QM + (size_t)r * 768 + h * 192 + 128; const float2 c = cs[t * 32 + i]; const float x1 = bf2f(p[i]), x2 = bf2f(p[i + 32]);
    p[i] = f2bf(x1 * c.x - x2 * c.y); p[i + 32] = f2bf(x1 * c.y + x2 * c.x);
}
__global__ void k_pooled(const bf16_t* __restrict__ Z, bf16_t* __restrict__ Pb) {
    const int idx = blockIdx.x * blockDim.x + threadIdx.x; if (idx >= R * 512) return;
    const int col = idx % 512, r = idx / 512; int b, t, L, isc; rowinfo(r, b, t, L, isc);
    const int g = col / 128, half = 1 << g; int lo = t - half; if (lo < 0) lo = 0; int hi = t + half; if (hi > L) hi = L;
    float s = 0.f; for (int tt = lo; tt < hi; ++tt) s += bf2f(Z[(size_t)(r - t + tt) * ZLD + Z_POOL + col]);
    Pb[idx] = f2bf(s / (float)(hi - lo) - bf2f(Z[(size_t)r * ZLD + Z_POOL + col]));
}
constexpr int NKMAX = SEQ + CTX;
__device__ __forceinline__ int keyrow(int isc, int b, int j) { return isc ? (RX + b * CTX + j) : (j < SEQ ? b * SEQ + j : RX + b * CTX + (j - SEQ)); }
__global__ __launch_bounds__(128) void k_attn_diff(const bf16_t* __restrict__ Z, const float* __restrict__ lamp, const float* __restrict__ subg, float lam_init, bf16_t* __restrict__ MIX) {
    __shared__ float S1[2][NKMAX], S2[2][NKMAX], Q[2][128];
    const int w = threadIdx.x >> 6, lane = threadIdx.x & 63; const int item = blockIdx.x * 2 + w; const int h = item & 3, r = item >> 2;
    int b, t, L, isc; rowinfo(r, b, t, L, isc); const int nk = isc ? CTX : SEQ + CTX;
    float l1 = lamp[lane] * lamp[64 + lane], l2 = lamp[128 + lane] * lamp[192 + lane]; l1 = wave_sum(l1); l2 = wave_sum(l2); const float lam = expf(l1) - expf(l2) + lam_init;
    Q[w][lane] = bf2f(Z[(size_t)r * ZLD + Z_Q + h * 128 + lane]); Q[w][64 + lane] = bf2f(Z[(size_t)r * ZLD + Z_Q + h * 128 + 64 + lane]);
    __syncthreads();
    float m1 = -1e30f, m2 = -1e30f;
    for (int j0 = 0; j0 < nk; j0 += 64) { const int j = j0 + lane; const bf16_t* kp = Z + (size_t)keyrow(isc, b, j) * ZLD + Z_K + h * 128; float s1 = 0.f, s2 = 0.f;
        for (int d = 0; d < 64; ++d) { s1 += Q[w][d] * bf2f(kp[d]); s2 += Q[w][64 + d] * bf2f(kp[64 + d]); }
        s1 *= 0.125f; s2 *= 0.125f; S1[w][j] = s1; S2[w][j] = s2; m1 = fmaxf(m1, s1); m2 = fmaxf(m2, s2); }
    m1 = wave_max(m1); m2 = wave_max(m2); float e1 = 0.f, e2 = 0.f;
    for (int j = lane; j < nk; j += 64) { const float p1 = expf(S1[w][j] - m1), p2 = expf(S2[w][j] - m2); S1[w][j] = p1; S2[w][j] = p2; e1 += p1; e2 += p2; }
    e1 = wave_sum(e1); e2 = wave_sum(e2); const float i1 = 1.f / e1, i2 = lam / e2;
    __syncthreads();
    float o0 = 0.f, o1 = 0.f;
    for (int j = 0; j < nk; ++j) { const float a = S1[w][j] * i1 - S2[w][j] * i2; const bf16_t* vp = Z + (size_t)keyrow(isc, b, j) * ZLD + Z_V + h * 128; o0 += a * bf2f(vp[lane]); o1 += a * bf2f(vp[64 + lane]); }
    const float ss = wave_sum(o0 * o0 + o1 * o1), rs = 1.0f / sqrtf(ss / 128.f + EPS);
    bf16_t* mp = MIX + (size_t)r * D + 512 + h * 128; mp[lane] = f2bf(o0 * rs * subg[lane] * (1.f - lam_init)); mp[64 + lane] = f2bf(o1 * rs * subg[64 + lane] * (1.f - lam_init));
}
__global__ __launch_bounds__(128) void k_attn_mla(const bf16_t* __restrict__ QM, const bf16_t* __restrict__ KN, const bf16_t* __restrict__ KR, const bf16_t* __restrict__ VM, bf16_t* __restrict__ MIX) {
    __shared__ float S1[2][NKMAX], Q[2][192];
    const int w = threadIdx.x >> 6, lane = threadIdx.x & 63; const int item = blockIdx.x * 2 + w; const int h = item & 3, r = item >> 2;
    int b, t, L, isc; rowinfo(r, b, t, L, isc); const int nk = isc ? CTX : SEQ + CTX;
    for (int d = lane; d < 192; d += 64) Q[w][d] = bf2f(QM[(size_t)r * 768 + h * 192 + d]);
    __syncthreads();
    const float scale = 0.07216878364870322f; float m1 = -1e30f;
    for (int j0 = 0; j0 < nk; j0 += 64) { const int j = j0 + lane, kr = keyrow(isc, b, j); const bf16_t* kp = KN + (size_t)kr * 512 + h * 128; const bf16_t* krp = KR + (size_t)kr * 64; float s1 = 0.f;
        for (int d = 0; d < 128; ++d) s1 += Q[w][d] * bf2f(kp[d]);
        for (int d = 0; d < 64; ++d) s1 += Q[w][128 + d] * bf2f(krp[d]);
        s1 *= scale; S1[w][j] = s1; m1 = fmaxf(m1, s1); }
    m1 = wave_max(m1); float e1 = 0.f;
    for (int j = lane; j < nk; j += 64) { const float p1 = expf(S1[w][j] - m1); S1[w][j] = p1; e1 += p1; }
    e1 = wave_sum(e1); const float i1 = 1.f / e1;
    __syncthreads();
    float o0 = 0.f, o1 = 0.f;
    for (int j = 0; j < nk; ++j) { const float a = S1[w][j] * i1; const bf16_t* vp = VM + (size_t)keyrow(isc, b, j) * 512 + h * 128; o0 += a * bf2f(vp[lane]); o1 += a * bf2f(vp[64 + lane]); }
    bf16_t* mp = MIX + (size_t)r * D + 1024 + h * 128; mp[lane] = f2bf(o0); mp[64 + lane] = f2bf(o1);
}
}

static void launch_phases(const Params& base, int lo, int hi, int mask, hipStream_t stream) {
    Params p = base; p.ph_lo = lo; p.ph_hi = hi; p.mask = mask;
    hipLaunchKernelGGL(mk_fwd, dim3(256), dim3(NTHR), LDS_BYTES, stream, p);
}
extern "C" void kernel_launch(void* const* d_in, const int* in_sizes, int n_in, void* d_out, int out_size, void* d_ws, size_t ws_size, hipStream_t stream) {
    static int ok = 0;
    if (ok == 0) {
        if (n_in != 24 || ws_size < WS_END) { fprintf(stderr, "kernel_launch: bad args n_in %d ws %zu (need %zu)\n", n_in, ws_size, (size_t)WS_END); ok = -1; return; }
        if (hipFuncSetAttribute((const void*)mk_fwd, hipFuncAttributeMaxDynamicSharedMemorySize, LDS_BYTES) != hipSuccess) { fprintf(stderr, "hipFuncSetAttribute failed\n"); ok = -1; return; }
        ok = 1;
    }
    if (ok < 0) return;
    unsigned char* ws = (unsigned char*)d_ws;
    (void)hipMemsetAsync(ws + WS_CTL, 0, CTL_BYTES, stream);
    Params P{};
    for (int i = 0; i < 24; ++i) P.in[i] = (const float*)d_in[i];
    P.out = (float*)d_out; P.ws = ws;
    bf16_t* H = (bf16_t*)(ws + WS_H); bf16_t* Z = (bf16_t*)(ws + WS_Z); bf16_t* QM = (bf16_t*)(ws + WS_QM); bf16_t* KN = (bf16_t*)(ws + WS_KN); bf16_t* VM = (bf16_t*)(ws + WS_VM); bf16_t* KR = (bf16_t*)(ws + WS_KR);
    bf16_t* MIX = (bf16_t*)(ws + WS_MIX); float* Y = (float*)(ws + WS_Y); bf16_t* U = (bf16_t*)(ws + WS_U); bf16_t* ACT = (bf16_t*)(ws + WS_ACT);
    const float2* cs = (const float2*)(ws + WS_CS);
    launch_phases(P, PH_PRO, PH_PRO + 1, 0, stream);
    launch_phases(P, PH_ROWA, PH_ROWA + 1, 0, stream);
    for (int l = 0; l < 2; ++l) {
        const int pb = PH_L0 + l * PH_PER_LAYER; const bool last = (l == 1); const int nr = last ? RX : R;
        const float lam_init = (float)(0.8 - 0.6 * exp(-0.3 * l));
        float* rsq = (float*)(ws + WS_RSQ) + (size_t)l * R * 2;
        const bf16_t* WIN = (const bf16_t*)(ws + WS_WIN) + (size_t)l * ZLD * D; const bf16_t* WOUT = (const bf16_t*)(ws + WS_WOUT) + (size_t)l * D * D;
        const bf16_t* WUP = (const bf16_t*)(ws + WS_WUP) + (size_t)l * UFF * D; const bf16_t* WDOWN = (const bf16_t*)(ws + WS_WDOWN) + (size_t)l * D * DFF;
        const bf16_t* WUQ = (const bf16_t*)(ws + WS_WUQ) + (size_t)l * 768 * 384; const bf16_t* WUKV = (const bf16_t*)(ws + WS_WUKV) + (size_t)l * 1024 * 256;
        const bf16_t* PW = (const bf16_t*)(ws + WS_POOLW) + (size_t)l * 4 * 128 * 128;
        hipLaunchKernelGGL(slow::k_sgemm<slow::EpiZ>, dim3(ZLD / 64, R / 64), dim3(256), 0, stream, H, D, WIN, D, D, slow::EpiZ{Z});
        hipLaunchKernelGGL(slow::k_rsq, dim3(R / 4), dim3(256), 0, stream, Z, rsq);
        hipLaunchKernelGGL(slow::k_sgemm<slow::EpiQ>, dim3(768 / 64, R / 64), dim3(256), 0, stream, Z + Z_CQ, ZLD, WUQ, 384, 384, slow::EpiQ{QM, rsq});
        hipLaunchKernelGGL(slow::k_rope_qm, dim3(RX * 128 / 256), dim3(256), 0, stream, QM, cs);
        hipLaunchKernelGGL(slow::k_sgemm<slow::EpiKV>, dim3(1024 / 64, R / 64), dim3(256), 0, stream, Z + Z_CKV, ZLD, WUKV, 256, 256, slow::EpiKV{KN, VM, rsq});
        launch_phases(P, pb + PHL_PRE, pb + PHL_PRE + 1, 2 | 8, stream);
        hipLaunchKernelGGL(slow::k_pooled, dim3(R * 512 / 256), dim3(256), 0, stream, Z, ACT);
        for (int g = 0; g < 4; ++g)
            hipLaunchKernelGGL(slow::k_sgemm<slow::EpiPool>, dim3(2, R / 64), dim3(256), 0, stream, ACT + g * 128, 512, PW + (size_t)g * 128 * 128, 128, 128, slow::EpiPool{MIX, g});
        hipLaunchKernelGGL(slow::k_attn_diff, dim3(nr * 4 / 2), dim3(128), 0, stream, Z, P.in[IN_DIFFLAM] + l * 256, P.in[IN_SUBLN] + l * 128, lam_init, MIX);
        hipLaunchKernelGGL(slow::k_attn_mla, dim3(nr * 4 / 2), dim3(128), 0, stream, QM, KN, KR, VM, MIX);
        hipLaunchKernelGGL(slow::k_sgemm<slow::EpiY>, dim3(D / 64, nr / 64), dim3(256), 0, stream, MIX, D, WOUT, D, D, slow::EpiY{Y});
        launch_phases(P, pb + PHL_ROWB, pb + PHL_ROWB + 1, 0, stream);
        hipLaunchKernelGGL(slow::k_sgemm<slow::EpiU>, dim3(UFF / 64, nr / 64), dim3(256), 0, stream, H, D, WUP, D, D, slow::EpiU{U});
        launch_phases(P, pb + PHL_ACT, pb + PHL_ACT + 1, 0, stream);
        hipLaunchKernelGGL(slow::k_sgemm<slow::EpiY>, dim3(D / 64, nr / 64), dim3(256), 0, stream, ACT, DFF, WDOWN, DFF, DFF, slow::EpiY{Y});
        launch_phases(P, pb + PHL_ROWC, pb + PHL_ROWC + 1, 0, stream);
    }
}
```

```cpp
#include <hip/hip_runtime.h>
#include <hip/hip_cooperative_groups.h>
#include <cstdint>
#include <cstdio>
#include <cmath>
namespace cg = cooperative_groups;

#define LAS __attribute__((address_space(3)))
typedef unsigned short bf16_t;
typedef short bf16x8 __attribute__((ext_vector_type(8)));
typedef short s16x4 __attribute__((ext_vector_type(4)));
typedef float f32x4 __attribute__((ext_vector_type(4)));
typedef float f32x2 __attribute__((ext_vector_type(2)));
typedef float f32x16 __attribute__((ext_vector_type(16)));
typedef unsigned u32x4 __attribute__((ext_vector_type(4)));
typedef unsigned u32x2 __attribute__((ext_vector_type(2)));

constexpr int D = 2048, NB = 4, SEQ = 2048, CTX = 256, GRIDW = 64;
constexpr int RX = NB * SEQ, RC = NB * CTX, R = RX + RC;
constexpr int INC = 4288, ZLD = 4352, DFF = 5632, UFF = 2 * DFF, MODW = 6 * D;
constexpr float EPS = 1e-6f;
constexpr int Z_POOL = 0, Z_Q = 512, Z_K = 1024, Z_V = 1536, Z_CQ = 2048, Z_CKV = 2432, Z_KR = 2688, Z_GB = 2752, Z_GC = 3264, Z_H = 3776;
constexpr int NWAVES = 8, NTHR = 512;

constexpr size_t MiB = 1u << 20;
constexpr size_t WS_CTL = 0, CTL_BYTES = 1 * MiB;
constexpr size_t WS_RSQ = 64 * 1024;
constexpr size_t WS_MOD = 1 * MiB;
constexpr size_t WS_CS = 2 * MiB;
constexpr size_t WS_POOLW = 3 * MiB;
constexpr size_t WS_WUQ = 4 * MiB;
constexpr size_t WS_WUKV = 6 * MiB;
constexpr size_t WS_WIN = 8 * MiB;
constexpr size_t WS_WOUT = 42 * MiB;
constexpr size_t WS_WUP = 58 * MiB;
constexpr size_t WS_WDOWN = 146 * MiB;
constexpr size_t WS_XR = 190 * MiB;
constexpr size_t WS_H = 262 * MiB;
constexpr size_t WS_BIG = 298 * MiB;
constexpr size_t WS_Z = WS_BIG;
constexpr size_t WS_QM = WS_BIG + 77 * MiB;
constexpr size_t WS_KN = WS_BIG + 91 * MiB;
constexpr size_t WS_VM = WS_BIG + 100 * MiB;
constexpr size_t WS_KR = WS_BIG + 109 * MiB;
constexpr size_t WS_MIX = WS_BIG + 111 * MiB;
constexpr size_t WS_Y = WS_BIG + 147 * MiB;
constexpr size_t WS_U = WS_BIG;
constexpr size_t WS_ACT = WS_BIG + 219 * MiB;
constexpr size_t WS_O1 = WS_ACT + 99 * MiB;
constexpr size_t WS_END = WS_O1 + 32 * MiB;
static_assert(WS_U + (size_t)R * UFF * 2 <= WS_ACT, "U overlay");
static_assert(WS_RSQ + (size_t)2 * R * 2 * 4 <= CTL_BYTES, "rsq in ctl");

struct Params {
    const float* in[24];
    float* out;
    unsigned char* ws;
    int ph_lo, ph_hi;
    int mask, pad;
};
typedef const __attribute__((address_space(4))) Params* KP;
enum { IN_X = 0, IN_C, IN_CTX, IN_CCTX, IN_ADAW, IN_ADAB, IN_GPREMIX, IN_GPOSTMIX, IN_GPREFFN, IN_GPOSTFFN, IN_WIN, IN_POOLW, IN_POOLSCALE, IN_DIFFLAM, IN_SUBLN,
       IN_GQ, IN_WUQ, IN_GKV, IN_WUKV, IN_CONVW, IN_WOUT, IN_WUP, IN_FFNCONVW, IN_WDOWN };
enum { PH_PRO = 0, PH_ROWA = 1, PH_L0 = 2, PHL_WIN = 0, PHL_PRE = 1, PHL_ATTN = 2, PHL_WOUT = 3, PHL_ROWB = 4, PHL_UP = 5, PHL_ACT = 6, PHL_DOWN = 7, PHL_ROWC = 8, PH_PER_LAYER = 9, PH_TOTAL = 2 + 2 * 9 };

__device__ __forceinline__ void rowinfo(int r, int& b, int& t, int& L, int& isc) {
    if (r < RX) { b = r / SEQ; t = r % SEQ; L = SEQ; isc = 0; } else { const int rc = r - RX; b = rc / CTX; t = rc % CTX; L = CTX; isc = 1; }
}
__device__ __forceinline__ float wave_sum(float v) {
#pragma unroll
    for (int o = 1; o < 64; o <<= 1) v += __shfl_xor(v, o);
    return v;
}
__device__ __forceinline__ float wave_max(float v) {
#pragma unroll
    for (int o = 1; o < 64; o <<= 1) v = fmaxf(v, __shfl_xor(v, o));
    return v;
}
__device__ __forceinline__ float sx(float v, int o, int lane) { return __int_as_float(__builtin_amdgcn_ds_bpermute((lane ^ o) << 2, __float_as_int(v))); }
__device__ __forceinline__ float wsum(float v, int lane) {
#pragma unroll
    for (int o = 1; o < 64; o <<= 1) v += sx(v, o, lane);
    return v;
}
typedef __bf16 bf16x2_t __attribute__((ext_vector_type(2)));
__device__ __forceinline__ unsigned cvt_pk_bf16(float lo, float hi) { const f32x2 v = {lo, hi}; const bf16x2_t b = __builtin_convertvector(v, bf16x2_t); return __builtin_bit_cast(unsigned, b); }
__device__ __forceinline__ bf16_t f2bf(float f) { return (bf16_t)(cvt_pk_bf16(f, 0.f) & 0xffffu); }
__device__ __forceinline__ float bf2f(bf16_t h) { return __uint_as_float(((unsigned)h) << 16); }
__device__ __forceinline__ void unpack8(const u32x4 w, float* f) {
    f[0] = __uint_as_float(w.x << 16); f[1] = __uint_as_float(w.x & 0xffff0000u); f[2] = __uint_as_float(w.y << 16); f[3] = __uint_as_float(w.y & 0xffff0000u);
    f[4] = __uint_as_float(w.z << 16); f[5] = __uint_as_float(w.z & 0xffff0000u); f[6] = __uint_as_float(w.w << 16); f[7] = __uint_as_float(w.w & 0xffff0000u);
}
__device__ __forceinline__ u32x4 pack8(const float* f) { u32x4 w; w.x = cvt_pk_bf16(f[0], f[1]); w.y = cvt_pk_bf16(f[2], f[3]); w.z = cvt_pk_bf16(f[4], f[5]); w.w = cvt_pk_bf16(f[6], f[7]); return w; }
__device__ __forceinline__ u32x4 ld16(const bf16_t* p) { return *(const u32x4*)p; }
__device__ __forceinline__ void st16(bf16_t* p, u32x4 v) { *(u32x4*)p = v; }

__host__ __device__ __forceinline__ int uq_pos(int n) { const int h = n / 192, j = n % 192; if (j < 128) return (h >> 1) * 256 + (h & 1) * 128 + j; const int jj = j - 128; return jj < 32 ? 512 + h * 32 + jj : 640 + h * 32 + (jj - 32); }

template <int MAP>
__device__ __forceinline__ void tr_item(const float* __restrict__ W, int K, int N, bf16_t* __restrict__ WT, int ldt, const float* __restrict__ ks, const float* __restrict__ ns, LAS float* scr, int item, int lane) {
    const int nblk = N / 32, kb = item / nblk, nb = item % nblk, k0 = 64 * kb, n0 = 32 * nb;
    const float nsv = ns ? ns[n0 + (lane & 31)] : 1.f;
#pragma unroll 8
    for (int i = 0; i < 32; ++i) { const int kk = 2 * i + (lane >> 5); float v = W[(size_t)(k0 + kk) * N + n0 + (lane & 31)]; if (ks) v *= ks[k0 + kk]; scr[kk * 33 + (lane & 31)] = v * nsv; }
    asm volatile("s_waitcnt lgkmcnt(0)" ::: "memory");
    const int c = lane & 7;
#pragma unroll
    for (int j = 0; j < 4; ++j) { const int n = (lane >> 3) + 8 * j; const LAS float* s = scr + (8 * c) * 33 + n;
        u32x4 o; o.x = cvt_pk_bf16(s[0 * 33], s[1 * 33]); o.y = cvt_pk_bf16(s[2 * 33], s[3 * 33]); o.z = cvt_pk_bf16(s[4 * 33], s[5 * 33]); o.w = cvt_pk_bf16(s[6 * 33], s[7 * 33]);
        const int nn = n0 + n; const int dst = (MAP == 1) ? uq_pos(nn) : nn;
        *(u32x4*)(WT + (size_t)dst * ldt + k0 + 8 * c) = o; }
    asm volatile("s_waitcnt lgkmcnt(0)" ::: "memory");
}

__device__ __forceinline__ void phase_prologue(KP kp, unsigned char* ws, int tid_, LAS unsigned char* lds, int vcu, int G) {
    const int tid = tid_, lane = tid & 63, wave = tid >> 6;
    {
        LAS float* red = (LAS float*)lds;
        float* MOD = (float*)(ws + WS_MOD);
        for (int cb = vcu; cb < 256; cb += G) {
            const int gn0 = cb * 96, l = gn0 / MODW, n0 = gn0 % MODW;
            if (tid < 384) {
                const int cq = tid % 24, kg = tid / 24;
                const float* w = kp->in[IN_ADAW] + ((size_t)l * D + kg * 128) * MODW + n0 + cq * 4;
                f32x4 acc[5];
#pragma unroll
                for (int i = 0; i < 5; ++i) acc[i] = (f32x4){0.f, 0.f, 0.f, 0.f};
#pragma unroll 4
                for (int k = 0; k < 128; ++k) { const f32x4 wv = *(const f32x4*)(w + (size_t)k * MODW); const int kk = kg * 128 + k;
#pragma unroll
                    for (int i = 0; i < 5; ++i) { const float v = (i < 4) ? kp->in[IN_C][i * D + kk] : kp->in[IN_CCTX][kk]; const float s = v / (1.f + __expf(-v)); acc[i] += wv * s; } }
#pragma unroll
                for (int i = 0; i < 5; ++i)
#pragma unroll
                    for (int e = 0; e < 4; ++e) red[(kg * 5 + i) * 96 + cq * 4 + e] = acc[i][e];
            }
            __syncthreads();
            if (tid < 480) { const int i = tid / 96, cn = tid % 96; float s = kp->in[IN_ADAB][l * MODW + n0 + cn];
#pragma unroll
                for (int kg = 0; kg < 16; ++kg) s += red[(kg * 5 + i) * 96 + cn];
                MOD[((size_t)l * 5 + i) * MODW + n0 + cn] = s; }
            __syncthreads();
        }
    }
    {
        float2* cs = (float2*)(ws + WS_CS);
        for (int idx = vcu * NTHR + tid; idx < SEQ * 32; idx += G * NTHR) {
            const int t = idx / 32, i = idx % 32, f = i & 15;
            const float base = ((f & 3) == 0) ? 1.0f : ((f & 3) == 1) ? 0.5623413251903491f : ((f & 3) == 2) ? 0.31622776601683794f : 0.1778279410038923f;
            const float dec = ((f >> 2) == 0) ? 1.0f : ((f >> 2) == 1) ? 0.1f : ((f >> 2) == 2) ? 0.01f : 0.001f;
            const float pos = (i < 16) ? (float)(t / GRIDW) : (float)(t % GRIDW);
            const float ang = pos * (base * dec);
            cs[idx] = make_float2(__cosf(ang), __sinf(ang));
        }
    }
    {
        for (int idx = vcu * NTHR + tid; idx < 2 * 64 * 256; idx += G * NTHR) { const int l = idx / (64 * 256), rem = idx % (64 * 256), row = INC + rem / 256, ch = rem % 256;
            *(u32x4*)((bf16_t*)(ws + WS_WIN) + ((size_t)l * ZLD + row) * D + ch * 8) = (u32x4){0u, 0u, 0u, 0u}; }
    }
    {
        LAS float* scr = (LAS float*)(lds + 32768) + wave * (64 * 33);
        constexpr int I_IN = 32 * 134, I_OUT = 32 * 64, I_UP = 32 * 352, I_DOWN = 88 * 64, I_UQ = 6 * 24, I_UKV = 4 * 32, I_POOL = 4 * 8;
        constexpr int I_LAYER = I_IN + I_OUT + I_UP + I_DOWN + I_UQ + I_UKV + I_POOL;
        const int gw = vcu * NWAVES + wave, NGW = G * NWAVES;
        for (int it = gw; it < 2 * I_LAYER; it += NGW) {
            const int l = it / I_LAYER; int r = it % I_LAYER;
            if (r < I_IN) { tr_item<0>(kp->in[IN_WIN] + (size_t)l * D * INC, D, INC, (bf16_t*)(ws + WS_WIN) + (size_t)l * ZLD * D, D, nullptr, nullptr, scr, r, lane); continue; } r -= I_IN;
            if (r < I_OUT) { tr_item<0>(kp->in[IN_WOUT] + (size_t)l * D * D, D, D, (bf16_t*)(ws + WS_WOUT) + (size_t)l * D * D, D, nullptr, nullptr, scr, r, lane); continue; } r -= I_OUT;
            if (r < I_UP) { tr_item<0>(kp->in[IN_WUP] + (size_t)l * D * UFF, D, UFF, (bf16_t*)(ws + WS_WUP) + (size_t)l * UFF * D, D, nullptr, nullptr, scr, r, lane); continue; } r -= I_UP;
            if (r < I_DOWN) { tr_item<0>(kp->in[IN_WDOWN] + (size_t)l * DFF * D, DFF, D, (bf16_t*)(ws + WS_WDOWN) + (size_t)l * D * DFF, DFF, nullptr, nullptr, scr, r, lane); continue; } r -= I_DOWN;
            if (r < I_UQ) { tr_item<1>(kp->in[IN_WUQ] + (size_t)l * 384 * 768, 384, 768, (bf16_t*)(ws + WS_WUQ) + (size_t)l * 768 * 384, 384, kp->in[IN_GQ] + l * 384, nullptr, scr, r, lane); continue; } r -= I_UQ;
            if (r < I_UKV) { tr_item<0>(kp->in[IN_WUKV] + (size_t)l * 256 * 1024, 256, 1024, (bf16_t*)(ws + WS_WUKV) + (size_t)l * 1024 * 256, 256, kp->in[IN_GKV] + l * 256, nullptr, scr, r, lane); continue; } r -= I_UKV;
            { const int g = r / 8, rr = r % 8;
              tr_item<0>(kp->in[IN_POOLW] + ((size_t)l * 4 + g) * 128 * 128, 128, 128, (bf16_t*)(ws + WS_POOLW) + ((size_t)l * 4 + g) * 128 * 128, 128, nullptr, kp->in[IN_POOLSCALE] + l * 512 + g * 128, scr, rr, lane); }
        }
    }
}

__device__ __forceinline__ void rowpass_row(const float* __restrict__ xin, const float* __restrict__ y, const float* __restrict__ ygain, const float* __restrict__ gate, float* __restrict__ xout,
                                            const float* __restrict__ ngain, const float* __restrict__ shift, const float* __restrict__ scale, bf16_t* __restrict__ hout, int lane) {
    f32x4 xv[8];
#pragma unroll
    for (int j = 0; j < 8; ++j) xv[j] = *(const f32x4*)(xin + j * 256 + lane * 4);
    if (y) {
        f32x4 yv[8]; float ss = 0.f;
#pragma unroll
        for (int j = 0; j < 8; ++j) { yv[j] = *(const f32x4*)(y + j * 256 + lane * 4); ss += (yv[j].x * yv[j].x + yv[j].y * yv[j].y) + (yv[j].z * yv[j].z + yv[j].w * yv[j].w); }
        ss = wsum(ss, lane); const float rs = 1.0f / sqrtf(ss * (1.f / D) + EPS);
#pragma unroll
        for (int j = 0; j < 8; ++j) { const f32x4 gg = *(const f32x4*)(gate + j * 256 + lane * 4), yg = *(const f32x4*)(ygain + j * 256 + lane * 4); xv[j] += gg * (yv[j] * rs * yg); }
    }
    if (xout) {
#pragma unroll
        for (int j = 0; j < 8; ++j) *(f32x4*)(xout + j * 256 + lane * 4) = xv[j];
    }
    if (hout) {
        float ss = 0.f;
#pragma unroll
        for (int j = 0; j < 8; ++j) ss += (xv[j].x * xv[j].x + xv[j].y * xv[j].y) + (xv[j].z * xv[j].z + xv[j].w * xv[j].w);
        ss = wsum(ss, lane); const float rs = 1.0f / sqrtf(ss * (1.f / D) + EPS);
#pragma unroll
        for (int j = 0; j < 8; ++j) { const f32x4 ng = *(const f32x4*)(ngain + j * 256 + lane * 4), sc = *(const f32x4*)(scale + j * 256 + lane * 4), sh = *(const f32x4*)(shift + j * 256 + lane * 4);
            const f32x4 o = (xv[j] * rs * ng) * (sc + 1.f) + sh; u32x2 w; w.x = cvt_pk_bf16(o.x, o.y); w.y = cvt_pk_bf16(o.z, o.w);
            *(u32x2*)(hout + j * 256 + lane * 4) = w; }
    }
}
__device__ __forceinline__ void phase_rowpass(KP kp, unsigned char* ws, int tid_, int kind, int l, int vcu, int G) {
    const int lane = tid_ & 63, wave = tid_ >> 6;
    const float* MOD = (const float*)(ws + WS_MOD);
    float* XR = (float*)(ws + WS_XR); const float* Y = (const float*)(ws + WS_Y); bf16_t* H = (bf16_t*)(ws + WS_H);
    const bool last = (l == 1);
    const int nrows = (kind == 0) ? R : (last ? RX : R);
    for (int r = vcu * NWAVES + wave; r < nrows; r += G * NWAVES) {
        int b, t, L, isc; rowinfo(r, b, t, L, isc); const int mi = isc ? 4 : b;
        const float* m = MOD + ((size_t)l * 5 + mi) * MODW;
        const float* xin0 = isc ? kp->in[IN_CTX] + (size_t)(r - RX) * D : kp->in[IN_X] + (size_t)r * D;
        if (kind == 0) {
            rowpass_row(xin0, nullptr, nullptr, nullptr, nullptr, kp->in[IN_GPREMIX], m + 0 * D, m + 1 * D, H + (size_t)r * D, lane);
        } else if (kind == 1) {
            const float* xin = (l == 0) ? xin0 : XR + (size_t)r * D;
            rowpass_row(xin, Y + (size_t)r * D, kp->in[IN_GPOSTMIX] + l * D, m + 2 * D, XR + (size_t)r * D, kp->in[IN_GPREFFN] + l * D, m + 3 * D, m + 4 * D, H + (size_t)r * D, lane);
        } else {
            if (!last) { const float* m1 = MOD + ((size_t)1 * 5 + mi) * MODW;
                rowpass_row(XR + (size_t)r * D, Y + (size_t)r * D, kp->in[IN_GPOSTFFN] + l * D, m + 5 * D, XR + (size_t)r * D, kp->in[IN_GPREMIX] + 1 * D, m1 + 0 * D, m1 + 1 * D, H + (size_t)r * D, lane);
            } else {
                rowpass_row(XR + (size_t)r * D, Y + (size_t)r * D, kp->in[IN_GPOSTFFN] + l * D, m + 5 * D, kp->out + (size_t)r * D, nullptr, nullptr, nullptr, nullptr, lane);
            }
        }
    }
}

__device__ __forceinline__ void pre_rope(KP kp, unsigned char* ws, int tid_, int vcu, int G) {
    bf16_t* Z = (bf16_t*)(ws + WS_Z); bf16_t* KR = (bf16_t*)(ws + WS_KR); const float2* cs = (const float2*)(ws + WS_CS);
    const int gt = vcu * NTHR + tid_, NGT = G * NTHR;
    for (int idx = gt; idx < RX * 68; idx += NGT) {
        const int ic = idx & 3, v = (idx >> 2) % 17, r = idx / 68, t = r % SEQ;
        const int col = (v < 16) ? Z_Q + v * 64 : Z_KR;
        const bf16_t* src = Z + (size_t)r * ZLD + col + ic * 8;
        float x1[8], x2[8], o1[8], o2[8]; unpack8(ld16(src), x1); unpack8(ld16(src + 32), x2);
        const f32x4* cp = (const f32x4*)(cs + t * 32 + ic * 8);
#pragma unroll
        for (int q = 0; q < 4; ++q) { const f32x4 c2 = cp[q];
            o1[2 * q] = x1[2 * q] * c2.x - x2[2 * q] * c2.y; o2[2 * q] = x1[2 * q] * c2.y + x2[2 * q] * c2.x;
            o1[2 * q + 1] = x1[2 * q + 1] * c2.z - x2[2 * q + 1] * c2.w; o2[2 * q + 1] = x1[2 * q + 1] * c2.w + x2[2 * q + 1] * c2.z; }
        bf16_t* dst = (v < 16) ? Z + (size_t)r * ZLD + col + ic * 8 : KR + (size_t)r * 64 + ic * 8;
        st16(dst, pack8(o1)); st16(dst + 32, pack8(o2));
    }
    for (int idx = gt; idx < RC * 8; idx += NGT) { const int r = RX + idx / 8, ch = idx % 8; st16(KR + (size_t)r * 64 + ch * 8, ld16(Z + (size_t)r * ZLD + Z_KR + ch * 8)); }
}
__device__ __forceinline__ void pre_conv(KP kp, unsigned char* ws, int tid_, int l, int vcu, int G) {
    const bf16_t* Z = (const bf16_t*)(ws + WS_Z); bf16_t* MIX = (bf16_t*)(ws + WS_MIX);
    const float* cw = kp->in[IN_CONVW] + (size_t)l * 3 * 512;
    const int gt = vcu * NTHR + tid_, NGT = G * NTHR;
    for (int idx = gt; idx < R * 64; idx += NGT) {
        const int ch = idx & 63, r = idx >> 6, c0 = ch * 8; int b, t, L, isc; rowinfo(r, b, t, L, isc);
        float s[8];
#pragma unroll
        for (int e = 0; e < 8; ++e) s[e] = 0.f;
#pragma unroll
        for (int k = 0; k < 3; ++k) { const int tt = t + k - 1;
            if (tt >= 0 && tt < L) { const bf16_t* zr = Z + (size_t)(r + k - 1) * ZLD; float gc[8], hh[8]; unpack8(ld16(zr + Z_GC + c0), gc); unpack8(ld16(zr + Z_H + c0), hh);
                const f32x4 w0 = *(const f32x4*)(cw + k * 512 + c0), w1 = *(const f32x4*)(cw + k * 512 + c0 + 4);
                s[0] += w0.x * gc[0] * hh[0]; s[1] += w0.y * gc[1] * hh[1]; s[2] += w0.z * gc[2] * hh[2]; s[3] += w0.w * gc[3] * hh[3];
                s[4] += w1.x * gc[4] * hh[4]; s[5] += w1.y * gc[5] * hh[5]; s[6] += w1.z * gc[6] * hh[6]; s[7] += w1.w * gc[7] * hh[7]; } }
        float gb[8]; unpack8(ld16(Z + (size_t)r * ZLD + Z_GB + c0), gb);
#pragma unroll
        for (int e = 0; e < 8; ++e) s[e] *= gb[e];
        st16(MIX + (size_t)r * D + 1536 + c0, pack8(s));
    }
}
__device__ __forceinline__ void pre_pool(KP kp, unsigned char* ws, int tid_, int l, int vcu, int G) {
    const bf16_t* Z = (const bf16_t*)(ws + WS_Z); bf16_t* MIX = (bf16_t*)(ws + WS_MIX);
    const bf16_t* PW = (const bf16_t*)(ws + WS_POOLW) + (size_t)l * 4 * 128 * 128;
    const int lane = tid_ & 63, wave = tid_ >> 6, fr = lane & 15, fq = lane >> 4;
    for (int item = vcu * NWAVES + wave; item < (R / 16) * 4; item += G * NWAVES) {
        const int g = item & 3, rt = item >> 2, r = rt * 16 + fr; int b, t, L, isc; rowinfo(r, b, t, L, isc);
        const int half = 1 << g; int lo = t - half; if (lo < 0) lo = 0; int hi = t + half; if (hi > L) hi = L;
        const float inv = 1.0f / (float)(hi - lo);
        float acc[4][8];
#pragma unroll
        for (int kk = 0; kk < 4; ++kk)
#pragma unroll
            for (int e = 0; e < 8; ++e) acc[kk][e] = 0.f;
        const bf16_t* zc = Z + Z_POOL + g * 128 + fq * 8;
        for (int tt = lo; tt < hi; ++tt) { const bf16_t* zr = zc + (size_t)(r - t + tt) * ZLD;
#pragma unroll
            for (int kk = 0; kk < 4; ++kk) { float v[8]; unpack8(ld16(zr + kk * 32), v);
#pragma unroll
                for (int e = 0; e < 8; ++e) acc[kk][e] += v[e]; } }
        bf16x8 a[4];
#pragma unroll
        for (int kk = 0; kk < 4; ++kk) { float v[8]; unpack8(ld16(zc + (size_t)r * ZLD + kk * 32), v);
#pragma unroll
            for (int e = 0; e < 8; ++e) v[e] = acc[kk][e] * inv - v[e];
            const u32x4 w = pack8(v); a[kk] = *(const bf16x8*)&w; }
        const bf16_t* pw = PW + (size_t)g * 128 * 128;
#pragma unroll
        for (int n = 0; n < 8; ++n) { f32x4 c = (f32x4){0.f, 0.f, 0.f, 0.f};
#pragma unroll
            for (int kk = 0; kk < 4; ++kk) { const u32x4 bw = ld16(pw + (size_t)(16 * n + fr) * 128 + kk * 32 + fq * 8); c = __builtin_amdgcn_mfma_f32_16x16x32_bf16(*(const bf16x8*)&bw, a[kk], c, 0, 0, 0); }
            u32x2 w; w.x = cvt_pk_bf16(c[0], c[1]); w.y = cvt_pk_bf16(c[2], c[3]);
            *(u32x2*)(MIX + (size_t)r * D + g * 128 + 16 * n + 4 * fq) = w; }
    }
}
__device__ __forceinline__ void phase_act(KP kp, unsigned char* ws, int tid_, int l, int vcu, int G) {
    const bf16_t* U = (const bf16_t*)(ws + WS_U); bf16_t* ACT = (bf16_t*)(ws + WS_ACT);
    const float* cw = kp->in[IN_FFNCONVW] + (size_t)l * 3 * UFF;
    const int nrows = (l == 1) ? RX : R;
    const int gt = vcu * NTHR + tid_, NGT = G * NTHR;
    for (int idx = gt; idx < (nrows / 16) * 704; idx += NGT) {
        const int chn = idx % 704, strip = idx / 704, r0 = strip * 16, j0 = chn * 8; int b, t0, L, isc; rowinfo(r0, b, t0, L, isc);
        float wg[3][8], wv[3][8];
#pragma unroll
        for (int k = 0; k < 3; ++k) { const f32x4 a0 = *(const f32x4*)(cw + k * UFF + j0), a1 = *(const f32x4*)(cw + k * UFF + j0 + 4), b0 = *(const f32x4*)(cw + k * UFF + DFF + j0), b1 = *(const f32x4*)(cw + k * UFF + DFF + j0 + 4);
            wg[k][0] = a0.x; wg[k][1] = a0.y; wg[k][2] = a0.z; wg[k][3] = a0.w; wg[k][4] = a1.x; wg[k][5] = a1.y; wg[k][6] = a1.z; wg[k][7] = a1.w;
            wv[k][0] = b0.x; wv[k][1] = b0.y; wv[k][2] = b0.z; wv[k][3] = b0.w; wv[k][4] = b1.x; wv[k][5] = b1.y; wv[k][6] = b1.z; wv[k][7] = b1.w; }
        float pg[8], pv[8], cg_[8], cv[8], ng[8], nv[8];
        const bf16_t* ub = U + (size_t)r0 * UFF + j0;
        if (t0 > 0) { unpack8(ld16(ub - UFF), pg); unpack8(ld16(ub - UFF + DFF), pv); } else {
#pragma unroll
            for (int e = 0; e < 8; ++e) { pg[e] = 0.f; pv[e] = 0.f; } }
        unpack8(ld16(ub), cg_); unpack8(ld16(ub + DFF), cv);
#pragma unroll 1
        for (int i = 0; i < 16; ++i) {
            if (t0 + i + 1 < L) { unpack8(ld16(ub + (size_t)(i + 1) * UFF), ng); unpack8(ld16(ub + (size_t)(i + 1) * UFF + DFF), nv); } else {
#pragma unroll
                for (int e = 0; e < 8; ++e) { ng[e] = 0.f; nv[e] = 0.f; } }
            float o[8];
#pragma unroll
            for (int e = 0; e < 8; ++e) { const float gsum = wg[0][e] * pg[e] + wg[1][e] * cg_[e] + wg[2][e] * ng[e]; const float vsum = wv[0][e] * pv[e] + wv[1][e] * cv[e] + wv[2][e] * nv[e];
                o[e] = gsum * __builtin_amdgcn_rcpf(1.f + __expf(-gsum)) * vsum; }
            st16(ACT + (size_t)(r0 + i) * DFF + j0, pack8(o));
#pragma unroll
            for (int e = 0; e < 8; ++e) { pg[e] = cg_[e]; pv[e] = cv[e]; cg_[e] = ng[e]; cv[e] = nv[e]; }
        }
    }
}


namespace pg8 {
constexpr int BM = 256, BK = 64, HALF = 128, HTB = HALF * BK * 2, STAGE_BYTES = 8 * HTB, NXCD = 8, WGM = 8;
__host__ __device__ __forceinline__ int lds_byte(int r, int c) { const int st = (r >> 4) * 2 + (c >> 5), rr = r & 15, cc = c & 31, ob = rr * 64 + cc * 2; return st * 1024 + (ob ^ (((ob >> 9) & 1) << 5)); }
__host__ __device__ __forceinline__ void stage_rc(int b, int& R_, int& C_) { const int st = b / 1024, sb = b % 1024, swz = sb ^ (((sb >> 9) & 1) << 5); R_ = (st >> 1) * 16 + swz / 64; C_ = (st & 1) * 32 + (swz % 64) / 2; }
__host__ __device__ __forceinline__ int perm32(int rho) { const int n = rho >> 4, i = rho & 15; return 8 * (i >> 2) + 4 * n + (i & 3); }
struct Unit { int pm, pn; };
struct Gemm { const bf16_t* A; const bf16_t* Bt; int lda, ldb, K; };
struct TileOrder {
    int nM, nN, nwg, G, c;
    __device__ void init(int nM_, int nN_, int G_, int c_) { nM = nM_; nN = nN_; nwg = nM * nN; G = G_; c = c_; }
    __device__ bool next(int i, Unit& u) const {
        const long L = (long)i * G + c; if (L >= nwg) return false;
        int wgid = (int)L; { const int q = nwg / NXCD, r = nwg % NXCD, xcd = wgid % NXCD, off = wgid / NXCD; wgid = (xcd < r ? xcd * (q + 1) : r * (q + 1) + (xcd - r) * q) + off; }
        const int nig = WGM * nN, gid = wgid / nig, fm = gid * WGM, gsz = (nM - fm) < WGM ? (nM - fm) : WGM;
        u.pm = fm + ((wgid % nig) % gsz); u.pn = (wgid % nig) / gsz; return true;
    }
};
typedef f32x4 Acc[2][2][4][2];
template <class Epi, class Sched, bool ALIGN_EPI>
__device__ __forceinline__ void gemm_phase(LAS unsigned char* lds, const Gemm g, const Sched& S, const Epi& E, int tid) {
    const int wid = __builtin_amdgcn_readfirstlane(tid >> 6), lane = tid & 63, wr = wid >> 2, wc = wid & 3, fr = lane & 15, fq = lane >> 4;
    const int nt = g.K / BK;
    unsigned voffA[2], voffB[2];
#pragma unroll
    for (int i = 0; i < 2; ++i) { int R_, C_; stage_rc(tid * 16 + i * 8192, R_, C_); const int Rb = Epi::PERM ? ((R_ & ~31) + perm32(R_ & 31)) : R_;
        voffA[i] = (unsigned)(R_ * g.lda + C_) * 2u; voffB[i] = (unsigned)(Rb * g.ldb + C_) * 2u; }
    const size_t kstep = (size_t)(BK * 2);
    const size_t hstepA = (size_t)HALF * g.lda * 2, hstepB = (size_t)HALF * g.ldb * 2;
    const size_t tstepA = 2 * hstepA, tstepB = 2 * hstepB;
    const unsigned ldsw = (unsigned)wid * 1024u;
    const int aoff = lds_byte(wr * 64 + fr, fq * 8), boff = lds_byte(wc * 32 + fr, fq * 8);
#define PG8_SA(b, h) (((b) * 2 + (h)) * HTB)
#define PG8_SB(b, h) ((4 + (b) * 2 + (h)) * HTB)
#define PG8_STAGE(bufoff, gbase, voff) do { _Pragma("unroll") for (int _i = 0; _i < 2; ++_i) \
        __builtin_amdgcn_global_load_lds((const unsigned*)((const char*)(gbase) + (voff)[_i]), (LAS unsigned*)(lds + (bufoff) + ldsw + _i * 8192), 16, 0, 0); } while (0)
#define PG8_LDA(dst, b, h) do { _Pragma("unroll") for (int m = 0; m < 4; ++m) _Pragma("unroll") for (int k = 0; k < 2; ++k) dst[m][k] = *(const LAS bf16x8*)(lds + PG8_SA(b, h) + aoff + m * 2048 + k * 1024); } while (0)
#define PG8_LDB(dst, b, h) do { _Pragma("unroll") for (int n = 0; n < 2; ++n) _Pragma("unroll") for (int k = 0; k < 2; ++k) dst[n][k] = *(const LAS bf16x8*)(lds + PG8_SB(b, h) + boff + n * 2048 + k * 1024); } while (0)
#define PG8_MMA(ai, bj, At, Bt) do { __builtin_amdgcn_s_setprio(1); _Pragma("unroll") for (int m = 0; m < 4; ++m) _Pragma("unroll") for (int n = 0; n < 2; ++n) _Pragma("unroll") for (int k = 0; k < 2; ++k) \
        acc[ai][bj][m][n] = __builtin_amdgcn_mfma_f32_16x16x32_bf16(Bt[n][k], At[m][k], acc[ai][bj][m][n], 0, 0, 0); __builtin_amdgcn_s_setprio(0); } while (0)
#define PG8_WAIT_V(n) asm volatile("s_waitcnt vmcnt(" #n ")" ::: "memory")
#define PG8_WAIT_L(n) asm volatile("s_waitcnt lgkmcnt(" #n ")" ::: "memory")
#define PG8_BAR __builtin_amdgcn_s_barrier()
#define PG8_SCHED __builtin_amdgcn_sched_barrier(0)
    Unit cur, nxt; int ui = 0;
    if (!S.next(0, cur)) return;
    f32x4 acc[2][2][4][2];
#pragma unroll
    for (int a = 0; a < 2; ++a)
#pragma unroll
        for (int b = 0; b < 2; ++b)
#pragma unroll
            for (int m = 0; m < 4; ++m)
#pragma unroll
                for (int n = 0; n < 2; ++n) acc[a][b][m][n] = (f32x4){0.f, 0.f, 0.f, 0.f};
    bf16x8 At[4][2], B0[2][2], B1[2][2];
    const char* cA = (const char*)g.A + (size_t)cur.pm * tstepA; const char* cB = (const char*)g.Bt + (size_t)cur.pn * tstepB;
    PG8_STAGE(PG8_SB(0, 0), cB, voffB); PG8_STAGE(PG8_SB(0, 1), cB + hstepB, voffB); PG8_STAGE(PG8_SA(0, 0), cA, voffA); PG8_STAGE(PG8_SA(0, 1), cA + hstepA, voffA);
    if (wr == 1) PG8_BAR;
    PG8_WAIT_V(2); PG8_BAR;
    PG8_STAGE(PG8_SB(1, 0), cB + kstep, voffB); PG8_STAGE(PG8_SA(1, 0), cA + kstep, voffA); PG8_STAGE(PG8_SB(1, 1), cB + hstepB + kstep, voffB);
    PG8_WAIT_V(6); PG8_BAR;
    for (;;) {
        const bool has_next = S.next(ui + 1, nxt);
        const char* nA = has_next ? (const char*)g.A + (size_t)nxt.pm * tstepA : cA; const char* nB = has_next ? (const char*)g.Bt + (size_t)nxt.pn * tstepB : cB;
#pragma unroll 1
        for (int t = 0; t < nt; t += 2) {
            const bool last = (t == nt - 2);
            const char* a1 = cA + (size_t)(t + 1) * kstep;
            const char* a2 = last ? nA : cA + (size_t)(t + 2) * kstep; const char* b2 = last ? nB : cB + (size_t)(t + 2) * kstep;
            const char* a3 = a2 + kstep; const char* b3 = b2 + kstep;
            PG8_LDB(B0, 0, 0); PG8_LDB(B1, 0, 1); PG8_SCHED; PG8_LDA(At, 0, 0); PG8_STAGE(PG8_SA(1, 1), a1 + hstepA, voffA);
            PG8_WAIT_V(8); PG8_WAIT_L(0); PG8_BAR; PG8_MMA(0, 0, At, B0); PG8_MMA(0, 1, At, B1); PG8_BAR; PG8_SCHED;
            PG8_LDA(At, 0, 1); PG8_STAGE(PG8_SB(0, 0), b2, voffB); PG8_STAGE(PG8_SB(0, 1), b2 + hstepB, voffB); PG8_STAGE(PG8_SA(0, 0), a2, voffA);
            PG8_WAIT_V(8); PG8_WAIT_L(0); PG8_BAR; PG8_MMA(1, 0, At, B0); PG8_MMA(1, 1, At, B1); PG8_BAR; PG8_SCHED;
            PG8_LDB(B0, 1, 0); PG8_LDB(B1, 1, 1); PG8_SCHED; PG8_LDA(At, 1, 0); PG8_STAGE(PG8_SA(0, 1), a2 + hstepA, voffA);
            PG8_WAIT_V(8); PG8_WAIT_L(0); PG8_BAR; PG8_MMA(0, 0, At, B0); PG8_MMA(0, 1, At, B1); PG8_BAR; PG8_SCHED;
            PG8_LDA(At, 1, 1); PG8_STAGE(PG8_SB(1, 0), b3, voffB); PG8_STAGE(PG8_SB(1, 1), b3 + hstepB, voffB); PG8_STAGE(PG8_SA(1, 0), a3, voffA);
            PG8_WAIT_V(8); PG8_WAIT_L(0); PG8_BAR; PG8_MMA(1, 0, At, B0); PG8_MMA(1, 1, At, B1); PG8_BAR; PG8_SCHED;
        }
        if constexpr (ALIGN_EPI) { if (wr == 0) PG8_BAR; }
        E(acc, cur, wr, wc, fr, fq);
        if (!has_next) break;
#pragma unroll
        for (int a = 0; a < 2; ++a)
#pragma unroll
            for (int b = 0; b < 2; ++b)
#pragma unroll
                for (int m = 0; m < 4; ++m)
#pragma unroll
                    for (int n = 0; n < 2; ++n) acc[a][b][m][n] = (f32x4){0.f, 0.f, 0.f, 0.f};
        cur = nxt; cA = nA; cB = nB; ++ui;
        if constexpr (ALIGN_EPI) { if (wr == 1) PG8_BAR; }
    }
    PG8_WAIT_V(0);
    if constexpr (!ALIGN_EPI) { if (wr == 0) PG8_BAR; }
    PG8_BAR;
#undef PG8_SA
#undef PG8_SB
#undef PG8_STAGE
#undef PG8_LDA
#undef PG8_LDB
#undef PG8_MMA
#undef PG8_WAIT_V
#undef PG8_WAIT_L
#undef PG8_BAR
#undef PG8_SCHED
}

struct EpiF32 {
    static constexpr bool PERM = false;
    float* C; int ldc;
    __device__ __forceinline__ void operator()(const Acc& acc, const Unit& u, int wr, int wc, int fr, int fq) const {
        const int row0 = u.pm * BM + wr * 64 + fr, col0 = u.pn * BM + wc * 32 + 4 * fq;
#pragma unroll
        for (int ai = 0; ai < 2; ++ai)
#pragma unroll
            for (int m = 0; m < 4; ++m) { float* rowp = C + (size_t)(row0 + ai * HALF + m * 16) * ldc + col0;
#pragma unroll
                for (int bj = 0; bj < 2; ++bj)
#pragma unroll
                    for (int n = 0; n < 2; ++n) *(f32x4*)(rowp + bj * HALF + n * 16) = acc[ai][bj][m][n]; }
    }
};
struct EpiBf16 {
    static constexpr bool PERM = true;
    bf16_t* O; int ldc;
    __device__ __forceinline__ void operator()(const Acc& acc, const Unit& u, int wr, int wc, int fr, int fq) const {
        const int row0 = u.pm * BM + wr * 64 + fr, col0 = u.pn * BM + wc * 32 + 8 * fq;
#pragma unroll
        for (int ai = 0; ai < 2; ++ai)
#pragma unroll
            for (int m = 0; m < 4; ++m) { bf16_t* rowp = O + (size_t)(row0 + ai * HALF + m * 16) * ldc + col0;
#pragma unroll
                for (int bj = 0; bj < 2; ++bj) { const f32x4 v0 = acc[ai][bj][m][0], v1 = acc[ai][bj][m][1];
                    u32x4 w; w.x = cvt_pk_bf16(v0[0], v0[1]); w.y = cvt_pk_bf16(v0[2], v0[3]); w.z = cvt_pk_bf16(v1[0], v1[1]); w.w = cvt_pk_bf16(v1[2], v1[3]);
                    *(u32x4*)(rowp + bj * HALF) = w; } }
    }
};
struct EpiZ {
    static constexpr bool PERM = true;
    bf16_t* Z; float* rsq;
    __device__ __forceinline__ void operator()(const Acc& acc, const Unit& u, int wr, int wc, int fr, int fq) const {
        const int row0 = u.pm * BM + wr * 64 + fr, col0 = u.pn * BM + wc * 32 + 8 * fq;
#pragma unroll
        for (int ai = 0; ai < 2; ++ai)
#pragma unroll
            for (int m = 0; m < 4; ++m) { bf16_t* rowp = Z + (size_t)(row0 + ai * HALF + m * 16) * ZLD + col0;
#pragma unroll
                for (int bj = 0; bj < 2; ++bj) { const f32x4 v0 = acc[ai][bj][m][0], v1 = acc[ai][bj][m][1];
                    u32x4 w; w.x = cvt_pk_bf16(v0[0], v0[1]); w.y = cvt_pk_bf16(v0[2], v0[3]); w.z = cvt_pk_bf16(v1[0], v1[1]); w.w = cvt_pk_bf16(v1[2], v1[3]);
                    *(u32x4*)(rowp + bj * HALF) = w; } }
        if (u.pn >= 8 && u.pn <= 10) {
#pragma unroll
            for (int bj = 0; bj < 2; ++bj) { const int cb = u.pn * BM + bj * HALF + wc * 32;
                const int region = (cb >= Z_CQ && cb < Z_CKV) ? 0 : ((cb >= Z_CKV && cb < Z_KR) ? 1 : -1);
                if (region >= 0) {
#pragma unroll
                    for (int ai = 0; ai < 2; ++ai)
#pragma unroll
                        for (int m = 0; m < 4; ++m) { const f32x4 v0 = acc[ai][bj][m][0], v1 = acc[ai][bj][m][1];
                            float s = (v0[0] * v0[0] + v0[1] * v0[1]) + (v0[2] * v0[2] + v0[3] * v0[3]) + (v1[0] * v1[0] + v1[1] * v1[1]) + (v1[2] * v1[2] + v1[3] * v1[3]);
                            s += sx(s, 16, fq * 16 + fr); s += sx(s, 32, fq * 16 + fr);
                            if (fq == 0) atomicAdd(rsq + (size_t)(row0 + ai * HALF + m * 16) * 2 + region, s); } } }
        }
    }
};
struct EpiQ {
    static constexpr bool PERM = true;
    bf16_t* QM; const float* rsq; const float2* cs;
    __device__ __forceinline__ void operator()(const Acc& acc, const Unit& u, int wr, int wc, int fr, int fq) const {
        const int row0 = u.pm * BM + wr * 64 + fr;
#pragma unroll
        for (int ai = 0; ai < 2; ++ai)
#pragma unroll
            for (int m = 0; m < 4; ++m) { const int row = row0 + ai * HALF + m * 16; const float rs = 1.0f / sqrtf(rsq[(size_t)row * 2] * (1.f / 384.f) + EPS);
                if (u.pn < 2) {
#pragma unroll
                    for (int bj = 0; bj < 2; ++bj) { const f32x4 v0 = acc[ai][bj][m][0] * rs, v1 = acc[ai][bj][m][1] * rs;
                        u32x4 w; w.x = cvt_pk_bf16(v0[0], v0[1]); w.y = cvt_pk_bf16(v0[2], v0[3]); w.z = cvt_pk_bf16(v1[0], v1[1]); w.w = cvt_pk_bf16(v1[2], v1[3]);
                        *(u32x4*)(QM + (size_t)row * 768 + (2 * u.pn + bj) * 192 + wc * 32 + 8 * fq) = w; }
                } else {
                    float x1[8], x2[8], o1[8], o2[8];
#pragma unroll
                    for (int e = 0; e < 4; ++e) { x1[e] = acc[ai][0][m][0][e] * rs; x1[4 + e] = acc[ai][0][m][1][e] * rs; x2[e] = acc[ai][1][m][0][e] * rs; x2[4 + e] = acc[ai][1][m][1][e] * rs; }
                    if (row < RX) { const f32x4* cp = (const f32x4*)(cs + (row % SEQ) * 32 + 8 * fq);
#pragma unroll
                        for (int q = 0; q < 4; ++q) { const f32x4 c2 = cp[q];
                            o1[2 * q] = x1[2 * q] * c2.x - x2[2 * q] * c2.y; o2[2 * q] = x1[2 * q] * c2.y + x2[2 * q] * c2.x;
                            o1[2 * q + 1] = x1[2 * q + 1] * c2.z - x2[2 * q + 1] * c2.w; o2[2 * q + 1] = x1[2 * q + 1] * c2.w + x2[2 * q + 1] * c2.z; }
                    } else {
#pragma unroll
                        for (int e = 0; e < 8; ++e) { o1[e] = x1[e]; o2[e] = x2[e]; } }
                    bf16_t* dst = QM + (size_t)row * 768 + wc * 192 + 128 + 8 * fq;
                    st16(dst, pack8(o1)); st16(dst + 32, pack8(o2));
                }
                asm volatile("" ::: "memory"); }
    }
};
struct EpiKV {
    static constexpr bool PERM = true;
    bf16_t* KN; bf16_t* VM; const float* rsq;
    __device__ __forceinline__ void operator()(const Acc& acc, const Unit& u, int wr, int wc, int fr, int fq) const {
        const int row0 = u.pm * BM + wr * 64 + fr;
#pragma unroll
        for (int ai = 0; ai < 2; ++ai)
#pragma unroll
            for (int m = 0; m < 4; ++m) { const int row = row0 + ai * HALF + m * 16; const float rs = 1.0f / sqrtf(rsq[(size_t)row * 2 + 1] * (1.f / 256.f) + EPS);
#pragma unroll
                for (int bj = 0; bj < 2; ++bj) { const f32x4 v0 = acc[ai][bj][m][0] * rs, v1 = acc[ai][bj][m][1] * rs;
                    u32x4 w; w.x = cvt_pk_bf16(v0[0], v0[1]); w.y = cvt_pk_bf16(v0[2], v0[3]); w.z = cvt_pk_bf16(v1[0], v1[1]); w.w = cvt_pk_bf16(v1[2], v1[3]);
                    *(u32x4*)((bj ? VM : KN) + (size_t)row * 512 + u.pn * 128 + wc * 32 + 8 * fq) = w; }
                asm volatile("" ::: "memory"); }
    }
};
template <class Epi>
__device__ __forceinline__ void run(LAS unsigned char* lds, const Gemm g, int nM, int nN, int G, int c, const Epi& E, int tid) {
    TileOrder S; S.init(nM, nN, G, c);
    gemm_phase<Epi, TileOrder, true>(lds, g, S, E, tid);
}
}


namespace att {
constexpr int SHM_V = 64 * 128 * 2;
#define SBAR() __builtin_amdgcn_sched_barrier(0)
__device__ __forceinline__ int crow(int r, int hi) { return (r & 3) + 8 * (r >> 2) + 4 * hi; }
__device__ __forceinline__ void partialSM(f32x16& p0, f32x16& p1, float& m_reg, float& mn, float& alpha, float C, float thr_raw) {
    float pmax = p0[0];
#pragma unroll
    for (int r = 1; r < 16; ++r) pmax = fmaxf(pmax, p0[r]);
#pragma unroll
    for (int r = 0; r < 16; ++r) pmax = fmaxf(pmax, p1[r]);
    { auto rr = __builtin_amdgcn_permlane32_swap(__float_as_uint(pmax), __float_as_uint(pmax), false, false); pmax = fmaxf(__uint_as_float(rr[0]), __uint_as_float(rr[1])); }
    if (__builtin_expect(__all(pmax - m_reg <= thr_raw), 1)) { mn = m_reg; alpha = 1.f; }
    else { mn = fmaxf(m_reg, pmax); alpha = __builtin_amdgcn_exp2f((m_reg - mn) * C); m_reg = mn; }
    const float mnC = -mn * C;
#pragma unroll
    for (int r = 0; r < 16; ++r) p0[r] = fmaf(p0[r], C, mnC);
#pragma unroll
    for (int r = 0; r < 16; ++r) p1[r] = fmaf(p1[r], C, mnC);
#pragma unroll
    for (int r = 0; r < 16; ++r) p0[r] = __builtin_amdgcn_exp2f(p0[r]);
}
__device__ __forceinline__ void finishSM(f32x16& p0, f32x16& p1, float alpha, float& l_reg, bf16x8& pa0, bf16x8& pa1, bf16x8& pa2, bf16x8& pa3) {
#pragma unroll
    for (int r = 0; r < 16; ++r) p1[r] = __builtin_amdgcn_exp2f(p1[r]);
    float ps = 0.f;
#pragma unroll
    for (int r = 0; r < 16; ++r) ps += p0[r];
#pragma unroll
    for (int r = 0; r < 16; ++r) ps += p1[r];
    { auto rr = __builtin_amdgcn_permlane32_swap(__float_as_uint(ps), __float_as_uint(ps), false, false); ps = __uint_as_float(rr[0]) + __uint_as_float(rr[1]); }
    l_reg = l_reg * alpha + ps;
#define PK4(P_, BASE, OUT) do { unsigned a0 = cvt_pk_bf16(P_[BASE + 0], P_[BASE + 1]), a1 = cvt_pk_bf16(P_[BASE + 2], P_[BASE + 3]);   \
    unsigned b0 = cvt_pk_bf16(P_[BASE + 4], P_[BASE + 5]), b1 = cvt_pk_bf16(P_[BASE + 6], P_[BASE + 7]);                              \
    auto r0 = __builtin_amdgcn_permlane32_swap(a0, b0, false, false); auto r1 = __builtin_amdgcn_permlane32_swap(a1, b1, false, false); \
    u32x4 w = {r0[0], r1[0], r0[1], r1[1]}; OUT = *reinterpret_cast<bf16x8*>(&w); } while (0)
    PK4(p0, 0, pa0); PK4(p0, 8, pa1); PK4(p1, 0, pa2); PK4(p1, 8, pa3);
#undef PK4
}
template <int NDQ> __device__ __forceinline__ int kaddr(int row, int cb) { return row * (32 * NDQ) + (cb ^ (((row >> 1) & 7) << 4)); }
template <int NDQ, int NQR>
__device__ __forceinline__ void qkt(f32x16& p0, f32x16& p1, const char* Ks, const bf16x8* qr, const char* ql, int r32, int hi) {
    p0 = f32x16{}; p1 = f32x16{};
#pragma unroll
    for (int d0 = 0; d0 < NDQ; ++d0) { const int cb = d0 * 32 + hi * 16;
        const bf16x8 b0 = *reinterpret_cast<const bf16x8*>(Ks + kaddr<NDQ>(r32, cb));
        const bf16x8 b1 = *reinterpret_cast<const bf16x8*>(Ks + kaddr<NDQ>(32 + r32, cb));
        bf16x8 q; if (d0 < NQR) q = qr[d0]; else q = *reinterpret_cast<const bf16x8*>(ql + (d0 - NQR) * 1024);
        p0 = __builtin_amdgcn_mfma_f32_32x32x16_bf16(b0, q, p0, 0, 0, 0);
        p1 = __builtin_amdgcn_mfma_f32_32x32x16_bf16(b1, q, p1, 0, 0, 0); }
}
__device__ __forceinline__ int v_st(int k, int c) { const int kk = (k & ~0xC) | ((k & 4) << 1) | ((k & 8) >> 1); return ((kk >> 3) * 4 + (c >> 5)) * 512 + ((kk & 7) * 32 + (c & 31)) * 2; }
__device__ __forceinline__ int v_rd_base(int lane) { return ((lane & 3) << 3) | (((lane >> 2) & 3) << 6) | (((lane >> 4) & 1) << 5) | (((lane >> 5) & 1) << 8); }
constexpr int v_rd_off(int d0, int ks, int half) { return d0 * 512 + ks * 4096 + half * 2048; }
template <int OFF> __device__ __forceinline__ s16x4 tr_read(int vb) { s16x4 r; asm volatile("ds_read_b64_tr_b16 %0, %1 offset:%2" : "=&v"(r) : "v"(vb), "i"(OFF) : "memory"); return r; }
template <int D0> __device__ __forceinline__ void pv_one(f32x16& od, int vb, bf16x8 pa0, bf16x8 pa1, bf16x8 pa2, bf16x8 pa3) {
    const s16x4 l0 = tr_read<v_rd_off(D0, 0, 0)>(vb), h0 = tr_read<v_rd_off(D0, 0, 1)>(vb), l1 = tr_read<v_rd_off(D0, 1, 0)>(vb), h1 = tr_read<v_rd_off(D0, 1, 1)>(vb);
    const s16x4 l2 = tr_read<v_rd_off(D0, 2, 0)>(vb), h2 = tr_read<v_rd_off(D0, 2, 1)>(vb), l3 = tr_read<v_rd_off(D0, 3, 0)>(vb), h3 = tr_read<v_rd_off(D0, 3, 1)>(vb);
    asm volatile("s_waitcnt lgkmcnt(0)" ::: "memory"); SBAR();
#define PKV(L_, H_) (bf16x8){L_[0], L_[1], L_[2], L_[3], H_[0], H_[1], H_[2], H_[3]}
    od = __builtin_amdgcn_mfma_f32_32x32x16_bf16(pa0, PKV(l0, h0), od, 0, 0, 0);
    od = __builtin_amdgcn_mfma_f32_32x32x16_bf16(pa1, PKV(l1, h1), od, 0, 0, 0);
    od = __builtin_amdgcn_mfma_f32_32x32x16_bf16(pa2, PKV(l2, h2), od, 0, 0, 0);
    od = __builtin_amdgcn_mfma_f32_32x32x16_bf16(pa3, PKV(l3, h3), od, 0, 0, 0);
#undef PKV
}
__device__ __forceinline__ void pv_d0(f32x16* o, int vb, bf16x8 pa0, bf16x8 pa1, bf16x8 pa2, bf16x8 pa3) {
    pv_one<0>(o[0], vb, pa0, pa1, pa2, pa3); pv_one<1>(o[1], vb, pa0, pa1, pa2, pa3); pv_one<2>(o[2], vb, pa0, pa1, pa2, pa3); pv_one<3>(o[3], vb, pa0, pa1, pa2, pa3);
}
template <int NDQ, int SD>
__device__ __forceinline__ void attn_body(const bf16_t* __restrict__ Qw, int ldq, const bf16_t* __restrict__ Kg, int ldk, const bf16_t* __restrict__ Krg, const bf16_t* __restrict__ Vg, int ldv,
                                          int xrow0, int nxt, int crow0, int NT, float C, char* lds, int tid, f32x16 (&o)[4], float (&rli)[16]) {
    constexpr int SHM_K = 64 * 32 * NDQ;
    const int wid = tid >> 6, lane = tid & 63, r32 = lane & 31, hi = lane >> 5;
    char* V_lds = lds; char* K_lds = lds + 2 * SHM_V;
    float* wsf = (float*)(lds + 2 * SHM_V + 2 * SHM_K) + wid * 64; float* li_l = wsf; float* al_l = wsf + 32;
    const float thr_raw = 8.f * 1.4426950408889634f / C;
    constexpr int NQR = (NDQ > 8) ? 6 : NDQ;
    char* ql = lds + 2 * SHM_V + 2 * SHM_K + 2048 + wid * ((NDQ - NQR) * 1024) + lane * 16;
    float m_reg = -1e30f, l_reg = 0.f; bf16x8 qr[NQR];
#pragma unroll
    for (int d0 = 0; d0 < 4; ++d0) o[d0] = f32x16{};
    const bf16_t* Ql = Qw + (size_t)r32 * ldq + hi * 8;
    __syncthreads();
#pragma unroll
    for (int d0 = 0; d0 < NDQ; ++d0) { const bf16x8 q = *reinterpret_cast<const bf16x8*>(Ql + d0 * 16); if (d0 < NQR) qr[d0] = q; else *reinterpret_cast<bf16x8*>(ql + (d0 - NQR) * 1024) = q; }
    const int sr = tid >> 4, sc = (tid & 15) * 8, vst0 = v_st(sr, sc), vst1 = v_st(32 + sr, sc);
    const int k8r = tid >> 3, k8c = (tid & 7) * 8;
    const int vb0 = (int)(uintptr_t)V_lds + v_rd_base(lane);
    bf16x8 vsA0, vsA1, ksA0, ksA1, ksA2, vsB0, vsB1, ksB0, ksB1, ksB2;
#define KROW(j) ((j) < nxt ? xrow0 + 64 * (j) : crow0 + 64 * ((j) - nxt))
#define SLOAD(S_, j) do { const int row0_ = KROW(j); \
        vs##S_##0 = *reinterpret_cast<const bf16x8*>(Vg + (size_t)(row0_ + sr) * ldv + sc); vs##S_##1 = *reinterpret_cast<const bf16x8*>(Vg + (size_t)(row0_ + 32 + sr) * ldv + sc); \
        if constexpr (NDQ == 4) { ks##S_##0 = *reinterpret_cast<const bf16x8*>(Kg + (size_t)(row0_ + k8r) * ldk + k8c); } \
        else { ks##S_##0 = *reinterpret_cast<const bf16x8*>(Kg + (size_t)(row0_ + sr) * ldk + sc); ks##S_##1 = *reinterpret_cast<const bf16x8*>(Kg + (size_t)(row0_ + 32 + sr) * ldk + sc); \
               ks##S_##2 = *reinterpret_cast<const bf16x8*>(Krg + (size_t)(row0_ + k8r) * 64 + k8c); } } while (0)
#define SWRITE(b, S_) do { *(bf16x8*)(V_lds + (b) * SHM_V + vst0) = vs##S_##0; *(bf16x8*)(V_lds + (b) * SHM_V + vst1) = vs##S_##1; \
        if constexpr (NDQ == 4) { *(bf16x8*)(K_lds + (b) * SHM_K + kaddr<NDQ>(k8r, k8c * 2)) = ks##S_##0; } \
        else { *(bf16x8*)(K_lds + (b) * SHM_K + kaddr<NDQ>(sr, sc * 2)) = ks##S_##0; *(bf16x8*)(K_lds + (b) * SHM_K + kaddr<NDQ>(32 + sr, sc * 2)) = ks##S_##1; \
               *(bf16x8*)(K_lds + (b) * SHM_K + kaddr<NDQ>(k8r, 256 + k8c * 2)) = ks##S_##2; } } while (0)
#define SLOAD_B(j) do { if constexpr (SD == 2) SLOAD(B, j); else SLOAD(A, j); } while (0)
#define SWRITE_B(b) do { if constexpr (SD == 2) SWRITE(b, B); else SWRITE(b, A); } while (0)
#define SWAIT() do { if constexpr (SD == 1) asm volatile("s_waitcnt vmcnt(0)" ::: "memory"); else if constexpr (NDQ == 4) asm volatile("s_waitcnt vmcnt(3)" ::: "memory"); else asm volatile("s_waitcnt vmcnt(5)" ::: "memory"); } while (0)
#define RESC(a) do { if (__any((a) < 1.f)) { if (hi == 0) al_l[r32] = (a); asm volatile("s_waitcnt lgkmcnt(0)" ::: "memory"); \
        _Pragma("unroll") for (int d = 0; d < 4; ++d) _Pragma("unroll") for (int r = 0; r < 16; ++r) o[d][r] *= al_l[crow(r, hi)]; } } while (0)
    f32x16 pA0, pA1, pB0, pB1; float mnA, mnB, alA, alB; bf16x8 pa0, pa1, pa2, pa3;
    SLOAD(A, 0); asm volatile("s_waitcnt vmcnt(0)" ::: "memory"); SWRITE(0, A); __syncthreads();
    qkt<NDQ, NQR>(pA0, pA1, K_lds, qr, ql, r32, hi); partialSM(pA0, pA1, m_reg, mnA, alA, C, thr_raw);
    SLOAD_B(1); if constexpr (SD == 2) { if (2 < NT) SLOAD(A, 2); }
    SWAIT(); SWRITE_B(1); __syncthreads();
    for (int j = 1; j + 1 < NT; j += 2) {
        SBAR(); qkt<NDQ, NQR>(pB0, pB1, K_lds + SHM_K, qr, ql, r32, hi);
        finishSM(pA0, pA1, alA, l_reg, pa0, pa1, pa2, pa3); SBAR();
        SLOAD_B(j + SD); SBAR();
        pv_d0(o, vb0, pa0, pa1, pa2, pa3); partialSM(pB0, pB1, m_reg, mnB, alB, C, thr_raw);
        __syncthreads(); SWAIT(); SWRITE(0, A);
        RESC(alB); __syncthreads();
        SBAR(); qkt<NDQ, NQR>(pA0, pA1, K_lds, qr, ql, r32, hi);
        finishSM(pB0, pB1, alB, l_reg, pa0, pa1, pa2, pa3); SBAR();
        if (SD == 1 || j + 3 < NT) SLOAD(A, j + 1 + SD); SBAR();
        pv_d0(o, vb0 + SHM_V, pa0, pa1, pa2, pa3); partialSM(pA0, pA1, m_reg, mnA, alA, C, thr_raw);
        __syncthreads(); SWAIT(); SWRITE_B(1);
        RESC(alA); __syncthreads();
    }
    SBAR(); qkt<NDQ, NQR>(pB0, pB1, K_lds + SHM_K, qr, ql, r32, hi);
    finishSM(pA0, pA1, alA, l_reg, pa0, pa1, pa2, pa3); SBAR();
    pv_d0(o, vb0, pa0, pa1, pa2, pa3); partialSM(pB0, pB1, m_reg, mnB, alB, C, thr_raw);
    __syncthreads(); RESC(alB);
    finishSM(pB0, pB1, alB, l_reg, pa0, pa1, pa2, pa3); SBAR();
    pv_d0(o, vb0 + SHM_V, pa0, pa1, pa2, pa3);
    if (hi == 0) li_l[r32] = l_reg; asm volatile("s_waitcnt lgkmcnt(0)" ::: "memory");
#pragma unroll
    for (int r = 0; r < 16; ++r) rli[r] = __builtin_amdgcn_rcpf(li_l[crow(r, hi)]);
#undef KROW
#undef SLOAD
#undef SWRITE
#undef SWAIT
#undef SLOAD_B
#undef SWRITE_B
#undef RESC
}
__device__ __forceinline__ void unit_diff(KP kp, unsigned char* ws, int l, int b, int h, int qrow0, int isc, char* lds, int tid, float* scratch) {
    const int wid = tid >> 6, lane = tid & 63, r32 = lane & 31, hi = lane >> 5;
    const bf16_t* Z = (const bf16_t*)(ws + WS_Z); bf16_t* MIX = (bf16_t*)(ws + WS_MIX);
    const int xrow0 = b * SEQ, nxt = isc ? 0 : SEQ / 64, crow0 = RX + b * CTX, NT = nxt + CTX / 64;
    const float C = 0.125f * 1.4426950408889634f;
    const float* lamp = kp->in[IN_DIFFLAM] + l * 256;
    float l1 = lamp[lane] * lamp[64 + lane], l2 = lamp[128 + lane] * lamp[192 + lane]; l1 = wsum(l1, lane); l2 = wsum(l2, lane);
    const float lam_init = (l == 0) ? 0.2f : 0.35550906759096907f;
    const float lam = expf(l1) - expf(l2) + lam_init;
    float* myscr = scratch + (size_t)wid * 64 * 64 + lane;
    f32x16 o[4]; float rli[16];
    attn_body<4, 2>(Z + (size_t)(qrow0 + wid * 32) * ZLD + Z_Q + h * 128, ZLD, Z + Z_K + h * 128, ZLD, nullptr, Z + Z_V + h * 128, ZLD, xrow0, nxt, crow0, NT, C, lds, tid, o, rli);
#pragma unroll
    for (int d0 = 0; d0 < 4; ++d0)
#pragma unroll
        for (int r = 0; r < 16; ++r) myscr[(d0 * 16 + r) * 64] = o[d0][r] * rli[r];
    attn_body<4, 2>(Z + (size_t)(qrow0 + wid * 32) * ZLD + Z_Q + h * 128 + 64, ZLD, Z + Z_K + h * 128 + 64, ZLD, nullptr, Z + Z_V + h * 128, ZLD, xrow0, nxt, crow0, NT, C, lds, tid, o, rli);
    size_t so = 0; asm volatile("" : "+v"(so) :: "memory"); const float* rdscr = myscr + so;
    const float* subg = kp->in[IN_SUBLN] + l * 128; const float post = 1.f - lam_init;
    float sg[4];
#pragma unroll
    for (int d0 = 0; d0 < 4; ++d0) sg[d0] = subg[d0 * 32 + r32] * post;
#pragma unroll
    for (int r = 0; r < 16; ++r) {
        float dv[4], ss = 0.f;
#pragma unroll
        for (int d0 = 0; d0 < 4; ++d0) { dv[d0] = rdscr[(d0 * 16 + r) * 64] - lam * (o[d0][r] * rli[r]); ss += dv[d0] * dv[d0]; }
        ss += sx(ss, 1, lane); ss += sx(ss, 2, lane); ss += sx(ss, 4, lane); ss += sx(ss, 8, lane); ss += sx(ss, 16, lane);
        const float rs = 1.0f / sqrtf(ss * (1.f / 128.f) + EPS);
        bf16_t* mp = MIX + (size_t)(qrow0 + wid * 32 + crow(r, hi)) * D + 512 + h * 128 + r32;
#pragma unroll
        for (int d0 = 0; d0 < 4; ++d0) mp[d0 * 32] = f2bf(dv[d0] * rs * sg[d0]);
    }
}
__device__ __forceinline__ void unit_mla(unsigned char* ws, int b, int h, int qrow0, int isc, char* lds, int tid) {
    const int wid = tid >> 6, lane = tid & 63, r32 = lane & 31, hi = lane >> 5;
    const bf16_t* QM = (const bf16_t*)(ws + WS_QM); const bf16_t* KN = (const bf16_t*)(ws + WS_KN); const bf16_t* KR = (const bf16_t*)(ws + WS_KR); const bf16_t* VM = (const bf16_t*)(ws + WS_VM);
    bf16_t* MIX = (bf16_t*)(ws + WS_MIX);
    const int xrow0 = b * SEQ, nxt = isc ? 0 : SEQ / 64, crow0 = RX + b * CTX, NT = nxt + CTX / 64;
    const float C = 0.07216878364870322f * 1.4426950408889634f;
    f32x16 o[4]; float rli[16];
    attn_body<12, 1>(QM + (size_t)(qrow0 + wid * 32) * 768 + h * 192, 768, KN + h * 128, 512, KR, VM + h * 128, 512, xrow0, nxt, crow0, NT, C, lds, tid, o, rli);
#pragma unroll
    for (int r = 0; r < 16; ++r) { bf16_t* mp = MIX + (size_t)(qrow0 + wid * 32 + crow(r, hi)) * D + 1024 + h * 128 + r32;
#pragma unroll
        for (int d0 = 0; d0 < 4; ++d0) mp[d0 * 32] = f2bf(o[d0][r] * rli[r]); }
}
__device__ __forceinline__ void phase_attn(KP kp, unsigned char* ws, int tid, int l, char* lds, int vcu, int G, int bx) {
    const int nunits = (l == 0) ? 288 : 256;
    float* scratch = (float*)(ws + WS_O1) + (size_t)bx * (8 * 64 * 64);
    for (int k = 0; k * G < nunits; ++k) {
        const int u = k * G + ((vcu + k * 128) % G); if (u >= nunits) continue;
        int tidu = tid; asm volatile("" : "+v"(tidu));
        size_t wo = 0; asm volatile("" : "+s"(wo)); unsigned char* wsu = kp->ws + wo; int lu = l; asm volatile("" : "+s"(lu));
        const bool isc = (u >= 256); const int v = isc ? (u - 256) & 15 : (u & 127);
        const bool mla = isc ? (u >= 272) : (u >= 128);
        const int b = isc ? (v >> 2) : (v >> 5), h = isc ? (v & 3) : ((v >> 3) & 3), q0 = isc ? RX + b * CTX : b * SEQ + (v & 7) * 256;
        if (!mla) unit_diff(kp, wsu, lu, b, h, q0, isc ? 1 : 0, lds, tidu, scratch);
        else unit_mla(wsu, b, h, q0, isc ? 1 : 0, lds, tidu);
    }
}
#undef SBAR
}

constexpr int LDS_BYTES = 147456;
__global__ void __launch_bounds__(NTHR, 2) mk_fwd(Params P) {
    extern __shared__ __attribute__((aligned(16))) unsigned char lds_raw[];
    LAS unsigned char* lds = (LAS unsigned char*)lds_raw;
    KP kp = (KP)__builtin_amdgcn_kernarg_segment_ptr();
    const int G0 = gridDim.x, bx0 = blockIdx.x;
    const int vcu0 = (G0 % 8 == 0) ? (bx0 % 8) * (G0 / 8) + bx0 / 8 : bx0;
    for (int ph = kp->ph_lo; ph < kp->ph_hi; ++ph) {
        if (ph != kp->ph_lo) cg::this_grid().sync();
        asm volatile("" : "+s"(kp));
        int G = G0, bx = bx0, vcu = vcu0; asm volatile("" : "+s"(G), "+s"(bx), "+s"(vcu));
        int tid_ = __builtin_amdgcn_workitem_id_x(); asm volatile("" : "+v"(tid_));
        size_t wsoff = 0; asm volatile("" : "+s"(wsoff)); unsigned char* ws = kp->ws + wsoff;
        if (ph == PH_PRO) { phase_prologue(kp, ws, tid_, lds, vcu, G); continue; }
        if (ph == PH_ROWA) { phase_rowpass(kp, ws, tid_, 0, 0, vcu, G); continue; }
        const int l = (ph - PH_L0) / PH_PER_LAYER, sub = (ph - PH_L0) % PH_PER_LAYER;
        const int nrM = (l == 1 ? RX : R) / 256;
        if (sub == PHL_WIN) {
            pg8::run(lds, pg8::Gemm{(const bf16_t*)(ws + WS_H), (const bf16_t*)(ws + WS_WIN) + (size_t)l * ZLD * D, D, D, D}, R / 256, ZLD / 256, G, bx, pg8::EpiZ{(bf16_t*)(ws + WS_Z), (float*)(ws + WS_RSQ) + (size_t)l * R * 2}, tid_);
        } else if (sub == PHL_WOUT) {
            pg8::run(lds, pg8::Gemm{(const bf16_t*)(ws + WS_MIX), (const bf16_t*)(ws + WS_WOUT) + (size_t)l * D * D, D, D, D}, nrM, D / 256, G, bx, pg8::EpiF32{(float*)(ws + WS_Y), D}, tid_);
        } else if (sub == PHL_UP) {
            pg8::run(lds, pg8::Gemm{(const bf16_t*)(ws + WS_H), (const bf16_t*)(ws + WS_WUP) + (size_t)l * UFF * D, D, D, D}, nrM, UFF / 256, G, bx, pg8::EpiBf16{(bf16_t*)(ws + WS_U), UFF}, tid_);
        } else if (sub == PHL_DOWN) {
            pg8::run(lds, pg8::Gemm{(const bf16_t*)(ws + WS_ACT), (const bf16_t*)(ws + WS_WDOWN) + (size_t)l * D * DFF, DFF, DFF, DFF}, nrM, D / 256, G, bx, pg8::EpiF32{(float*)(ws + WS_Y), D}, tid_);
        } else if (sub == PHL_PRE) {
            if (kp->mask & 1) {
                const float* rsq = (const float*)(ws + WS_RSQ) + (size_t)l * R * 2;
                pg8::run(lds, pg8::Gemm{(const bf16_t*)(ws + WS_Z) + Z_CQ, (const bf16_t*)(ws + WS_WUQ) + (size_t)l * 768 * 384, ZLD, 384, 384}, R / 256, 3, G, bx, pg8::EpiQ{(bf16_t*)(ws + WS_QM), rsq, (const float2*)(ws + WS_CS)}, tid_);
                int tid2 = tid_; asm volatile("" : "+v"(tid2)); size_t wsoff2 = 0; asm volatile("" : "+s"(wsoff2)); unsigned char* ws2 = kp->ws + wsoff2;
                pg8::run(lds, pg8::Gemm{(const bf16_t*)(ws2 + WS_Z) + Z_CKV, (const bf16_t*)(ws2 + WS_WUKV) + (size_t)l * 1024 * 256, ZLD, 256, 256}, R / 256, 4, G, (bx + G - 108) % G, pg8::EpiKV{(bf16_t*)(ws2 + WS_KN), (bf16_t*)(ws2 + WS_VM), (const float*)(ws2 + WS_RSQ) + (size_t)l * R * 2}, tid2);
            }
            if (kp->mask & 2) pre_rope(kp, ws, tid_, vcu, G);
            if (kp->mask & 4) pre_pool(kp, ws, tid_, l, vcu, G);
            if (kp->mask & 8) pre_conv(kp, ws, tid_, l, vcu, G);
        } else if (sub == PHL_ATTN) { att::phase_attn(kp, ws, tid_, l, (char*)lds_raw, vcu, G, bx);
        } else if (sub == PHL_ROWB) phase_rowpass(kp, ws, tid_, 1, l, vcu, G);
        else if (sub == PHL_ACT) phase_act(kp, ws, tid_, l, vcu, G);
        else if (sub == PHL_ROWC) phase_rowpass(kp, ws, tid_, 2, l, vcu, G);
    }
}

namespace slow {
struct EpiZ { bf16_t* Z; __device__ void operator()(int r, int n, float v) const { Z[(size_t)r * ZLD + n] = f2bf(v); } };
struct EpiQ { bf16_t* QM; const float* rsq; __device__ void operator()(int r, int p, float v) const {
        int nat; if (p < 512) { const int h = (p >> 8) * 2 + ((p >> 7) & 1); nat = h * 192 + (p & 127); } else { const int q = p - 512, half = q >> 7, h = (q & 127) >> 5, i = q & 31; nat = h * 192 + 128 + half * 32 + i; }
        const float rs = 1.0f / sqrtf(rsq[r * 2 + 0] * (1.f / 384.f) + EPS); QM[(size_t)r * 768 + nat] = f2bf(v * rs); } };
struct EpiKV { bf16_t* KN; bf16_t* VM; const float* rsq; __device__ void operator()(int r, int n, float v) const {
        const int h = n >> 8, j = n & 255; const float rs = 1.0f / sqrtf(rsq[r * 2 + 1] * (1.f / 256.f) + EPS);
        if (j < 128) KN[(size_t)r * 512 + h * 128 + j] = f2bf(v * rs); else VM[(size_t)r * 512 + h * 128 + j - 128] = f2bf(v * rs); } };
struct EpiY { float* Y; __device__ void operator()(int r, int n, float v) const { Y[(size_t)r * D + n] = v; } };
struct EpiU { bf16_t* U; __device__ void operator()(int r, int n, float v) const { U[(size_t)r * UFF + n] = f2bf(v); } };
struct EpiPool { bf16_t* MIX; int g; __device__ void operator()(int r, int n, float v) const { MIX[(size_t)r * D + g * 128 + n] = f2bf(v); } };

template <class Epi>
__global__ __launch_bounds__(256) void k_sgemm(const bf16_t* __restrict__ A, int lda, const bf16_t* __restrict__ Bt, int ldb, int K, Epi E) {
    __shared__ float As[32][68]; __shared__ float Bs[32][68];
    const int tid = threadIdx.x, tx = tid & 15, ty = tid >> 4; const int m0 = blockIdx.y * 64, n0 = blockIdx.x * 64;
    float acc[4][4];
#pragma unroll
    for (int i = 0; i < 4; ++i)
#pragma unroll
        for (int j = 0; j < 4; ++j) acc[i][j] = 0.f;
    const int lr = tid >> 2, lk = (tid & 3) * 8;
    for (int k0 = 0; k0 < K; k0 += 32) {
        float av[8], bv[8]; unpack8(ld16(A + (size_t)(m0 + lr) * lda + k0 + lk), av); unpack8(ld16(Bt + (size_t)(n0 + lr) * ldb + k0 + lk), bv);
        __syncthreads();
#pragma unroll
        for (int e = 0; e < 8; ++e) { As[lk + e][lr] = av[e]; Bs[lk + e][lr] = bv[e]; }
        __syncthreads();
#pragma unroll
        for (int k = 0; k < 32; ++k) { const f32x4 a = *(const f32x4*)&As[k][ty * 4], b = *(const f32x4*)&Bs[k][tx * 4];
#pragma unroll
            for (int i = 0; i < 4; ++i)
#pragma unroll
                for (int j = 0; j < 4; ++j) acc[i][j] += a[i] * b[j]; }
    }
#pragma unroll
    for (int i = 0; i < 4; ++i)
#pragma unroll
        for (int j = 0; j < 4; ++j) E(m0 + ty * 4 + i, n0 + tx * 4 + j, acc[i][j]);
}
__global__ __launch_bounds__(256) void k_rsq(const bf16_t* __restrict__ Z, float* __restrict__ rsq) {
    const int r = blockIdx.x * 4 + (threadIdx.x >> 6), lane = threadIdx.x & 63; if (r >= R) return;
    float s0 = 0.f, s1 = 0.f;
    for (int j = lane; j < 384; j += 64) { const float v = bf2f(Z[(size_t)r * ZLD + Z_CQ + j]); s0 += v * v; }
    for (int j = lane; j < 256; j += 64) { const float v = bf2f(Z[(size_t)r * ZLD + Z_CKV + j]); s1 += v * v; }
    s0 = wave_sum(s0); s1 = wave_sum(s1); if (lane == 0) { rsq[r * 2] = s0; rsq[r * 2 + 1] = s1; }
}
__global__ void k_rope_qm(bf16_t* __restrict__ QM, const float2* __restrict__ cs) {
    const int idx = blockIdx.x * blockDim.x + threadIdx.x; if (idx >= RX * 4 * 32) return;
    const int i = idx % 32, h = (idx / 32) % 4, r = idx / 128, t = r % SEQ;
    bf16_t* p = QM + (size_t)r * 768 + h * 192 + 128; const float2 c = cs[t * 32 + i]; const float x1 = bf2f(p[i]), x2 = bf2f(p[i + 32]);
    p[i] = f2bf(x1 * c.x - x2 * c.y); p[i + 32] = f2bf(x1 * c.y + x2 * c.x);
}
__global__ void k_pooled(const bf16_t* __restrict__ Z, bf16_t* __restrict__ Pb) {
    const int idx = blockIdx.x * blockDim.x + threadIdx.x; if (idx >= R * 512) return;
    const int col = idx % 512, r = idx / 512; int b, t, L, isc; rowinfo(r, b, t, L, isc);
    const int g = col / 128, half = 1 << g; int lo = t - half; if (lo < 0) lo = 0; int hi = t + half; if (hi > L) hi = L;
    float s = 0.f; for (int tt = lo; tt < hi; ++tt) s += bf2f(Z[(size_t)(r - t + tt) * ZLD + Z_POOL + col]);
    Pb[idx] = f2bf(s / (float)(hi - lo) - bf2f(Z[(size_t)r * ZLD + Z_POOL + col]));
}
constexpr int NKMAX = SEQ + CTX;
__device__ __forceinline__ int keyrow(int isc, int b, int j) { return isc ? (RX + b * CTX + j) : (j < SEQ ? b * SEQ + j : RX + b * CTX + (j - SEQ)); }
__global__ __launch_bounds__(128) void k_attn_diff(const bf16_t* __restrict__ Z, const float* __restrict__ lamp, const float* __restrict__ subg, float lam_init, bf16_t* __restrict__ MIX) {
    __shared__ float S1[2][NKMAX], S2[2][NKMAX], Q[2][128];
    const int w = threadIdx.x >> 6, lane = threadIdx.x & 63; const int item = blockIdx.x * 2 + w; const int h = item & 3, r = item >> 2;
    int b, t, L, isc; rowinfo(r, b, t, L, isc); const int nk = isc ? CTX : SEQ + CTX;
    float l1 = lamp[lane] * lamp[64 + lane], l2 = lamp[128 + lane] * lamp[192 + lane]; l1 = wave_sum(l1); l2 = wave_sum(l2); const float lam = expf(l1) - expf(l2) + lam_init;
    Q[w][lane] = bf2f(Z[(size_t)r * ZLD + Z_Q + h * 128 + lane]); Q[w][64 + lane] = bf2f(Z[(size_t)r * ZLD + Z_Q + h * 128 + 64 + lane]);
    __syncthreads();
    float m1 = -1e30f, m2 = -1e30f;
    for (int j0 = 0; j0 < nk; j0 += 64) { const int j = j0 + lane; const bf16_t* kp = Z + (size_t)keyrow(isc, b, j) * ZLD + Z_K + h * 128; float s1 = 0.f, s2 = 0.f;
        for (int d = 0; d < 64; ++d) { s1 += Q[w][d] * bf2f(kp[d]); s2 += Q[w][64 + d] * bf2f(kp[64 + d]); }
        s1 *= 0.125f; s2 *= 0.125f; S1[w][j] = s1; S2[w][j] = s2; m1 = fmaxf(m1, s1); m2 = fmaxf(m2, s2); }
    m1 = wave_max(m1); m2 = wave_max(m2); float e1 = 0.f, e2 = 0.f;
    for (int j = lane; j < nk; j += 64) { const float p1 = expf(S1[w][j] - m1), p2 = expf(S2[w][j] - m2); S1[w][j] = p1; S2[w][j] = p2; e1 += p1; e2 += p2; }
    e1 = wave_sum(e1); e2 = wave_sum(e2); const float i1 = 1.f / e1, i2 = lam / e2;
    __syncthreads();
    float o0 = 0.f, o1 = 0.f;
    for (int j = 0; j < nk; ++j) { const float a = S1[w][j] * i1 - S2[w][j] * i2; const bf16_t* vp = Z + (size_t)keyrow(isc, b, j) * ZLD + Z_V + h * 128; o0 += a * bf2f(vp[lane]); o1 += a * bf2f(vp[64 + lane]); }
    const float ss = wave_sum(o0 * o0 + o1 * o1), rs = 1.0f / sqrtf(ss / 128.f + EPS);
    bf16_t* mp = MIX + (size_t)r * D + 512 + h * 128; mp[lane] = f2bf(o0 * rs * subg[lane] * (1.f - lam_init)); mp[64 + lane] = f2bf(o1 * rs * subg[64 + lane] * (1.f - lam_init));
}
__global__ __launch_bounds__(128) void k_attn_mla(const bf16_t* __restrict__ QM, const bf16_t* __restrict__ KN, const bf16_t* __restrict__ KR, const bf16_t* __restrict__ VM, bf16_t* __restrict__ MIX) {
    __shared__ float S1[2][NKMAX], Q[2][192];
    const int w = threadIdx.x >> 6, lane = threadIdx.x & 63; const int item = blockIdx.x * 2 + w; const int h = item & 3, r = item >> 2;
    int b, t, L, isc; rowinfo(r, b, t, L, isc); const int nk = isc ? CTX : SEQ + CTX;
    for (int d = lane; d < 192; d += 64) Q[w][d] = bf2f(QM[(size_t)r * 768 + h * 192 + d]);
    __syncthreads();
    const float scale = 0.07216878364870322f; float m1 = -1e30f;
    for (int j0 = 0; j0 < nk; j0 += 64) { const int j = j0 + lane, kr = keyrow(isc, b, j); const bf16_t* kp = KN + (size_t)kr * 512 + h * 128; const bf16_t* krp = KR + (size_t)kr * 64; float s1 = 0.f;
        for (int d = 0; d < 128; ++d) s1 += Q[w][d] * bf2f(kp[d]);
        for (int d = 0; d < 64; ++d) s1 += Q[w][128 + d] * bf2f(krp[d]);
        s1 *= scale; S1[w][j] = s1; m1 = fmaxf(m1, s1); }
    m1 = wave_max(m1); float e1 = 0.f;
    for (int j = lane; j < nk; j += 64) { const float p1 = expf(S1[w][j] - m1); S1[w][j] = p1; e1 += p1; }
    e1 = wave_sum(e1); const float i1 = 1.f / e1;
    __syncthreads();
    float o0 = 0.f, o1 = 0.f;
    for (int j = 0; j < nk; ++j) { const float a = S1[w][j] * i1; const bf16_t* vp = VM + (size_t)keyrow(isc, b, j) * 512 + h * 128; o0 += a * bf2f(vp[lane]); o1 += a * bf2f(vp[64 + lane]); }
    bf16_t* mp = MIX + (size_t)r * D + 1024 + h * 128; mp[lane] = f2bf(o0); mp[64 + lane] = f2bf(o1);
}
}

#ifndef FAST
#define FAST (1 | 2 | 4 | 8 | 16 | 32 | 64)
#endif
static void launch_phases(const Params& base, int lo, int hi, int mask, hipStream_t stream) {
    Params p = base; p.ph_lo = lo; p.ph_hi = hi; p.mask = mask;
    hipLaunchKernelGGL(mk_fwd, dim3(256), dim3(NTHR), LDS_BYTES, stream, p);
}
extern "C" void kernel_launch(void* const* d_in, const int* in_sizes, int n_in, void* d_out, int out_size, void* d_ws, size_t ws_size, hipStream_t stream) {
    static int ok = 0;
    if (ok == 0) {
        if (n_in != 24 || ws_size < WS_END) { fprintf(stderr, "kernel_launch: bad args n_in %d ws %zu (need %zu)\n", n_in, ws_size, (size_t)WS_END); ok = -1; return; }
        if (hipFuncSetAttribute((const void*)mk_fwd, hipFuncAttributeMaxDynamicSharedMemorySize, LDS_BYTES) != hipSuccess) { fprintf(stderr, "hipFuncSetAttribute failed\n"); ok = -1; return; }
        ok = 1;
    }
    if (ok < 0) return;
    unsigned char* ws = (unsigned char*)d_ws;
    (void)hipMemsetAsync(ws + WS_CTL, 0, CTL_BYTES, stream);
    Params P{};
    for (int i = 0; i < 24; ++i) P.in[i] = (const float*)d_in[i];
    P.out = (float*)d_out; P.ws = ws;
    bf16_t* H = (bf16_t*)(ws + WS_H); bf16_t* Z = (bf16_t*)(ws + WS_Z); bf16_t* QM = (bf16_t*)(ws + WS_QM); bf16_t* KN = (bf16_t*)(ws + WS_KN); bf16_t* VM = (bf16_t*)(ws + WS_VM); bf16_t* KR = (bf16_t*)(ws + WS_KR);
    bf16_t* MIX = (bf16_t*)(ws + WS_MIX); float* Y = (float*)(ws + WS_Y); bf16_t* U = (bf16_t*)(ws + WS_U); bf16_t* ACT = (bf16_t*)(ws + WS_ACT);
    const float2* cs = (const float2*)(ws + WS_CS);
    launch_phases(P, PH_PRO, PH_PRO + 1, 0, stream);
    launch_phases(P, PH_ROWA, PH_ROWA + 1, 0, stream);
    for (int l = 0; l < 2; ++l) {
        const int pb = PH_L0 + l * PH_PER_LAYER; const bool last = (l == 1); const int nr = last ? RX : R;
        const float lam_init = (float)(0.8 - 0.6 * exp(-0.3 * l));
        float* rsq = (float*)(ws + WS_RSQ) + (size_t)l * R * 2;
        const bf16_t* WIN = (const bf16_t*)(ws + WS_WIN) + (size_t)l * ZLD * D; const bf16_t* WOUT = (const bf16_t*)(ws + WS_WOUT) + (size_t)l * D * D;
        const bf16_t* WUP = (const bf16_t*)(ws + WS_WUP) + (size_t)l * UFF * D; const bf16_t* WDOWN = (const bf16_t*)(ws + WS_WDOWN) + (size_t)l * D * DFF;
        const bf16_t* WUQ = (const bf16_t*)(ws + WS_WUQ) + (size_t)l * 768 * 384; const bf16_t* WUKV = (const bf16_t*)(ws + WS_WUKV) + (size_t)l * 1024 * 256;
        const bf16_t* PW = (const bf16_t*)(ws + WS_POOLW) + (size_t)l * 4 * 128 * 128;
        if (FAST & 1) launch_phases(P, pb + PHL_WIN, pb + PHL_WIN + 1, 0, stream);
        else { hipLaunchKernelGGL(slow::k_sgemm<slow::EpiZ>, dim3(ZLD / 64, R / 64), dim3(256), 0, stream, H, D, WIN, D, D, slow::EpiZ{Z});
               hipLaunchKernelGGL(slow::k_rsq, dim3(R / 4), dim3(256), 0, stream, Z, rsq); }
        int premask = 2 | 8;
        if (FAST & 2) premask |= 1;
        else { hipLaunchKernelGGL(slow::k_sgemm<slow::EpiQ>, dim3(768 / 64, R / 64), dim3(256), 0, stream, Z + Z_CQ, ZLD, WUQ, 384, 384, slow::EpiQ{QM, rsq});
               hipLaunchKernelGGL(slow::k_rope_qm, dim3(RX * 128 / 256), dim3(256), 0, stream, QM, cs);
               hipLaunchKernelGGL(slow::k_sgemm<slow::EpiKV>, dim3(1024 / 64, R / 64), dim3(256), 0, stream, Z + Z_CKV, ZLD, WUKV, 256, 256, slow::EpiKV{KN, VM, rsq}); }
        if (FAST & 32) premask |= 4;
        launch_phases(P, pb + PHL_PRE, pb + PHL_PRE + 1, premask, stream);
        if (!(FAST & 32)) { hipLaunchKernelGGL(slow::k_pooled, dim3(R * 512 / 256), dim3(256), 0, stream, Z, ACT);
            for (int g = 0; g < 4; ++g)
                hipLaunchKernelGGL(slow::k_sgemm<slow::EpiPool>, dim3(2, R / 64), dim3(256), 0, stream, ACT + g * 128, 512, PW + (size_t)g * 128 * 128, 128, 128, slow::EpiPool{MIX, g}); }
        if (FAST & 64) launch_phases(P, pb + PHL_ATTN, pb + PHL_ATTN + 1, 0, stream);
        else { hipLaunchKernelGGL(slow::k_attn_diff, dim3(nr * 4 / 2), dim3(128), 0, stream, Z, P.in[IN_DIFFLAM] + l * 256, P.in[IN_SUBLN] + l * 128, lam_init, MIX);
               hipLaunchKernelGGL(slow::k_attn_mla, dim3(nr * 4 / 2), dim3(128), 0, stream, QM, KN, KR, VM, MIX); }
        if (FAST & 4) launch_phases(P, pb + PHL_WOUT, pb + PHL_WOUT + 1, 0, stream);
        else hipLaunchKernelGGL(slow::k_sgemm<slow::EpiY>, dim3(D / 64, nr / 64), dim3(256), 0, stream, MIX, D, WOUT, D, D, slow::EpiY{Y});
        launch_phases(P, pb + PHL_ROWB, pb + PHL_ROWB + 1, 0, stream);
        if (FAST & 8) launch_phases(P, pb + PHL_UP, pb + PHL_UP + 1, 0, stream);
        else hipLaunchKernelGGL(slow::k_sgemm<slow::EpiU>, dim3(UFF / 64, nr / 64), dim3(256), 0, stream, H, D, WUP, D, D, slow::EpiU{U});
        launch_phases(P, pb + PHL_ACT, pb + PHL_ACT + 1, 0, stream);
        if (FAST & 16) launch_phases(P, pb + PHL_DOWN, pb + PHL_DOWN + 1, 0, stream);
        else hipLaunchKernelGGL(slow::k_sgemm<slow::EpiY>, dim3(D / 64, nr / 64), dim3(256), 0, stream, ACT, DFF, WDOWN, DFF, DFF, slow::EpiY{Y});
        launch_phases(P, pb + PHL_ROWC, pb + PHL_ROWC + 1, 0, stream);
    }
}
```

```cpp
#include <hip/hip_runtime.h>
#include <hip/hip_cooperative_groups.h>
#include <cstdint>
#include <cstdio>
#include <cmath>
namespace cg = cooperative_groups;

#define LAS __attribute__((address_space(3)))
typedef unsigned short bf16_t;
typedef short bf16x8 __attribute__((ext_vector_type(8)));
typedef short s16x4 __attribute__((ext_vector_type(4)));
typedef float f32x4 __attribute__((ext_vector_type(4)));
typedef float f32x2 __attribute__((ext_vector_type(2)));
typedef float f32x16 __attribute__((ext_vector_type(16)));
typedef unsigned u32x4 __attribute__((ext_vector_type(4)));
typedef unsigned u32x2 __attribute__((ext_vector_type(2)));

constexpr int D = 2048, NB = 4, SEQ = 2048, CTX = 256, GRIDW = 64;
constexpr int RX = NB * SEQ, RC = NB * CTX, R = RX + RC;
constexpr int INC = 4288, ZLD = 4352, DFF = 5632, UFF = 2 * DFF, MODW = 6 * D;
constexpr float EPS = 1e-6f;
constexpr int Z_POOL = 0, Z_Q = 512, Z_K = 1024, Z_V = 1536, Z_CQ = 2048, Z_CKV = 2432, Z_KR = 2688, Z_GB = 2752, Z_GC = 3264, Z_H = 3776;
constexpr int NWAVES = 8, NTHR = 512;

constexpr size_t MiB = 1u << 20;
constexpr size_t WS_CTL = 0, CTL_BYTES = 1 * MiB;
constexpr size_t WS_RSQ = 64 * 1024;
constexpr size_t WS_MOD = 1 * MiB;
constexpr size_t WS_CS = 2 * MiB;
constexpr size_t WS_POOLW = 3 * MiB;
constexpr size_t WS_WUQ = 4 * MiB;
constexpr size_t WS_WUKV = 6 * MiB;
constexpr size_t WS_WIN = 8 * MiB;
constexpr size_t WS_WOUT = 42 * MiB;
constexpr size_t WS_WUP = 58 * MiB;
constexpr size_t WS_WDOWN = 146 * MiB;
constexpr size_t WS_XR = 190 * MiB;
constexpr size_t WS_H = 262 * MiB;
constexpr size_t WS_BIG = 298 * MiB;
constexpr size_t WS_Z = WS_BIG;
constexpr size_t WS_QM = WS_BIG + 77 * MiB;
constexpr size_t WS_KN = WS_BIG + 91 * MiB;
constexpr size_t WS_VM = WS_BIG + 100 * MiB;
constexpr size_t WS_KR = WS_BIG + 109 * MiB;
constexpr size_t WS_MIX = WS_BIG + 111 * MiB;
constexpr size_t WS_Y = WS_BIG + 147 * MiB;
constexpr size_t WS_U = WS_BIG;
constexpr size_t WS_ACT = WS_BIG + 219 * MiB;
constexpr size_t WS_O1 = WS_ACT + 99 * MiB;
constexpr size_t WS_END = WS_O1 + 32 * MiB;
static_assert(WS_U + (size_t)R * UFF * 2 <= WS_ACT, "U overlay");
static_assert(WS_RSQ + (size_t)2 * R * 2 * 4 <= CTL_BYTES, "rsq in ctl");

struct Params {
    const float* in[24];
    float* out;
    unsigned char* ws;
    int ph_lo, ph_hi;
    int mask, pad;
};
typedef const __attribute__((address_space(4))) Params* KP;
enum { IN_X = 0, IN_C, IN_CTX, IN_CCTX, IN_ADAW, IN_ADAB, IN_GPREMIX, IN_GPOSTMIX, IN_GPREFFN, IN_GPOSTFFN, IN_WIN, IN_POOLW, IN_POOLSCALE, IN_DIFFLAM, IN_SUBLN,
       IN_GQ, IN_WUQ, IN_GKV, IN_WUKV, IN_CONVW, IN_WOUT, IN_WUP, IN_FFNCONVW, IN_WDOWN };
enum { PH_PRO = 0, PH_ROWA = 1, PH_L0 = 2, PHL_WIN = 0, PHL_PRE = 1, PHL_ATTN = 2, PHL_WOUT = 3, PHL_ROWB = 4, PHL_UP = 5, PHL_ACT = 6, PHL_DOWN = 7, PHL_ROWC = 8, PH_PER_LAYER = 9, PH_TOTAL = 2 + 2 * 9 };

__device__ __forceinline__ void rowinfo(int r, int& b, int& t, int& L, int& isc) {
    if (r < RX) { b = r / SEQ; t = r % SEQ; L = SEQ; isc = 0; } else { const int rc = r - RX; b = rc / CTX; t = rc % CTX; L = CTX; isc = 1; }
}
__device__ __forceinline__ float wave_sum(float v) {
#pragma unroll
    for (int o = 1; o < 64; o <<= 1) v += __shfl_xor(v, o);
    return v;
}
__device__ __forceinline__ float wave_max(float v) {
#pragma unroll
    for (int o = 1; o < 64; o <<= 1) v = fmaxf(v, __shfl_xor(v, o));
    return v;
}
__device__ __forceinline__ float sx(float v, int o, int lane) { return __int_as_float(__builtin_amdgcn_ds_bpermute((lane ^ o) << 2, __float_as_int(v))); }
__device__ __forceinline__ float wsum(float v, int lane) {
#pragma unroll
    for (int o = 1; o < 64; o <<= 1) v += sx(v, o, lane);
    return v;
}
typedef __bf16 bf16x2_t __attribute__((ext_vector_type(2)));
__device__ __forceinline__ unsigned cvt_pk_bf16(float lo, float hi) { const f32x2 v = {lo, hi}; const bf16x2_t b = __builtin_convertvector(v, bf16x2_t); return __builtin_bit_cast(unsigned, b); }
__device__ __forceinline__ bf16_t f2bf(float f) { return (bf16_t)(cvt_pk_bf16(f, 0.f) & 0xffffu); }
__device__ __forceinline__ float bf2f(bf16_t h) { return __uint_as_float(((unsigned)h) << 16); }
__device__ __forceinline__ void unpack8(const u32x4 w, float* f) {
    f[0] = __uint_as_float(w.x << 16); f[1] = __uint_as_float(w.x & 0xffff0000u); f[2] = __uint_as_float(w.y << 16); f[3] = __uint_as_float(w.y & 0xffff0000u);
    f[4] = __uint_as_float(w.z << 16); f[5] = __uint_as_float(w.z & 0xffff0000u); f[6] = __uint_as_float(w.w << 16); f[7] = __uint_as_float(w.w & 0xffff0000u);
}
__device__ __forceinline__ u32x4 pack8(const float* f) { u32x4 w; w.x = cvt_pk_bf16(f[0], f[1]); w.y = cvt_pk_bf16(f[2], f[3]); w.z = cvt_pk_bf16(f[4], f[5]); w.w = cvt_pk_bf16(f[6], f[7]); return w; }
__device__ __forceinline__ u32x4 ld16(const bf16_t* p) { return *(const u32x4*)p; }
__device__ __forceinline__ void st16(bf16_t* p, u32x4 v) { *(u32x4*)p = v; }

__host__ __device__ __forceinline__ int uq_pos(int n) { const int h = n / 192, j = n % 192; if (j < 128) return (h >> 1) * 256 + (h & 1) * 128 + j; const int jj = j - 128; return jj < 32 ? 512 + h * 32 + jj : 640 + h * 32 + (jj - 32); }

template <int MAP>
__device__ __forceinline__ void tr_item(const float* __restrict__ W, int K, int N, bf16_t* __restrict__ WT, int ldt, const float* __restrict__ ks, const float* __restrict__ ns, LAS float* scr, int item, int lane) {
    const int nblk = N / 32, kb = item / nblk, nb = item % nblk, k0 = 64 * kb, n0 = 32 * nb;
    const float nsv = ns ? ns[n0 + (lane & 31)] : 1.f;
#pragma unroll 8
    for (int i = 0; i < 32; ++i) { const int kk = 2 * i + (lane >> 5); float v = W[(size_t)(k0 + kk) * N + n0 + (lane & 31)]; if (ks) v *= ks[k0 + kk]; scr[kk * 33 + (lane & 31)] = v * nsv; }
    asm volatile("s_waitcnt lgkmcnt(0)" ::: "memory");
    const int c = lane & 7;
#pragma unroll
    for (int j = 0; j < 4; ++j) { const int n = (lane >> 3) + 8 * j; const LAS float* s = scr + (8 * c) * 33 + n;
        u32x4 o; o.x = cvt_pk_bf16(s[0 * 33], s[1 * 33]); o.y = cvt_pk_bf16(s[2 * 33], s[3 * 33]); o.z = cvt_pk_bf16(s[4 * 33], s[5 * 33]); o.w = cvt_pk_bf16(s[6 * 33], s[7 * 33]);
        const int nn = n0 + n; const int dst = (MAP == 1) ? uq_pos(nn) : nn;
        *(u32x4*)(WT + (size_t)dst * ldt + k0 + 8 * c) = o; }
    asm volatile("s_waitcnt lgkmcnt(0)" ::: "memory");
}

__device__ __forceinline__ void phase_prologue(KP kp, unsigned char* ws, int tid_, LAS unsigned char* lds, int vcu, int G) {
    const int tid = tid_, lane = tid & 63, wave = tid >> 6;
    {
        LAS float* red = (LAS float*)lds;
        float* MOD = (float*)(ws + WS_MOD);
        for (int cb = vcu; cb < 256; cb += G) {
            const int gn0 = cb * 96, l = gn0 / MODW, n0 = gn0 % MODW;
            if (tid < 384) {
                const int cq = tid % 24, kg = tid / 24;
                const float* w = kp->in[IN_ADAW] + ((size_t)l * D + kg * 128) * MODW + n0 + cq * 4;
                f32x4 acc[5];
#pragma unroll
                for (int i = 0; i < 5; ++i) acc[i] = (f32x4){0.f, 0.f, 0.f, 0.f};
#pragma unroll 4
                for (int k = 0; k < 128; ++k) { const f32x4 wv = *(const f32x4*)(w + (size_t)k * MODW); const int kk = kg * 128 + k;
#pragma unroll
                    for (int i = 0; i < 5; ++i) { const float v = (i < 4) ? kp->in[IN_C][i * D + kk] : kp->in[IN_CCTX][kk]; const float s = v / (1.f + __expf(-v)); acc[i] += wv * s; } }
#pragma unroll
                for (int i = 0; i < 5; ++i)
#pragma unroll
                    for (int e = 0; e < 4; ++e) red[(kg * 5 + i) * 96 + cq * 4 + e] = acc[i][e];
            }
            __syncthreads();
            if (tid < 480) { const int i = tid / 96, cn = tid % 96; float s = kp->in[IN_ADAB][l * MODW + n0 + cn];
#pragma unroll
                for (int kg = 0; kg < 16; ++kg) s += red[(kg * 5 + i) * 96 + cn];
                MOD[((size_t)l * 5 + i) * MODW + n0 + cn] = s; }
            __syncthreads();
        }
    }
    {
        float2* cs = (float2*)(ws + WS_CS);
        for (int idx = vcu * NTHR + tid; idx < SEQ * 32; idx += G * NTHR) {
            const int t = idx / 32, i = idx % 32, f = i & 15;
            const float base = ((f & 3) == 0) ? 1.0f : ((f & 3) == 1) ? 0.5623413251903491f : ((f & 3) == 2) ? 0.31622776601683794f : 0.1778279410038923f;
            const float dec = ((f >> 2) == 0) ? 1.0f : ((f >> 2) == 1) ? 0.1f : ((f >> 2) == 2) ? 0.01f : 0.001f;
            const float pos = (i < 16) ? (float)(t / GRIDW) : (float)(t % GRIDW);
            const float ang = pos * (base * dec);
            cs[idx] = make_float2(__cosf(ang), __sinf(ang));
        }
    }
    {
        for (int idx = vcu * NTHR + tid; idx < 2 * 64 * 256; idx += G * NTHR) { const int l = idx / (64 * 256), rem = idx % (64 * 256), row = INC + rem / 256, ch = rem % 256;
            *(u32x4*)((bf16_t*)(ws + WS_WIN) + ((size_t)l * ZLD + row) * D + ch * 8) = (u32x4){0u, 0u, 0u, 0u}; }
    }
    {
        LAS float* scr = (LAS float*)(lds + 32768) + wave * (64 * 33);
        constexpr int I_IN = 32 * 134, I_OUT = 32 * 64, I_UP = 32 * 352, I_DOWN = 88 * 64, I_UQ = 6 * 24, I_UKV = 4 * 32, I_POOL = 4 * 8;
        constexpr int I_LAYER = I_IN + I_OUT + I_UP + I_DOWN + I_UQ + I_UKV + I_POOL;
        const int gw = vcu * NWAVES + wave, NGW = G * NWAVES;
        for (int it = gw; it < 2 * I_LAYER; it += NGW) {
            const int l = it / I_LAYER; int r = it % I_LAYER;
            if (r < I_IN) { tr_item<0>(kp->in[IN_WIN] + (size_t)l * D * INC, D, INC, (bf16_t*)(ws + WS_WIN) + (size_t)l * ZLD * D, D, nullptr, nullptr, scr, r, lane); continue; } r -= I_IN;
            if (r < I_OUT) { tr_item<0>(kp->in[IN_WOUT] + (size_t)l * D * D, D, D, (bf16_t*)(ws + WS_WOUT) + (size_t)l * D * D, D, nullptr, nullptr, scr, r, lane); continue; } r -= I_OUT;
            if (r < I_UP) { tr_item<0>(kp->in[IN_WUP] + (size_t)l * D * UFF, D, UFF, (bf16_t*)(ws + WS_WUP) + (size_t)l * UFF * D, D, nullptr, nullptr, scr, r, lane); continue; } r -= I_UP;
            if (r < I_DOWN) { tr_item<0>(kp->in[IN_WDOWN] + (size_t)l * DFF * D, DFF, D, (bf16_t*)(ws + WS_WDOWN) + (size_t)l * D * DFF, DFF, nullptr, nullptr, scr, r, lane); continue; } r -= I_DOWN;
            if (r < I_UQ) { tr_item<1>(kp->in[IN_WUQ] + (size_t)l * 384 * 768, 384, 768, (bf16_t*)(ws + WS_WUQ) + (size_t)l * 768 * 384, 384, kp->in[IN_GQ] + l * 384, nullptr, scr, r, lane); continue; } r -= I_UQ;
            if (r < I_UKV) { tr_item<0>(kp->in[IN_WUKV] + (size_t)l * 256 * 1024, 256, 1024, (bf16_t*)(ws + WS_WUKV) + (size_t)l * 1024 * 256, 256, kp->in[IN_GKV] + l * 256, nullptr, scr, r, lane); continue; } r -= I_UKV;
            { const int g = r / 8, rr = r % 8;
              tr_item<0>(kp->in[IN_POOLW] + ((size_t)l * 4 + g) * 128 * 128, 128, 128, (bf16_t*)(ws + WS_POOLW) + ((size_t)l * 4 + g) * 128 * 128, 128, nullptr, kp->in[IN_POOLSCALE] + l * 512 + g * 128, scr, rr, lane); }
        }
    }
}

__device__ __forceinline__ void rowpass_row(const float* __restrict__ xin, const float* __restrict__ y, const float* __restrict__ ygain, const float* __restrict__ gate, float* __restrict__ xout,
                                            const float* __restrict__ ngain, const float* __restrict__ shift, const float* __restrict__ scale, bf16_t* __restrict__ hout, int lane) {
    f32x4 xv[8];
#pragma unroll
    for (int j = 0; j < 8; ++j) xv[j] = *(const f32x4*)(xin + j * 256 + lane * 4);
    if (y) {
        f32x4 yv[8]; float ss = 0.f;
#pragma unroll
        for (int j = 0; j < 8; ++j) { yv[j] = *(const f32x4*)(y + j * 256 + lane * 4); ss += (yv[j].x * yv[j].x + yv[j].y * yv[j].y) + (yv[j].z * yv[j].z + yv[j].w * yv[j].w); }
        ss = wsum(ss, lane); const float rs = 1.0f / sqrtf(ss * (1.f / D) + EPS);
#pragma unroll
        for (int j = 0; j < 8; ++j) { const f32x4 gg = *(const f32x4*)(gate + j * 256 + lane * 4), yg = *(const f32x4*)(ygain + j * 256 + lane * 4); xv[j] += gg * (yv[j] * rs * yg); }
    }
    if (xout) {
#pragma unroll
        for (int j = 0; j < 8; ++j) *(f32x4*)(xout + j * 256 + lane * 4) = xv[j];
    }
    if (hout) {
        float ss = 0.f;
#pragma unroll
        for (int j = 0; j < 8; ++j) ss += (xv[j].x * xv[j].x + xv[j].y * xv[j].y) + (xv[j].z * xv[j].z + xv[j].w * xv[j].w);
        ss = wsum(ss, lane); const float rs = 1.0f / sqrtf(ss * (1.f / D) + EPS);
#pragma unroll
        for (int j = 0; j < 8; ++j) { const f32x4 ng = *(const f32x4*)(ngain + j * 256 + lane * 4), sc = *(const f32x4*)(scale + j * 256 + lane * 4), sh = *(const f32x4*)(shift + j * 256 + lane * 4);
            const f32x4 o = (xv[j] * rs * ng) * (sc + 1.f) + sh; u32x2 w; w.x = cvt_pk_bf16(o.x, o.y); w.y = cvt_pk_bf16(o.z, o.w);
            *(u32x2*)(hout + j * 256 + lane * 4) = w; }
    }
}
__device__ __forceinline__ void phase_rowpass(KP kp, unsigned char* ws, int tid_, int kind, int l, int vcu, int G) {
    const int lane = tid_ & 63, wave = tid_ >> 6;
    const float* MOD = (const float*)(ws + WS_MOD);
    float* XR = (float*)(ws + WS_XR); const float* Y = (const float*)(ws + WS_Y); bf16_t* H = (bf16_t*)(ws + WS_H);
    const bool last = (l == 1);
    const int nrows = (kind == 0) ? R : (last ? RX : R);
    for (int r = vcu * NWAVES + wave; r < nrows; r += G * NWAVES) {
        int b, t, L, isc; rowinfo(r, b, t, L, isc); const int mi = isc ? 4 : b;
        const float* m = MOD + ((size_t)l * 5 + mi) * MODW;
        const float* xin0 = isc ? kp->in[IN_CTX] + (size_t)(r - RX) * D : kp->in[IN_X] + (size_t)r * D;
        if (kind == 0) {
            rowpass_row(xin0, nullptr, nullptr, nullptr, nullptr, kp->in[IN_GPREMIX], m + 0 * D, m + 1 * D, H + (size_t)r * D, lane);
        } else if (kind == 1) {
            const float* xin = (l == 0) ? xin0 : XR + (size_t)r * D;
            rowpass_row(xin, Y + (size_t)r * D, kp->in[IN_GPOSTMIX] + l * D, m + 2 * D, XR + (size_t)r * D, kp->in[IN_GPREFFN] + l * D, m + 3 * D, m + 4 * D, H + (size_t)r * D, lane);
        } else {
            if (!last) { const float* m1 = MOD + ((size_t)1 * 5 + mi) * MODW;
                rowpass_row(XR + (size_t)r * D, Y + (size_t)r * D, kp->in[IN_GPOSTFFN] + l * D, m + 5 * D, XR + (size_t)r * D, kp->in[IN_GPREMIX] + 1 * D, m1 + 0 * D, m1 + 1 * D, H + (size_t)r * D, lane);
            } else {
                rowpass_row(XR + (size_t)r * D, Y + (size_t)r * D, kp->in[IN_GPOSTFFN] + l * D, m + 5 * D, kp->out + (size_t)r * D, nullptr, nullptr, nullptr, nullptr, lane);
            }
        }
    }
}

__device__ __forceinline__ void pre_rope(KP kp, unsigned char* ws, int tid_, int vcu, int G) {
    bf16_t* Z = (bf16_t*)(ws + WS_Z); bf16_t* KR = (bf16_t*)(ws + WS_KR); const float2* cs = (const float2*)(ws + WS_CS);
    const int gt = vcu * NTHR + tid_, NGT = G * NTHR;
    for (int idx = gt; idx < RX * 68; idx += NGT) {
        const int ic = idx & 3, v = (idx >> 2) % 17, r = idx / 68, t = r % SEQ;
        const int col = (v < 16) ? Z_Q + v * 64 : Z_KR;
        const bf16_t* src = Z + (size_t)r * ZLD + col + ic * 8;
        float x1[8], x2[8], o1[8], o2[8]; unpack8(ld16(src), x1); unpack8(ld16(src + 32), x2);
        const f32x4* cp = (const f32x4*)(cs + t * 32 + ic * 8);
#pragma unroll
        for (int q = 0; q < 4; ++q) { const f32x4 c2 = cp[q];
            o1[2 * q] = x1[2 * q] * c2.x - x2[2 * q] * c2.y; o2[2 * q] = x1[2 * q] * c2.y + x2[2 * q] * c2.x;
            o1[2 * q + 1] = x1[2 * q + 1] * c2.z - x2[2 * q + 1] * c2.w; o2[2 * q + 1] = x1[2 * q + 1] * c2.w + x2[2 * q + 1] * c2.z; }
        bf16_t* dst = (v < 16) ? Z + (size_t)r * ZLD + col + ic * 8 : KR + (size_t)r * 64 + ic * 8;
        st16(dst, pack8(o1)); st16(dst + 32, pack8(o2));
    }
    for (int idx = gt; idx < RC * 8; idx += NGT) { const int r = RX + idx / 8, ch = idx % 8; st16(KR + (size_t)r * 64 + ch * 8, ld16(Z + (size_t)r * ZLD + Z_KR + ch * 8)); }
}
__device__ __forceinline__ void pre_conv(KP kp, unsigned char* ws, int tid_, int l, int vcu, int G) {
    const bf16_t* Z = (const bf16_t*)(ws + WS_Z); bf16_t* MIX = (bf16_t*)(ws + WS_MIX);
    const float* cw = kp->in[IN_CONVW] + (size_t)l * 3 * 512;
    const int gt = vcu * NTHR + tid_, NGT = G * NTHR;
    for (int idx = gt; idx < R * 64; idx += NGT) {
        const int ch = idx & 63, r = idx >> 6, c0 = ch * 8; int b, t, L, isc; rowinfo(r, b, t, L, isc);
        float s[8];
#pragma unroll
        for (int e = 0; e < 8; ++e) s[e] = 0.f;
#pragma unroll
        for (int k = 0; k < 3; ++k) { const int tt = t + k - 1;
            if (tt >= 0 && tt < L) { const bf16_t* zr = Z + (size_t)(r + k - 1) * ZLD; float gc[8], hh[8]; unpack8(ld16(zr + Z_GC + c0), gc); unpack8(ld16(zr + Z_H + c0), hh);
                const f32x4 w0 = *(const f32x4*)(cw + k * 512 + c0), w1 = *(const f32x4*)(cw + k * 512 + c0 + 4);
                s[0] += w0.x * gc[0] * hh[0]; s[1] += w0.y * gc[1] * hh[1]; s[2] += w0.z * gc[2] * hh[2]; s[3] += w0.w * gc[3] * hh[3];
                s[4] += w1.x * gc[4] * hh[4]; s[5] += w1.y * gc[5] * hh[5]; s[6] += w1.z * gc[6] * hh[6]; s[7] += w1.w * gc[7] * hh[7]; } }
        float gb[8]; unpack8(ld16(Z + (size_t)r * ZLD + Z_GB + c0), gb);
#pragma unroll
        for (int e = 0; e < 8; ++e) s[e] *= gb[e];
        st16(MIX + (size_t)r * D + 1536 + c0, pack8(s));
    }
}
__device__ __forceinline__ void pre_pool(KP kp, unsigned char* ws, int tid_, int l, int vcu, int G) {
    const bf16_t* Z = (const bf16_t*)(ws + WS_Z); bf16_t* MIX = (bf16_t*)(ws + WS_MIX);
    const bf16_t* PW = (const bf16_t*)(ws + WS_POOLW) + (size_t)l * 4 * 128 * 128;
    const int lane = tid_ & 63, wave = tid_ >> 6, fr = lane & 15, fq = lane >> 4;
    for (int item = vcu * NWAVES + wave; item < (R / 16) * 4; item += G * NWAVES) {
        const int g = item & 3, rt = item >> 2, r = rt * 16 + fr; int b, t, L, isc; rowinfo(r, b, t, L, isc);
        const int half = 1 << g; int lo = t - half; if (lo < 0) lo = 0; int hi = t + half; if (hi > L) hi = L;
        const float inv = 1.0f / (float)(hi - lo);
        float acc[4][8];
#pragma unroll
        for (int kk = 0; kk < 4; ++kk)
#pragma unroll
            for (int e = 0; e < 8; ++e) acc[kk][e] = 0.f;
        const bf16_t* zc = Z + Z_POOL + g * 128 + fq * 8;
        for (int tt = lo; tt < hi; ++tt) { const bf16_t* zr = zc + (size_t)(r - t + tt) * ZLD;
#pragma unroll
            for (int kk = 0; kk < 4; ++kk) { float v[8]; unpack8(ld16(zr + kk * 32), v);
#pragma unroll
                for (int e = 0; e < 8; ++e) acc[kk][e] += v[e]; } }
        bf16x8 a[4];
#pragma unroll
        for (int kk = 0; kk < 4; ++kk) { float v[8]; unpack8(ld16(zc + (size_t)r * ZLD + kk * 32), v);
#pragma unroll
            for (int e = 0; e < 8; ++e) v[e] = acc[kk][e] * inv - v[e];
            const u32x4 w = pack8(v); a[kk] = *(const bf16x8*)&w; }
        const bf16_t* pw = PW + (size_t)g * 128 * 128;
#pragma unroll
        for (int n = 0; n < 8; ++n) { f32x4 c = (f32x4){0.f, 0.f, 0.f, 0.f};
#pragma unroll
            for (int kk = 0; kk < 4; ++kk) { const u32x4 bw = ld16(pw + (size_t)(16 * n + fr) * 128 + kk * 32 + fq * 8); c = __builtin_amdgcn_mfma_f32_16x16x32_bf16(*(const bf16x8*)&bw, a[kk], c, 0, 0, 0); }
            u32x2 w; w.x = cvt_pk_bf16(c[0], c[1]); w.y = cvt_pk_bf16(c[2], c[3]);
            *(u32x2*)(MIX + (size_t)r * D + g * 128 + 16 * n + 4 * fq) = w; }
    }
}
__device__ __forceinline__ void phase_act(KP kp, unsigned char* ws, int tid_, int l, int vcu, int G) {
    const bf16_t* U = (const bf16_t*)(ws + WS_U); bf16_t* ACT = (bf16_t*)(ws + WS_ACT);
    const float* cw = kp->in[IN_FFNCONVW] + (size_t)l * 3 * UFF;
    const int nrows = (l == 1) ? RX : R;
    const int gt = vcu * NTHR + tid_, NGT = G * NTHR;
    for (int idx = gt; idx < (nrows / 16) * 704; idx += NGT) {
        const int chn = idx % 704, strip = idx / 704, r0 = strip * 16, j0 = chn * 8; int b, t0, L, isc; rowinfo(r0, b, t0, L, isc);
        float wg[3][8], wv[3][8];
#pragma unroll
        for (int k = 0; k < 3; ++k) { const f32x4 a0 = *(const f32x4*)(cw + k * UFF + j0), a1 = *(const f32x4*)(cw + k * UFF + j0 + 4), b0 = *(const f32x4*)(cw + k * UFF + DFF + j0), b1 = *(const f32x4*)(cw + k * UFF + DFF + j0 + 4);
            wg[k][0] = a0.x; wg[k][1] = a0.y; wg[k][2] = a0.z; wg[k][3] = a0.w; wg[k][4] = a1.x; wg[k][5] = a1.y; wg[k][6] = a1.z; wg[k][7] = a1.w;
            wv[k][0] = b0.x; wv[k][1] = b0.y; wv[k][2] = b0.z; wv[k][3] = b0.w; wv[k][4] = b1.x; wv[k][5] = b1.y; wv[k][6] = b1.z; wv[k][7] = b1.w; }
        float pg[8], pv[8], cg_[8], cv[8], ng[8], nv[8];
        const bf16_t* ub = U + (size_t)r0 * UFF + j0;
        if (t0 > 0) { unpack8(ld16(ub - UFF), pg); unpack8(ld16(ub - UFF + DFF), pv); } else {
#pragma unroll
            for (int e = 0; e < 8; ++e) { pg[e] = 0.f; pv[e] = 0.f; } }
        unpack8(ld16(ub), cg_); unpack8(ld16(ub + DFF), cv);
#pragma unroll 1
        for (int i = 0; i < 16; ++i) {
            if (t0 + i + 1 < L) { unpack8(ld16(ub + (size_t)(i + 1) * UFF), ng); unpack8(ld16(ub + (size_t)(i + 1) * UFF + DFF), nv); } else {
#pragma unroll
                for (int e = 0; e < 8; ++e) { ng[e] = 0.f; nv[e] = 0.f; } }
            float o[8];
#pragma unroll
            for (int e = 0; e < 8; ++e) { const float gsum = wg[0][e] * pg[e] + wg[1][e] * cg_[e] + wg[2][e] * ng[e]; const float vsum = wv[0][e] * pv[e] + wv[1][e] * cv[e] + wv[2][e] * nv[e];
                o[e] = gsum * __builtin_amdgcn_rcpf(1.f + __expf(-gsum)) * vsum; }
            st16(ACT + (size_t)(r0 + i) * DFF + j0, pack8(o));
#pragma unroll
            for (int e = 0; e < 8; ++e) { pg[e] = cg_[e]; pv[e] = cv[e]; cg_[e] = ng[e]; cv[e] = nv[e]; }
        }
    }
}


namespace pg8 {
constexpr int BM = 256, BK = 64, HALF = 128, HTB = HALF * BK * 2, STAGE_BYTES = 8 * HTB, NXCD = 8, WGM = 8;
__host__ __device__ __forceinline__ int lds_byte(int r, int c) { const int st = (r >> 4) * 2 + (c >> 5), rr = r & 15, cc = c & 31, ob = rr * 64 + cc * 2; return st * 1024 + (ob ^ (((ob >> 9) & 1) << 5)); }
__host__ __device__ __forceinline__ void stage_rc(int b, int& R_, int& C_) { const int st = b / 1024, sb = b % 1024, swz = sb ^ (((sb >> 9) & 1) << 5); R_ = (st >> 1) * 16 + swz / 64; C_ = (st & 1) * 32 + (swz % 64) / 2; }
__host__ __device__ __forceinline__ int perm32(int rho) { const int n = rho >> 4, i = rho & 15; return 8 * (i >> 2) + 4 * n + (i & 3); }
struct Unit { int pm, pn; };
struct Gemm { const bf16_t* A; const bf16_t* Bt; int lda, ldb, K; };
struct TileOrder {
    int nM, nN, nwg, G, c;
    __device__ void init(int nM_, int nN_, int G_, int c_) { nM = nM_; nN = nN_; nwg = nM * nN; G = G_; c = c_; }
    __device__ bool next(int i, Unit& u) const {
        const long L = (long)i * G + c; if (L >= nwg) return false;
        int wgid = (int)L; { const int q = nwg / NXCD, r = nwg % NXCD, xcd = wgid % NXCD, off = wgid / NXCD; wgid = (xcd < r ? xcd * (q + 1) : r * (q + 1) + (xcd - r) * q) + off; }
        const int nig = WGM * nN, gid = wgid / nig, fm = gid * WGM, gsz = (nM - fm) < WGM ? (nM - fm) : WGM;
        u.pm = fm + ((wgid % nig) % gsz); u.pn = (wgid % nig) / gsz; return true;
    }
};
typedef f32x4 Acc[2][2][4][2];
template <class Epi, class Sched, bool ALIGN_EPI>
__device__ __forceinline__ void gemm_phase(LAS unsigned char* lds, const Gemm g, const Sched& S, const Epi& E, int tid) {
    const int wid = __builtin_amdgcn_readfirstlane(tid >> 6), lane = tid & 63, wr = wid >> 2, wc = wid & 3, fr = lane & 15, fq = lane >> 4;
    const int nt = g.K / BK;
    unsigned voffA[2], voffB[2];
#pragma unroll
    for (int i = 0; i < 2; ++i) { int R_, C_; stage_rc(tid * 16 + i * 8192, R_, C_); const int Rb = Epi::PERM ? ((R_ & ~31) + perm32(R_ & 31)) : R_;
        voffA[i] = (unsigned)(R_ * g.lda + C_) * 2u; voffB[i] = (unsigned)(Rb * g.ldb + C_) * 2u; }
    const size_t kstep = (size_t)(BK * 2);
    const size_t hstepA = (size_t)HALF * g.lda * 2, hstepB = (size_t)HALF * g.ldb * 2;
    const size_t tstepA = 2 * hstepA, tstepB = 2 * hstepB;
    const unsigned ldsw = (unsigned)wid * 1024u;
    const int aoff = lds_byte(wr * 64 + fr, fq * 8), boff = lds_byte(wc * 32 + fr, fq * 8);
#define PG8_SA(b, h) (((b) * 2 + (h)) * HTB)
#define PG8_SB(b, h) ((4 + (b) * 2 + (h)) * HTB)
#define PG8_STAGE(bufoff, gbase, voff) do { _Pragma("unroll") for (int _i = 0; _i < 2; ++_i) \
        __builtin_amdgcn_global_load_lds((const unsigned*)((const char*)(gbase) + (voff)[_i]), (LAS unsigned*)(lds + (bufoff) + ldsw + _i * 8192), 16, 0, 0); } while (0)
#define PG8_LDA(dst, b, h) do { _Pragma("unroll") for (int m = 0; m < 4; ++m) _Pragma("unroll") for (int k = 0; k < 2; ++k) dst[m][k] = *(const LAS bf16x8*)(lds + PG8_SA(b, h) + aoff + m * 2048 + k * 1024); } while (0)
#define PG8_LDB(dst, b, h) do { _Pragma("unroll") for (int n = 0; n < 2; ++n) _Pragma("unroll") for (int k = 0; k < 2; ++k) dst[n][k] = *(const LAS bf16x8*)(lds + PG8_SB(b, h) + boff + n * 2048 + k * 1024); } while (0)
#define PG8_MMA(ai, bj, At, Bt) do { __builtin_amdgcn_s_setprio(1); _Pragma("unroll") for (int m = 0; m < 4; ++m) _Pragma("unroll") for (int n = 0; n < 2; ++n) _Pragma("unroll") for (int k = 0; k < 2; ++k) \
        acc[ai][bj][m][n] = __builtin_amdgcn_mfma_f32_16x16x32_bf16(Bt[n][k], At[m][k], acc[ai][bj][m][n], 0, 0, 0); __builtin_amdgcn_s_setprio(0); } while (0)
#define PG8_WAIT_V(n) asm volatile("s_waitcnt vmcnt(" #n ")" ::: "memory")
#define PG8_WAIT_L(n) asm volatile("s_waitcnt lgkmcnt(" #n ")" ::: "memory")
#define PG8_BAR __builtin_amdgcn_s_barrier()
#define PG8_SCHED __builtin_amdgcn_sched_barrier(0)
    Unit cur, nxt; int ui = 0;
    if (!S.next(0, cur)) return;
    f32x4 acc[2][2][4][2];
#pragma unroll
    for (int a = 0; a < 2; ++a)
#pragma unroll
        for (int b = 0; b < 2; ++b)
#pragma unroll
            for (int m = 0; m < 4; ++m)
#pragma unroll
                for (int n = 0; n < 2; ++n) acc[a][b][m][n] = (f32x4){0.f, 0.f, 0.f, 0.f};
    bf16x8 At[4][2], B0[2][2], B1[2][2];
    const char* cA = (const char*)g.A + (size_t)cur.pm * tstepA; const char* cB = (const char*)g.Bt + (size_t)cur.pn * tstepB;
    PG8_STAGE(PG8_SB(0, 0), cB, voffB); PG8_STAGE(PG8_SB(0, 1), cB + hstepB, voffB); PG8_STAGE(PG8_SA(0, 0), cA, voffA); PG8_STAGE(PG8_SA(0, 1), cA + hstepA, voffA);
    if (wr == 1) PG8_BAR;
    PG8_WAIT_V(2); PG8_BAR;
    PG8_STAGE(PG8_SB(1, 0), cB + kstep, voffB); PG8_STAGE(PG8_SA(1, 0), cA + kstep, voffA); PG8_STAGE(PG8_SB(1, 1), cB + hstepB + kstep, voffB);
    PG8_WAIT_V(6); PG8_BAR;
    for (;;) {
        const bool has_next = S.next(ui + 1, nxt);
        const char* nA = has_next ? (const char*)g.A + (size_t)nxt.pm * tstepA : cA; const char* nB = has_next ? (const char*)g.Bt + (size_t)nxt.pn * tstepB : cB;
#pragma unroll 1
        for (int t = 0; t < nt; t += 2) {
            const bool last = (t == nt - 2);
            const char* a1 = cA + (size_t)(t + 1) * kstep;
            const char* a2 = last ? nA : cA + (size_t)(t + 2) * kstep; const char* b2 = last ? nB : cB + (size_t)(t + 2) * kstep;
            const char* a3 = a2 + kstep; const char* b3 = b2 + kstep;
            PG8_LDB(B0, 0, 0); PG8_LDB(B1, 0, 1); PG8_SCHED; PG8_LDA(At, 0, 0); PG8_STAGE(PG8_SA(1, 1), a1 + hstepA, voffA);
            PG8_WAIT_V(8); PG8_WAIT_L(0); PG8_BAR; PG8_MMA(0, 0, At, B0); PG8_MMA(0, 1, At, B1); PG8_BAR; PG8_SCHED;
            PG8_LDA(At, 0, 1); PG8_STAGE(PG8_SB(0, 0), b2, voffB); PG8_STAGE(PG8_SB(0, 1), b2 + hstepB, voffB); PG8_STAGE(PG8_SA(0, 0), a2, voffA);
            PG8_WAIT_V(8); PG8_WAIT_L(0); PG8_BAR; PG8_MMA(1, 0, At, B0); PG8_MMA(1, 1, At, B1); PG8_BAR; PG8_SCHED;
            PG8_LDB(B0, 1, 0); PG8_LDB(B1, 1, 1); PG8_SCHED; PG8_LDA(At, 1, 0); PG8_STAGE(PG8_SA(0, 1), a2 + hstepA, voffA);
            PG8_WAIT_V(8); PG8_WAIT_L(0); PG8_BAR; PG8_MMA(0, 0, At, B0); PG8_MMA(0, 1, At, B1); PG8_BAR; PG8_SCHED;
            PG8_LDA(At, 1, 1); PG8_STAGE(PG8_SB(1, 0), b3, voffB); PG8_STAGE(PG8_SB(1, 1), b3 + hstepB, voffB); PG8_STAGE(PG8_SA(1, 0), a3, voffA);
            PG8_WAIT_V(8); PG8_WAIT_L(0); PG8_BAR; PG8_MMA(1, 0, At, B0); PG8_MMA(1, 1, At, B1); PG8_BAR; PG8_SCHED;
        }
        if constexpr (ALIGN_EPI) { if (wr == 0) PG8_BAR; }
        E(acc, cur, wr, wc, fr, fq);
        if (!has_next) break;
#pragma unroll
        for (int a = 0; a < 2; ++a)
#pragma unroll
            for (int b = 0; b < 2; ++b)
#pragma unroll
                for (int m = 0; m < 4; ++m)
#pragma unroll
                    for (int n = 0; n < 2; ++n) acc[a][b][m][n] = (f32x4){0.f, 0.f, 0.f, 0.f};
        cur = nxt; cA = nA; cB = nB; ++ui;
        if constexpr (ALIGN_EPI) { if (wr == 1) PG8_BAR; }
    }
    PG8_WAIT_V(0);
    if constexpr (!ALIGN_EPI) { if (wr == 0) PG8_BAR; }
    PG8_BAR;
#undef PG8_SA
#undef PG8_SB
#undef PG8_STAGE
#undef PG8_LDA
#undef PG8_LDB
#undef PG8_MMA
#undef PG8_WAIT_V
#undef PG8_WAIT_L
#undef PG8_BAR
#undef PG8_SCHED
}

struct EpiF32 {
    static constexpr bool PERM = false;
    float* C; int ldc;
    __device__ __forceinline__ void operator()(const Acc& acc, const Unit& u, int wr, int wc, int fr, int fq) const {
        const int row0 = u.pm * BM + wr * 64 + fr, col0 = u.pn * BM + wc * 32 + 4 * fq;
#pragma unroll
        for (int ai = 0; ai < 2; ++ai)
#pragma unroll
            for (int m = 0; m < 4; ++m) { float* rowp = C + (size_t)(row0 + ai * HALF + m * 16) * ldc + col0;
#pragma unroll
                for (int bj = 0; bj < 2; ++bj)
#pragma unroll
                    for (int n = 0; n < 2; ++n) *(f32x4*)(rowp + bj * HALF + n * 16) = acc[ai][bj][m][n]; }
    }
};
struct EpiBf16 {
    static constexpr bool PERM = true;
    bf16_t* O; int ldc;
    __device__ __forceinline__ void operator()(const Acc& acc, const Unit& u, int wr, int wc, int fr, int fq) const {
        const int row0 = u.pm * BM + wr * 64 + fr, col0 = u.pn * BM + wc * 32 + 8 * fq;
#pragma unroll
        for (int ai = 0; ai < 2; ++ai)
#pragma unroll
            for (int m = 0; m < 4; ++m) { bf16_t* rowp = O + (size_t)(row0 + ai * HALF + m * 16) * ldc + col0;
#pragma unroll
                for (int bj = 0; bj < 2; ++bj) { const f32x4 v0 = acc[ai][bj][m][0], v1 = acc[ai][bj][m][1];
                    u32x4 w; w.x = cvt_pk_bf16(v0[0], v0[1]); w.y = cvt_pk_bf16(v0[2], v0[3]); w.z = cvt_pk_bf16(v1[0], v1[1]); w.w = cvt_pk_bf16(v1[2], v1[3]);
                    *(u32x4*)(rowp + bj * HALF) = w; } }
    }
};
struct EpiZ {
    static constexpr bool PERM = true;
    bf16_t* Z; float* rsq;
    __device__ __forceinline__ void operator()(const Acc& acc, const Unit& u, int wr, int wc, int fr, int fq) const {
        const int row0 = u.pm * BM + wr * 64 + fr, col0 = u.pn * BM + wc * 32 + 8 * fq;
#pragma unroll
        for (int ai = 0; ai < 2; ++ai)
#pragma unroll
            for (int m = 0; m < 4; ++m) { bf16_t* rowp = Z + (size_t)(row0 + ai * HALF + m * 16) * ZLD + col0;
#pragma unroll
                for (int bj = 0; bj < 2; ++bj) { const f32x4 v0 = acc[ai][bj][m][0], v1 = acc[ai][bj][m][1];
                    u32x4 w; w.x = cvt_pk_bf16(v0[0], v0[1]); w.y = cvt_pk_bf16(v0[2], v0[3]); w.z = cvt_pk_bf16(v1[0], v1[1]); w.w = cvt_pk_bf16(v1[2], v1[3]);
                    *(u32x4*)(rowp + bj * HALF) = w; } }
        if (u.pn >= 8 && u.pn <= 10) {
#pragma unroll
            for (int bj = 0; bj < 2; ++bj) { const int cb = u.pn * BM + bj * HALF + wc * 32;
                const int region = (cb >= Z_CQ && cb < Z_CKV) ? 0 : ((cb >= Z_CKV && cb < Z_KR) ? 1 : -1);
                if (region >= 0) {
#pragma unroll
                    for (int ai = 0; ai < 2; ++ai)
#pragma unroll
                        for (int m = 0; m < 4; ++m) { const f32x4 v0 = acc[ai][bj][m][0], v1 = acc[ai][bj][m][1];
                            float s = (v0[0] * v0[0] + v0[1] * v0[1]) + (v0[2] * v0[2] + v0[3] * v0[3]) + (v1[0] * v1[0] + v1[1] * v1[1]) + (v1[2] * v1[2] + v1[3] * v1[3]);
                            s += sx(s, 16, fq * 16 + fr); s += sx(s, 32, fq * 16 + fr);
                            if (fq == 0) atomicAdd(rsq + (size_t)(row0 + ai * HALF + m * 16) * 2 + region, s); } } }
        }
    }
};
struct EpiQ {
    static constexpr bool PERM = true;
    bf16_t* QM; const float* rsq; const float2* cs;
    __device__ __forceinline__ void operator()(const Acc& acc, const Unit& u, int wr, int wc, int fr, int fq) const {
        const int row0 = u.pm * BM + wr * 64 + fr;
#pragma unroll
        for (int ai = 0; ai < 2; ++ai)
#pragma unroll
            for (int m = 0; m < 4; ++m) { const int row = row0 + ai * HALF + m * 16; const float rs = 1.0f / sqrtf(rsq[(size_t)row * 2] * (1.f / 384.f) + EPS);
                if (u.pn < 2) {
#pragma unroll
                    for (int bj = 0; bj < 2; ++bj) { const f32x4 v0 = acc[ai][bj][m][0] * rs, v1 = acc[ai][bj][m][1] * rs;
                        u32x4 w; w.x = cvt_pk_bf16(v0[0], v0[1]); w.y = cvt_pk_bf16(v0[2], v0[3]); w.z = cvt_pk_bf16(v1[0], v1[1]); w.w = cvt_pk_bf16(v1[2], v1[3]);
                        *(u32x4*)(QM + (size_t)row * 768 + (2 * u.pn + bj) * 192 + wc * 32 + 8 * fq) = w; }
                } else {
                    float x1[8], x2[8], o1[8], o2[8];
#pragma unroll
                    for (int e = 0; e < 4; ++e) { x1[e] = acc[ai][0][m][0][e] * rs; x1[4 + e] = acc[ai][0][m][1][e] * rs; x2[e] = acc[ai][1][m][0][e] * rs; x2[4 + e] = acc[ai][1][m][1][e] * rs; }
                    if (row < RX) { const f32x4* cp = (const f32x4*)(cs + (row % SEQ) * 32 + 8 * fq);
#pragma unroll
                        for (int q = 0; q < 4; ++q) { const f32x4 c2 = cp[q];
                            o1[2 * q] = x1[2 * q] * c2.x - x2[2 * q] * c2.y; o2[2 * q] = x1[2 * q] * c2.y + x2[2 * q] * c2.x;
                            o1[2 * q + 1] = x1[2 * q + 1] * c2.z - x2[2 * q + 1] * c2.w; o2[2 * q + 1] = x1[2 * q + 1] * c2.w + x2[2 * q + 1] * c2.z; }
                    } else {
#pragma unroll
                        for (int e = 0; e < 8; ++e) { o1[e] = x1[e]; o2[e] = x2[e]; } }
                    bf16_t* dst = QM + (size_t)row * 768 + wc * 192 + 128 + 8 * fq;
                    st16(dst, pack8(o1)); st16(dst + 32, pack8(o2));
                }
                asm volatile("" ::: "memory"); }
    }
};
struct EpiKV {
    static constexpr bool PERM = true;
    bf16_t* KN; bf16_t* VM; const float* rsq;
    __device__ __forceinline__ void operator()(const Acc& acc, const Unit& u, int wr, int wc, int fr, int fq) const {
        const int row0 = u.pm * BM + wr * 64 + fr;
#pragma unroll
        for (int ai = 0; ai < 2; ++ai)
#pragma unroll
            for (int m = 0; m < 4; ++m) { const int row = row0 + ai * HALF + m * 16; const float rs = 1.0f / sqrtf(rsq[(size_t)row * 2 + 1] * (1.f / 256.f) + EPS);
#pragma unroll
                for (int bj = 0; bj < 2; ++bj) { const f32x4 v0 = acc[ai][bj][m][0] * rs, v1 = acc[ai][bj][m][1] * rs;
                    u32x4 w; w.x = cvt_pk_bf16(v0[0], v0[1]); w.y = cvt_pk_bf16(v0[2], v0[3]); w.z = cvt_pk_bf16(v1[0], v1[1]); w.w = cvt_pk_bf16(v1[2], v1[3]);
                    *(u32x4*)((bj ? VM : KN) + (size_t)row * 512 + u.pn * 128 + wc * 32 + 8 * fq) = w; }
                asm volatile("" ::: "memory"); }
    }
};
template <class Epi>
__device__ __forceinline__ void run(LAS unsigned char* lds, const Gemm g, int nM, int nN, int G, int c, const Epi& E, int tid) {
    TileOrder S; S.init(nM, nN, G, c);
    gemm_phase<Epi, TileOrder, true>(lds, g, S, E, tid);
}
}


namespace att {
constexpr int SHM_V = 64 * 128 * 2;
#define SBAR() __builtin_amdgcn_sched_barrier(0)
__device__ __forceinline__ int crow(int r, int hi) { return (r & 3) + 8 * (r >> 2) + 4 * hi; }
__device__ __forceinline__ void partialSM(f32x16& p0, f32x16& p1, float& m_reg, float& mn, float& alpha, float C, float thr_raw) {
    float pmax = p0[0];
#pragma unroll
    for (int r = 1; r < 16; ++r) pmax = fmaxf(pmax, p0[r]);
#pragma unroll
    for (int r = 0; r < 16; ++r) pmax = fmaxf(pmax, p1[r]);
    { auto rr = __builtin_amdgcn_permlane32_swap(__float_as_uint(pmax), __float_as_uint(pmax), false, false); pmax = fmaxf(__uint_as_float(rr[0]), __uint_as_float(rr[1])); }
    if (__builtin_expect(__all(pmax - m_reg <= thr_raw), 1)) { mn = m_reg; alpha = 1.f; }
    else { mn = fmaxf(m_reg, pmax); alpha = __builtin_amdgcn_exp2f((m_reg - mn) * C); m_reg = mn; }
    const float mnC = -mn * C;
#pragma unroll
    for (int r = 0; r < 16; ++r) p0[r] = fmaf(p0[r], C, mnC);
#pragma unroll
    for (int r = 0; r < 16; ++r) p1[r] = fmaf(p1[r], C, mnC);
#pragma unroll
    for (int r = 0; r < 16; ++r) p0[r] = __builtin_amdgcn_exp2f(p0[r]);
}
__device__ __forceinline__ void finishSM(f32x16& p0, f32x16& p1, float alpha, float& l_reg, bf16x8& pa0, bf16x8& pa1, bf16x8& pa2, bf16x8& pa3) {
#pragma unroll
    for (int r = 0; r < 16; ++r) p1[r] = __builtin_amdgcn_exp2f(p1[r]);
    float ps = 0.f;
#pragma unroll
    for (int r = 0; r < 16; ++r) ps += p0[r];
#pragma unroll
    for (int r = 0; r < 16; ++r) ps += p1[r];
    { auto rr = __builtin_amdgcn_permlane32_swap(__float_as_uint(ps), __float_as_uint(ps), false, false); ps = __uint_as_float(rr[0]) + __uint_as_float(rr[1]); }
    l_reg = l_reg * alpha + ps;
#define PK4(P_, BASE, OUT) do { unsigned a0 = cvt_pk_bf16(P_[BASE + 0], P_[BASE + 1]), a1 = cvt_pk_bf16(P_[BASE + 2], P_[BASE + 3]);   \
    unsigned b0 = cvt_pk_bf16(P_[BASE + 4], P_[BASE + 5]), b1 = cvt_pk_bf16(P_[BASE + 6], P_[BASE + 7]);                              \
    auto r0 = __builtin_amdgcn_permlane32_swap(a0, b0, false, false); auto r1 = __builtin_amdgcn_permlane32_swap(a1, b1, false, false); \
    u32x4 w = {r0[0], r1[0], r0[1], r1[1]}; OUT = *reinterpret_cast<bf16x8*>(&w); } while (0)
    PK4(p0, 0, pa0); PK4(p0, 8, pa1); PK4(p1, 0, pa2); PK4(p1, 8, pa3);
#undef PK4
}
template <int NDQ> __device__ __forceinline__ int kaddr(int row, int cb) { return row * (32 * NDQ) + (cb ^ (((row >> 1) & 7) << 4)); }
template <int NDQ, int NQR>
__device__ __forceinline__ void qkt(f32x16& p0, f32x16& p1, const char* Ks, const bf16x8* qr, const char* ql, int r32, int hi) {
    p0 = f32x16{}; p1 = f32x16{};
#pragma unroll
    for (int d0 = 0; d0 < NDQ; ++d0) { const int cb = d0 * 32 + hi * 16;
        const bf16x8 b0 = *reinterpret_cast<const bf16x8*>(Ks + kaddr<NDQ>(r32, cb));
        const bf16x8 b1 = *reinterpret_cast<const bf16x8*>(Ks + kaddr<NDQ>(32 + r32, cb));
        bf16x8 q; if (d0 < NQR) q = qr[d0]; else q = *reinterpret_cast<const bf16x8*>(ql + (d0 - NQR) * 1024);
        p0 = __builtin_amdgcn_mfma_f32_32x32x16_bf16(b0, q, p0, 0, 0, 0);
        p1 = __builtin_amdgcn_mfma_f32_32x32x16_bf16(b1, q, p1, 0, 0, 0); }
}
__device__ __forceinline__ int v_st(int k, int c) { const int kk = (k & ~0xC) | ((k & 4) << 1) | ((k & 8) >> 1); return ((kk >> 3) * 4 + (c >> 5)) * 512 + ((kk & 7) * 32 + (c & 31)) * 2; }
__device__ __forceinline__ int v_rd_base(int lane) { return ((lane & 3) << 3) | (((lane >> 2) & 3) << 6) | (((lane >> 4) & 1) << 5) | (((lane >> 5) & 1) << 8); }
constexpr int v_rd_off(int d0, int ks, int half) { return d0 * 512 + ks * 4096 + half * 2048; }
template <int OFF> __device__ __forceinline__ s16x4 tr_read(int vb) { s16x4 r; asm volatile("ds_read_b64_tr_b16 %0, %1 offset:%2" : "=&v"(r) : "v"(vb), "i"(OFF) : "memory"); return r; }
template <int D0> __device__ __forceinline__ void pv_one(f32x16& od, int vb, bf16x8 pa0, bf16x8 pa1, bf16x8 pa2, bf16x8 pa3) {
    const s16x4 l0 = tr_read<v_rd_off(D0, 0, 0)>(vb), h0 = tr_read<v_rd_off(D0, 0, 1)>(vb), l1 = tr_read<v_rd_off(D0, 1, 0)>(vb), h1 = tr_read<v_rd_off(D0, 1, 1)>(vb);
    const s16x4 l2 = tr_read<v_rd_off(D0, 2, 0)>(vb), h2 = tr_read<v_rd_off(D0, 2, 1)>(vb), l3 = tr_read<v_rd_off(D0, 3, 0)>(vb), h3 = tr_read<v_rd_off(D0, 3, 1)>(vb);
    asm volatile("s_waitcnt lgkmcnt(0)" ::: "memory"); SBAR();
#define PKV(L_, H_) (bf16x8){L_[0], L_[1], L_[2], L_[3], H_[0], H_[1], H_[2], H_[3]}
    od = __builtin_amdgcn_mfma_f32_32x32x16_bf16(pa0, PKV(l0, h0), od, 0, 0, 0);
    od = __builtin_amdgcn_mfma_f32_32x32x16_bf16(pa1, PKV(l1, h1), od, 0, 0, 0);
    od = __builtin_amdgcn_mfma_f32_32x32x16_bf16(pa2, PKV(l2, h2), od, 0, 0, 0);
    od = __builtin_amdgcn_mfma_f32_32x32x16_bf16(pa3, PKV(l3, h3), od, 0, 0, 0);
#undef PKV
}
__device__ __forceinline__ void pv_d0(f32x16* o, int vb, bf16x8 pa0, bf16x8 pa1, bf16x8 pa2, bf16x8 pa3) {
    pv_one<0>(o[0], vb, pa0, pa1, pa2, pa3); pv_one<1>(o[1], vb, pa0, pa1, pa2, pa3); pv_one<2>(o[2], vb, pa0, pa1, pa2, pa3); pv_one<3>(o[3], vb, pa0, pa1, pa2, pa3);
}
template <int NDQ, int SD>
__device__ __forceinline__ void attn_body(const bf16_t* __restrict__ Qw, int ldq, const bf16_t* __restrict__ Kg, int ldk, const bf16_t* __restrict__ Krg, const bf16_t* __restrict__ Vg, int ldv,
                                          int xrow0, int nxt, int crow0, int NT, float C, char* lds, int tid, f32x16 (&o)[4], float (&rli)[16]) {
    constexpr int SHM_K = 64 * 32 * NDQ;
    const int wid = tid >> 6, lane = tid & 63, r32 = lane & 31, hi = lane >> 5;
    char* V_lds = lds; char* K_lds = lds + 2 * SHM_V;
    float* wsf = (float*)(lds + 2 * SHM_V + 2 * SHM_K) + wid * 64; float* li_l = wsf; float* al_l = wsf + 32;
    const float thr_raw = 8.f * 1.4426950408889634f / C;
    constexpr int NQR = (NDQ > 8) ? 6 : NDQ;
    char* ql = lds + 2 * SHM_V + 2 * SHM_K + 2048 + wid * ((NDQ - NQR) * 1024) + lane * 16;
    float m_reg = -1e30f, l_reg = 0.f; bf16x8 qr[NQR];
#pragma unroll
    for (int d0 = 0; d0 < 4; ++d0) o[d0] = f32x16{};
    const bf16_t* Ql = Qw + (size_t)r32 * ldq + hi * 8;
    __syncthreads();
#pragma unroll
    for (int d0 = 0; d0 < NDQ; ++d0) { const bf16x8 q = *reinterpret_cast<const bf16x8*>(Ql + d0 * 16); if (d0 < NQR) qr[d0] = q; else *reinterpret_cast<bf16x8*>(ql + (d0 - NQR) * 1024) = q; }
    const int sr = tid >> 4, sc = (tid & 15) * 8, vst0 = v_st(sr, sc), vst1 = v_st(32 + sr, sc);
    const int k8r = tid >> 3, k8c = (tid & 7) * 8;
    const int vb0 = (int)(uintptr_t)V_lds + v_rd_base(lane);
    bf16x8 vsA0, vsA1, ksA0, ksA1, ksA2, vsB0, vsB1, ksB0, ksB1, ksB2;
#define KROW(j) ((j) < nxt ? xrow0 + 64 * (j) : crow0 + 64 * ((j) - nxt))
#define SLOAD(S_, j) do { const int row0_ = KROW(j); \
        vs##S_##0 = *reinterpret_cast<const bf16x8*>(Vg + (size_t)(row0_ + sr) * ldv + sc); vs##S_##1 = *reinterpret_cast<const bf16x8*>(Vg + (size_t)(row0_ + 32 + sr) * ldv + sc); \
        if constexpr (NDQ == 4) { ks##S_##0 = *reinterpret_cast<const bf16x8*>(Kg + (size_t)(row0_ + k8r) * ldk + k8c); } \
        else { ks##S_##0 = *reinterpret_cast<const bf16x8*>(Kg + (size_t)(row0_ + sr) * ldk + sc); ks##S_##1 = *reinterpret_cast<const bf16x8*>(Kg + (size_t)(row0_ + 32 + sr) * ldk + sc); \
               ks##S_##2 = *reinterpret_cast<const bf16x8*>(Krg + (size_t)(row0_ + k8r) * 64 + k8c); } } while (0)
#define SWRITE(b, S_) do { *(bf16x8*)(V_lds + (b) * SHM_V + vst0) = vs##S_##0; *(bf16x8*)(V_lds + (b) * SHM_V + vst1) = vs##S_##1; \
        if constexpr (NDQ == 4) { *(bf16x8*)(K_lds + (b) * SHM_K + kaddr<NDQ>(k8r, k8c * 2)) = ks##S_##0; } \
        else { *(bf16x8*)(K_lds + (b) * SHM_K + kaddr<NDQ>(sr, sc * 2)) = ks##S_##0; *(bf16x8*)(K_lds + (b) * SHM_K + kaddr<NDQ>(32 + sr, sc * 2)) = ks##S_##1; \
               *(bf16x8*)(K_lds + (b) * SHM_K + kaddr<NDQ>(k8r, 256 + k8c * 2)) = ks##S_##2; } } while (0)
#define SLOAD_B(j) do { if constexpr (SD == 2) SLOAD(B, j); else SLOAD(A, j); } while (0)
#define SWRITE_B(b) do { if constexpr (SD == 2) SWRITE(b, B); else SWRITE(b, A); } while (0)
#define SWAIT() do { if constexpr (SD == 1) asm volatile("s_waitcnt vmcnt(0)" ::: "memory"); else if constexpr (NDQ == 4) asm volatile("s_waitcnt vmcnt(3)" ::: "memory"); else asm volatile("s_waitcnt vmcnt(5)" ::: "memory"); } while (0)
#define RESC(a) do { if (__any((a) < 1.f)) { if (hi == 0) al_l[r32] = (a); asm volatile("s_waitcnt lgkmcnt(0)" ::: "memory"); \
        _Pragma("unroll") for (int d = 0; d < 4; ++d) _Pragma("unroll") for (int r = 0; r < 16; ++r) o[d][r] *= al_l[crow(r, hi)]; } } while (0)
    f32x16 pA0, pA1, pB0, pB1; float mnA, mnB, alA, alB; bf16x8 pa0, pa1, pa2, pa3;
    SLOAD(A, 0); asm volatile("s_waitcnt vmcnt(0)" ::: "memory"); SWRITE(0, A); __syncthreads();
    qkt<NDQ, NQR>(pA0, pA1, K_lds, qr, ql, r32, hi); partialSM(pA0, pA1, m_reg, mnA, alA, C, thr_raw);
    SLOAD_B(1); if constexpr (SD == 2) { if (2 < NT) SLOAD(A, 2); }
    SWAIT(); SWRITE_B(1); __syncthreads();
    for (int j = 1; j + 1 < NT; j += 2) {
        SBAR(); qkt<NDQ, NQR>(pB0, pB1, K_lds + SHM_K, qr, ql, r32, hi);
        finishSM(pA0, pA1, alA, l_reg, pa0, pa1, pa2, pa3); SBAR();
        SLOAD_B(j + SD); SBAR();
        pv_d0(o, vb0, pa0, pa1, pa2, pa3); partialSM(pB0, pB1, m_reg, mnB, alB, C, thr_raw);
        __syncthreads(); SWAIT(); SWRITE(0, A);
        RESC(alB); __syncthreads();
        SBAR(); qkt<NDQ, NQR>(pA0, pA1, K_lds, qr, ql, r32, hi);
        finishSM(pB0, pB1, alB, l_reg, pa0, pa1, pa2, pa3); SBAR();
        if (SD == 1 || j + 3 < NT) SLOAD(A, j + 1 + SD); SBAR();
        pv_d0(o, vb0 + SHM_V, pa0, pa1, pa2, pa3); partialSM(pA0, pA1, m_reg, mnA, alA, C, thr_raw);
        __syncthreads(); SWAIT(); SWRITE_B(1);
        RESC(alA); __syncthreads();
    }
    SBAR(); qkt<NDQ, NQR>(pB0, pB1, K_lds + SHM_K, qr, ql, r32, hi);
    finishSM(pA0, pA1, alA, l_reg, pa0, pa1, pa2, pa3); SBAR();
    pv_d0(o, vb0, pa0, pa1, pa2, pa3); partialSM(pB0, pB1, m_reg, mnB, alB, C, thr_raw);
    __syncthreads(); RESC(alB);
    finishSM(pB0, pB1, alB, l_reg, pa0, pa1, pa2, pa3); SBAR();
    pv_d0(o, vb0 + SHM_V, pa0, pa1, pa2, pa3);
    if (hi == 0) li_l[r32] = l_reg; asm volatile("s_waitcnt lgkmcnt(0)" ::: "memory");
#pragma unroll
    for (int r = 0; r < 16; ++r) rli[r] = __builtin_amdgcn_rcpf(li_l[crow(r, hi)]);
#undef KROW
#undef SLOAD
#undef SWRITE
#undef SWAIT
#undef SLOAD_B
#undef SWRITE_B
#undef RESC
}
__device__ __forceinline__ void unit_diff(KP kp, unsigned char* ws, int l, int b, int h, int qrow0, int isc, char* lds, int tid, float* scratch) {
    const int wid = tid >> 6, lane = tid & 63, r32 = lane & 31, hi = lane >> 5;
    const bf16_t* Z = (const bf16_t*)(ws + WS_Z); bf16_t* MIX = (bf16_t*)(ws + WS_MIX);
    const int xrow0 = b * SEQ, nxt = isc ? 0 : SEQ / 64, crow0 = RX + b * CTX, NT = nxt + CTX / 64;
    const float C = 0.125f * 1.4426950408889634f;
    const float* lamp = kp->in[IN_DIFFLAM] + l * 256;
    float l1 = lamp[lane] * lamp[64 + lane], l2 = lamp[128 + lane] * lamp[192 + lane]; l1 = wsum(l1, lane); l2 = wsum(l2, lane);
    const float lam_init = (l == 0) ? 0.2f : 0.35550906759096907f;
    const float lam = expf(l1) - expf(l2) + lam_init;
    float* myscr = scratch + (size_t)wid * 64 * 64 + lane;
    f32x16 o[4]; float rli[16];
    attn_body<4, 2>(Z + (size_t)(qrow0 + wid * 32) * ZLD + Z_Q + h * 128, ZLD, Z + Z_K + h * 128, ZLD, nullptr, Z + Z_V + h * 128, ZLD, xrow0, nxt, crow0, NT, C, lds, tid, o, rli);
#pragma unroll
    for (int d0 = 0; d0 < 4; ++d0)
#pragma unroll
        for (int r = 0; r < 16; ++r) myscr[(d0 * 16 + r) * 64] = o[d0][r] * rli[r];
    attn_body<4, 2>(Z + (size_t)(qrow0 + wid * 32) * ZLD + Z_Q + h * 128 + 64, ZLD, Z + Z_K + h * 128 + 64, ZLD, nullptr, Z + Z_V + h * 128, ZLD, xrow0, nxt, crow0, NT, C, lds, tid, o, rli);
    size_t so = 0; asm volatile("" : "+v"(so) :: "memory"); const float* rdscr = myscr + so;
    const float* subg = kp->in[IN_SUBLN] + l * 128; const float post = 1.f - lam_init;
    float sg[4];
#pragma unroll
    for (int d0 = 0; d0 < 4; ++d0) sg[d0] = subg[d0 * 32 + r32] * post;
#pragma unroll
    for (int r = 0; r < 16; ++r) {
        float dv[4], ss = 0.f;
#pragma unroll
        for (int d0 = 0; d0 < 4; ++d0) { dv[d0] = rdscr[(d0 * 16 + r) * 64] - lam * (o[d0][r] * rli[r]); ss += dv[d0] * dv[d0]; }
        ss += sx(ss, 1, lane); ss += sx(ss, 2, lane); ss += sx(ss, 4, lane); ss += sx(ss, 8, lane); ss += sx(ss, 16, lane);
        const float rs = 1.0f / sqrtf(ss * (1.f / 128.f) + EPS);
        bf16_t* mp = MIX + (size_t)(qrow0 + wid * 32 + crow(r, hi)) * D + 512 + h * 128 + r32;
#pragma unroll
        for (int d0 = 0; d0 < 4; ++d0) mp[d0 * 32] = f2bf(dv[d0] * rs * sg[d0]);
    }
}
__device__ __forceinline__ void unit_mla(unsigned char* ws, int b, int h, int qrow0, int isc, char* lds, int tid) {
    const int wid = tid >> 6, lane = tid & 63, r32 = lane & 31, hi = lane >> 5;
    const bf16_t* QM = (const bf16_t*)(ws + WS_QM); const bf16_t* KN = (const bf16_t*)(ws + WS_KN); const bf16_t* KR = (const bf16_t*)(ws + WS_KR); const bf16_t* VM = (const bf16_t*)(ws + WS_VM);
    bf16_t* MIX = (bf16_t*)(ws + WS_MIX);
    const int xrow0 = b * SEQ, nxt = isc ? 0 : SEQ / 64, crow0 = RX + b * CTX, NT = nxt + CTX / 64;
    const float C = 0.07216878364870322f * 1.4426950408889634f;
    f32x16 o[4]; float rli[16];
    attn_body<12, 1>(QM + (size_t)(qrow0 + wid * 32) * 768 + h * 192, 768, KN + h * 128, 512, KR, VM + h * 128, 512, xrow0, nxt, crow0, NT, C, lds, tid, o, rli);
#pragma unroll
    for (int r = 0; r < 16; ++r) { bf16_t* mp = MIX + (size_t)(qrow0 + wid * 32 + crow(r, hi)) * D + 1024 + h * 128 + r32;
#pragma unroll
        for (int d0 = 0; d0 < 4; ++d0) mp[d0 * 32] = f2bf(o[d0][r] * rli[r]); }
}
__device__ __forceinline__ void phase_attn(KP kp, unsigned char* ws, int tid, int l, char* lds, int vcu, int G, int bx) {
    const int nunits = (l == 0) ? 288 : 256;
    float* scratch = (float*)(ws + WS_O1) + (size_t)bx * (8 * 64 * 64);
    for (int k = 0; k * G < nunits; ++k) {
        const int u = k * G + ((vcu + k * 128) % G); if (u >= nunits) continue;
        int tidu = tid; asm volatile("" : "+v"(tidu));
        size_t wo = 0; asm volatile("" : "+s"(wo)); unsigned char* wsu = kp->ws + wo; int lu = l; asm volatile("" : "+s"(lu));
        const bool isc = (u >= 256); const int v = isc ? (u - 256) & 15 : (u & 127);
        const bool mla = isc ? (u >= 272) : (u >= 128);
        const int b = isc ? (v >> 2) : (v >> 5), h = isc ? (v & 3) : ((v >> 3) & 3), q0 = isc ? RX + b * CTX : b * SEQ + (v & 7) * 256;
        if (!mla) unit_diff(kp, wsu, lu, b, h, q0, isc ? 1 : 0, lds, tidu, scratch);
        else unit_mla(wsu, b, h, q0, isc ? 1 : 0, lds, tidu);
    }
}
#undef SBAR
}

constexpr int LDS_BYTES = 147456;
__global__ void __launch_bounds__(NTHR, 2) mk_fwd(Params P) {
    extern __shared__ __attribute__((aligned(16))) unsigned char lds_raw[];
    LAS unsigned char* lds = (LAS unsigned char*)lds_raw;
    KP kp = (KP)__builtin_amdgcn_kernarg_segment_ptr();
    const int G0 = gridDim.x, bx0 = blockIdx.x;
    const int vcu0 = (G0 % 8 == 0) ? (bx0 % 8) * (G0 / 8) + bx0 / 8 : bx0;
    for (int ph = kp->ph_lo; ph < kp->ph_hi; ++ph) {
        if (ph != kp->ph_lo) cg::this_grid().sync();
        asm volatile("" : "+s"(kp));
        int G = G0, bx = bx0, vcu = vcu0; asm volatile("" : "+s"(G), "+s"(bx), "+s"(vcu));
        int tid_ = __builtin_amdgcn_workitem_id_x(); asm volatile("" : "+v"(tid_));
        size_t wsoff = 0; asm volatile("" : "+s"(wsoff)); unsigned char* ws = kp->ws + wsoff;
        if (ph == PH_PRO) { phase_prologue(kp, ws, tid_, lds, vcu, G); continue; }
        if (ph == PH_ROWA) { phase_rowpass(kp, ws, tid_, 0, 0, vcu, G); continue; }
        const int l = (ph - PH_L0) / PH_PER_LAYER, sub = (ph - PH_L0) % PH_PER_LAYER;
        const int nrM = (l == 1 ? RX : R) / 256;
        if (sub == PHL_WIN) {
            pg8::run(lds, pg8::Gemm{(const bf16_t*)(ws + WS_H), (const bf16_t*)(ws + WS_WIN) + (size_t)l * ZLD * D, D, D, D}, R / 256, ZLD / 256, G, bx, pg8::EpiZ{(bf16_t*)(ws + WS_Z), (float*)(ws + WS_RSQ) + (size_t)l * R * 2}, tid_);
        } else if (sub == PHL_WOUT) {
            pg8::run(lds, pg8::Gemm{(const bf16_t*)(ws + WS_MIX), (const bf16_t*)(ws + WS_WOUT) + (size_t)l * D * D, D, D, D}, nrM, D / 256, G, bx, pg8::EpiF32{(float*)(ws + WS_Y), D}, tid_);
        } else if (sub == PHL_UP) {
            pg8::run(lds, pg8::Gemm{(const bf16_t*)(ws + WS_H), (const bf16_t*)(ws + WS_WUP) + (size_t)l * UFF * D, D, D, D}, nrM, UFF / 256, G, bx, pg8::EpiBf16{(bf16_t*)(ws + WS_U), UFF}, tid_);
        } else if (sub == PHL_DOWN) {
            pg8::run(lds, pg8::Gemm{(const bf16_t*)(ws + WS_ACT), (const bf16_t*)(ws + WS_WDOWN) + (size_t)l * D * DFF, DFF, DFF, DFF}, nrM, D / 256, G, bx, pg8::EpiF32{(float*)(ws + WS_Y), D}, tid_);
        } else if (sub == PHL_PRE) {
            if (kp->mask & 1) {
                const float* rsq = (const float*)(ws + WS_RSQ) + (size_t)l * R * 2;
                pg8::run(lds, pg8::Gemm{(const bf16_t*)(ws + WS_Z) + Z_CQ, (const bf16_t*)(ws + WS_WUQ) + (size_t)l * 768 * 384, ZLD, 384, 384}, R / 256, 3, G, bx, pg8::EpiQ{(bf16_t*)(ws + WS_QM), rsq, (const float2*)(ws + WS_CS)}, tid_);
                int tid2 = tid_; asm volatile("" : "+v"(tid2)); size_t wsoff2 = 0; asm volatile("" : "+s"(wsoff2)); unsigned char* ws2 = kp->ws + wsoff2;
                pg8::run(lds, pg8::Gemm{(const bf16_t*)(ws2 + WS_Z) + Z_CKV, (const bf16_t*)(ws2 + WS_WUKV) + (size_t)l * 1024 * 256, ZLD, 256, 256}, R / 256, 4, G, (bx + G - 108) % G, pg8::EpiKV{(bf16_t*)(ws2 + WS_KN), (bf16_t*)(ws2 + WS_VM), (const float*)(ws2 + WS_RSQ) + (size_t)l * R * 2}, tid2);
            }
            if (kp->mask & 2) pre_rope(kp, ws, tid_, vcu, G);
            if (kp->mask & 4) pre_pool(kp, ws, tid_, l, vcu, G);
            if (kp->mask & 8) pre_conv(kp, ws, tid_, l, vcu, G);
        } else if (sub == PHL_ATTN) { att::phase_attn(kp, ws, tid_, l, (char*)lds_raw, vcu, G, bx);
        } else if (sub == PHL_ROWB) phase_rowpass(kp, ws, tid_, 1, l, vcu, G);
        else if (sub == PHL_ACT) phase_act(kp, ws, tid_, l, vcu, G);
        else if (sub == PHL_ROWC) phase_rowpass(kp, ws, tid_, 2, l, vcu, G);
    }
}

extern "C" void kernel_launch(void* const* d_in, const int* in_sizes, int n_in, void* d_out, int out_size, void* d_ws, size_t ws_size, hipStream_t stream) {
    static int grid = 0;
    if (grid == 0) {
        if (n_in != 24 || ws_size < WS_END) { fprintf(stderr, "kernel_launch: bad args n_in %d ws %zu (need %zu)\n", n_in, ws_size, (size_t)WS_END); grid = -1; return; }
        if (hipFuncSetAttribute((const void*)mk_fwd, hipFuncAttributeMaxDynamicSharedMemorySize, LDS_BYTES) != hipSuccess) { fprintf(stderr, "hipFuncSetAttribute failed\n"); grid = -1; return; }
        int dev = 0, cus = 0, per_cu = 0;
        if (hipGetDevice(&dev) != hipSuccess || hipDeviceGetAttribute(&cus, hipDeviceAttributeMultiprocessorCount, dev) != hipSuccess) { grid = -1; return; }
        if (hipOccupancyMaxActiveBlocksPerMultiprocessor(&per_cu, (const void*)mk_fwd, NTHR, LDS_BYTES) != hipSuccess || per_cu < 1) { fprintf(stderr, "occupancy query failed (%d)\n", per_cu); grid = -1; return; }
        grid = cus * per_cu;
    }
    if (grid < 0) return;
    unsigned char* ws = (unsigned char*)d_ws;
    (void)hipMemsetAsync(ws + WS_CTL, 0, CTL_BYTES, stream);
    Params P{};
    for (int i = 0; i < 24; ++i) P.in[i] = (const float*)d_in[i];
    P.out = (float*)d_out; P.ws = ws; P.ph_lo = 0; P.ph_hi = PH_TOTAL; P.mask = 15; P.pad = 0;
    void* args[] = {&P};
    const hipError_t e = hipLaunchCooperativeKernel((const void*)mk_fwd, dim3(grid), dim3(NTHR), args, LDS_BYTES, stream);
    if (e != hipSuccess) fprintf(stderr, "cooperative launch failed: %s (grid %d)\n", hipGetErrorString(e), grid);
}
```

```cpp
#include <hip/hip_runtime.h>
#include <hip/hip_cooperative_groups.h>
#include <cstdint>
#include <cstdio>
#include <cmath>
namespace cg = cooperative_groups;

#define LAS __attribute__((address_space(3)))
typedef unsigned short bf16_t;
typedef short bf16x8 __attribute__((ext_vector_type(8)));
typedef short s16x4 __attribute__((ext_vector_type(4)));
typedef float f32x4 __attribute__((ext_vector_type(4)));
typedef float f32x2 __attribute__((ext_vector_type(2)));
typedef float f32x16 __attribute__((ext_vector_type(16)));
typedef unsigned u32x4 __attribute__((ext_vector_type(4)));
typedef unsigned u32x2 __attribute__((ext_vector_type(2)));

constexpr int D = 2048, NB = 4, SEQ = 2048, CTX = 256, GRIDW = 64;
constexpr int RX = NB * SEQ, RC = NB * CTX, R = RX + RC;
constexpr int INC = 4288, ZLD = 4352, DFF = 5632, UFF = 2 * DFF, MODW = 6 * D;
constexpr float EPS = 1e-6f;
constexpr int Z_POOL = 0, Z_Q = 512, Z_K = 1024, Z_V = 1536, Z_CQ = 2048, Z_CKV = 2432, Z_KR = 2688, Z_GB = 2752, Z_GC = 3264, Z_H = 3776;
constexpr int NWAVES = 8, NTHR = 512;
constexpr int LDS_BYTES = 147456, MISC_OFF = LDS_BYTES - 64;

constexpr size_t MiB = 1u << 20;
constexpr size_t WS_CTL = 0, CTL_BYTES = 1 * MiB;
constexpr size_t WS_BAR = 0;
constexpr size_t WS_CVQ = 48 * 1024;
constexpr size_t WS_RSQ = 64 * 1024;
constexpr size_t WS_MOD = 1 * MiB;
constexpr size_t WS_CS = 2 * MiB;
constexpr size_t WS_POOLW = 3 * MiB;
constexpr size_t WS_WUQ = 4 * MiB;
constexpr size_t WS_WUKV = 6 * MiB;
constexpr size_t WS_WIN = 8 * MiB;
constexpr size_t WS_WOUT = 42 * MiB;
constexpr size_t WS_WUP = 58 * MiB;
constexpr size_t WS_WDOWN = 146 * MiB;
constexpr size_t WS_XR = 190 * MiB;
constexpr size_t WS_H = 262 * MiB;
constexpr size_t WS_BIG = 298 * MiB;
constexpr size_t WS_Z = WS_BIG;
constexpr size_t WS_QM = WS_BIG + 77 * MiB;
constexpr size_t WS_KN = WS_BIG + 91 * MiB;
constexpr size_t WS_VM = WS_BIG + 100 * MiB;
constexpr size_t WS_KR = WS_BIG + 109 * MiB;
constexpr size_t WS_MIX = WS_BIG + 111 * MiB;
constexpr size_t WS_Y = WS_BIG + 147 * MiB;
constexpr size_t WS_U = WS_BIG;
constexpr size_t WS_ACT = WS_BIG + 219 * MiB;
constexpr size_t WS_O1 = WS_ACT + 99 * MiB;
constexpr size_t WS_YP = WS_O1 + 32 * MiB;
constexpr size_t WS_EDGE = WS_YP + 24 * MiB;
constexpr size_t WS_END = WS_EDGE + 4 * MiB;
static_assert(WS_U + (size_t)R * UFF * 2 <= WS_ACT, "U overlay");
static_assert(WS_RSQ + (size_t)2 * R * 2 * 4 <= 256 * 1024, "control words inside the per-call memset");

struct Params {
    const float* in[24];
    float* out;
    unsigned char* ws;
    int ph_lo, ph_hi;
    int mask, pad;
};
typedef const __attribute__((address_space(4))) Params* KP;
enum { IN_X = 0, IN_C, IN_CTX, IN_CCTX, IN_ADAW, IN_ADAB, IN_GPREMIX, IN_GPOSTMIX, IN_GPREFFN, IN_GPOSTFFN, IN_WIN, IN_POOLW, IN_POOLSCALE, IN_DIFFLAM, IN_SUBLN,
       IN_GQ, IN_WUQ, IN_GKV, IN_WUKV, IN_CONVW, IN_WOUT, IN_WUP, IN_FFNCONVW, IN_WDOWN };
enum { PH_PRO = 0, PH_ROWA = 1, PH_L0 = 2, PHL_WIN = 0, PHL_PRE = 1, PHL_ATTN = 2, PHL_WOUT = 3, PHL_ROWB = 4, PHL_UP = 5, PHL_ACT = 6, PHL_DOWN = 7, PHL_ROWC = 8, PH_PER_LAYER = 9, PH_TOTAL = 2 + 2 * 9 };

__device__ __forceinline__ void rowinfo(int r, int& b, int& t, int& L, int& isc) {
    if (r < RX) { b = r / SEQ; t = r % SEQ; L = SEQ; isc = 0; } else { const int rc = r - RX; b = rc / CTX; t = rc % CTX; L = CTX; isc = 1; }
}
__device__ __forceinline__ float wave_sum(float v) {
#pragma unroll
    for (int o = 1; o < 64; o <<= 1) v += __shfl_xor(v, o);
    return v;
}
__device__ __forceinline__ float wave_max(float v) {
#pragma unroll
    for (int o = 1; o < 64; o <<= 1) v = fmaxf(v, __shfl_xor(v, o));
    return v;
}
__device__ __forceinline__ float sx(float v, int o, int lane) { return __int_as_float(__builtin_amdgcn_ds_bpermute((lane ^ o) << 2, __float_as_int(v))); }
__device__ __forceinline__ float wsum(float v, int lane) {
#pragma unroll
    for (int o = 1; o < 64; o <<= 1) v += sx(v, o, lane);
    return v;
}
typedef __bf16 bf16x2_t __attribute__((ext_vector_type(2)));
__device__ __forceinline__ unsigned cvt_pk_bf16(float lo, float hi) { const f32x2 v = {lo, hi}; const bf16x2_t b = __builtin_convertvector(v, bf16x2_t); return __builtin_bit_cast(unsigned, b); }
__device__ __forceinline__ bf16_t f2bf(float f) { return (bf16_t)(cvt_pk_bf16(f, 0.f) & 0xffffu); }
__device__ __forceinline__ float bf2f(bf16_t h) { return __uint_as_float(((unsigned)h) << 16); }
__device__ __forceinline__ void unpack8(const u32x4 w, float* f) {
    f[0] = __uint_as_float(w.x << 16); f[1] = __uint_as_float(w.x & 0xffff0000u); f[2] = __uint_as_float(w.y << 16); f[3] = __uint_as_float(w.y & 0xffff0000u);
    f[4] = __uint_as_float(w.z << 16); f[5] = __uint_as_float(w.z & 0xffff0000u); f[6] = __uint_as_float(w.w << 16); f[7] = __uint_as_float(w.w & 0xffff0000u);
}
__device__ __forceinline__ u32x4 pack8(const float* f) { u32x4 w; w.x = cvt_pk_bf16(f[0], f[1]); w.y = cvt_pk_bf16(f[2], f[3]); w.z = cvt_pk_bf16(f[4], f[5]); w.w = cvt_pk_bf16(f[6], f[7]); return w; }
__device__ __forceinline__ u32x4 ld16(const bf16_t* p) { return *(const u32x4*)p; }
__device__ __forceinline__ void st16(bf16_t* p, u32x4 v) { *(u32x4*)p = v; }

__host__ __device__ __forceinline__ int uq_pos(int n) { const int h = n / 192, j = n % 192; if (j < 128) return (h >> 1) * 256 + (h & 1) * 128 + j; const int jj = j - 128; return jj < 32 ? 512 + h * 32 + jj : 640 + h * 32 + (jj - 32); }

__host__ __device__ __forceinline__ int up_pos(int n) { const int m = n < DFF ? n : n - DFF; return (m >> 7) * 256 + (n < DFF ? 0 : 128) + (m & 127); }
template <int MAP>
__device__ __forceinline__ void tr_item(const float* __restrict__ W, int K, int N, bf16_t* __restrict__ WT, int ldt, const float* __restrict__ ks, const float* __restrict__ ns, LAS float* scr, int item, int lane) {
    const int nblk = N / 32, kb = item / nblk, nb = item % nblk, k0 = 64 * kb, n0 = 32 * nb;
    const float nsv = ns ? ns[n0 + (lane & 31)] : 1.f;
    float wv[32];
#pragma unroll
    for (int i = 0; i < 32; ++i) wv[i] = __builtin_nontemporal_load(&W[(size_t)(k0 + 2 * i + (lane >> 5)) * N + n0 + (lane & 31)]);
#pragma unroll
    for (int i = 0; i < 32; ++i) { const int kk = 2 * i + (lane >> 5); float v = wv[i]; if (ks) v *= ks[k0 + kk]; scr[kk * 33 + (lane & 31)] = v * nsv; }
    asm volatile("s_waitcnt lgkmcnt(0)" ::: "memory");
    const int c = lane & 7;
#pragma unroll
    for (int j = 0; j < 4; ++j) { const int n = (lane >> 3) + 8 * j; const LAS float* s = scr + (8 * c) * 33 + n;
        u32x4 o; o.x = cvt_pk_bf16(s[0 * 33], s[1 * 33]); o.y = cvt_pk_bf16(s[2 * 33], s[3 * 33]); o.z = cvt_pk_bf16(s[4 * 33], s[5 * 33]); o.w = cvt_pk_bf16(s[6 * 33], s[7 * 33]);
        const int nn = n0 + n; const int dst = (MAP == 1) ? uq_pos(nn) : (MAP == 2) ? up_pos(nn) : nn;
        *(u32x4*)(WT + (size_t)dst * ldt + k0 + 8 * c) = o; }
    asm volatile("s_waitcnt lgkmcnt(0)" ::: "memory");
}

__device__ __forceinline__ void tr_item_poolfold(const float* __restrict__ W  , const float* __restrict__ pw  , const float* __restrict__ psc  ,
                                                 bf16_t* __restrict__ WT, LAS float* scr, int item, int lane) {
    const int kb = item / 16, nb = item % 16, k0 = 64 * kb, n0 = 32 * nb, g = n0 >> 7, d0 = n0 & 127, kg = lane >> 5, nl = lane & 31;
    const float* wa = W + (size_t)(k0 + nl) * INC + g * 128 + kg * 8;
    const float* pb = pw + (size_t)g * 128 * 128 + (size_t)(kg * 8) * 128 + d0 + nl;
    f32x4 av[8][4]; float bv[8][8];
#pragma unroll
    for (int ks = 0; ks < 8; ++ks) {
        av[ks][0] = *(const f32x4*)(wa + ks * 16); av[ks][1] = *(const f32x4*)(wa + ks * 16 + 4);
        av[ks][2] = *(const f32x4*)(wa + (size_t)32 * INC + ks * 16); av[ks][3] = *(const f32x4*)(wa + (size_t)32 * INC + ks * 16 + 4);
        if (ks < 4) {
#pragma unroll
            for (int j = 0; j < 8; ++j) bv[ks][j] = pb[(size_t)(ks * 16 + j) * 128]; } }
    __builtin_amdgcn_sched_barrier(0);
#pragma unroll
    for (int ks = 4; ks < 8; ++ks)
#pragma unroll
        for (int j = 0; j < 8; ++j) bv[ks][j] = pb[(size_t)(ks * 16 + j) * 128];
    f32x16 acc0, acc1;
#pragma unroll
    for (int i = 0; i < 16; ++i) { acc0[i] = 0.f; acc1[i] = 0.f; }
#pragma unroll
    for (int ks = 0; ks < 8; ++ks) {
        u32x4 A0, A1, B;
        A0.x = cvt_pk_bf16(av[ks][0].x, av[ks][0].y); A0.y = cvt_pk_bf16(av[ks][0].z, av[ks][0].w); A0.z = cvt_pk_bf16(av[ks][1].x, av[ks][1].y); A0.w = cvt_pk_bf16(av[ks][1].z, av[ks][1].w);
        A1.x = cvt_pk_bf16(av[ks][2].x, av[ks][2].y); A1.y = cvt_pk_bf16(av[ks][2].z, av[ks][2].w); A1.z = cvt_pk_bf16(av[ks][3].x, av[ks][3].y); A1.w = cvt_pk_bf16(av[ks][3].z, av[ks][3].w);
        B.x = cvt_pk_bf16(bv[ks][0], bv[ks][1]); B.y = cvt_pk_bf16(bv[ks][2], bv[ks][3]); B.z = cvt_pk_bf16(bv[ks][4], bv[ks][5]); B.w = cvt_pk_bf16(bv[ks][6], bv[ks][7]);
        acc0 = __builtin_amdgcn_mfma_f32_32x32x16_bf16(__builtin_bit_cast(bf16x8, A0), __builtin_bit_cast(bf16x8, B), acc0, 0, 0, 0);
        acc1 = __builtin_amdgcn_mfma_f32_32x32x16_bf16(__builtin_bit_cast(bf16x8, A1), __builtin_bit_cast(bf16x8, B), acc1, 0, 0, 0);
    }
    const float sc = psc[n0 + nl];
    bf16_t* wt = WT + (size_t)(n0 + nl) * D + k0 + 4 * kg;
#pragma unroll
    for (int q = 0; q < 4; ++q) {
        u32x2 o0, o1;
        o0.x = cvt_pk_bf16(acc0[4 * q] * sc, acc0[4 * q + 1] * sc); o0.y = cvt_pk_bf16(acc0[4 * q + 2] * sc, acc0[4 * q + 3] * sc);
        o1.x = cvt_pk_bf16(acc1[4 * q] * sc, acc1[4 * q + 1] * sc); o1.y = cvt_pk_bf16(acc1[4 * q + 2] * sc, acc1[4 * q + 3] * sc);
        *(u32x2*)(wt + 8 * q) = o0; *(u32x2*)(wt + 32 + 8 * q) = o1; }
}
constexpr int CV_IN = 32 * 134, CV_OUT = 32 * 64, CV_UP = 32 * 352, CV_DOWN = 88 * 64, CV_UQ = 6 * 24, CV_UKV = 4 * 32, CV_POOL = 0;
constexpr int CV_SEG0 = CV_UQ + CV_UKV + CV_POOL + CV_IN;
constexpr int CV_E1 = CV_OUT, CV_E2 = CV_E1 + CV_UP, CV_E3 = CV_E2 + CV_DOWN, CV_E4 = CV_E3 + CV_SEG0, CV_E5 = CV_E4 + CV_OUT, CV_E6 = CV_E5 + CV_UP, CV_E7 = CV_E6 + CV_DOWN;
__device__ __forceinline__ void conv_item0(KP kp, unsigned char* ws, int l, int r, LAS float* scr, int lane) {
    if (r < CV_UQ) { tr_item<1>(kp->in[IN_WUQ] + (size_t)l * 384 * 768, 384, 768, (bf16_t*)(ws + WS_WUQ) + (size_t)l * 768 * 384, 384, kp->in[IN_GQ] + l * 384, nullptr, scr, r, lane); return; } r -= CV_UQ;
    if (r < CV_UKV) { tr_item<0>(kp->in[IN_WUKV] + (size_t)l * 256 * 1024, 256, 1024, (bf16_t*)(ws + WS_WUKV) + (size_t)l * 1024 * 256, 256, kp->in[IN_GKV] + l * 256, nullptr, scr, r, lane); return; } r -= CV_UKV;
    if (r < CV_POOL) { const int g = r / 8, rr = r % 8;
        tr_item<0>(kp->in[IN_POOLW] + ((size_t)l * 4 + g) * 128 * 128, 128, 128, (bf16_t*)(ws + WS_POOLW) + ((size_t)l * 4 + g) * 128 * 128, 128, nullptr, kp->in[IN_POOLSCALE] + l * 512 + g * 128, scr, rr, lane); return; } r -= CV_POOL;
    if (r % 134 < 16) { tr_item_poolfold(kp->in[IN_WIN] + (size_t)l * D * INC, kp->in[IN_POOLW] + (size_t)l * 4 * 128 * 128, kp->in[IN_POOLSCALE] + l * 512, (bf16_t*)(ws + WS_WIN) + (size_t)l * ZLD * D, scr, (r / 134) * 16 + r % 134, lane); return; }
    tr_item<0>(kp->in[IN_WIN] + (size_t)l * D * INC, D, INC, (bf16_t*)(ws + WS_WIN) + (size_t)l * ZLD * D, D, nullptr, nullptr, scr, r, lane);
}
__device__ __forceinline__ void phase_prologue(KP kp, unsigned char* ws, int tid_, LAS unsigned char* lds, int vcu, int G) {
    const int tid = tid_, lane = tid & 63, wave = tid >> 6;
    {
        LAS float* red = (LAS float*)lds;
        LAS float* sil = (LAS float*)(lds + 32768);
        float* MOD = (float*)(ws + WS_MOD);
        for (int i = tid; i < 5 * D; i += NTHR) { const int row = i / D, k = i % D; const float v = (row < 4) ? kp->in[IN_C][row * D + k] : kp->in[IN_CCTX][k]; sil[i] = v / (1.f + __expf(-v)); }
        __syncthreads();
        for (int cb = vcu; cb < 256; cb += G) {
            const int gn0 = cb * 96, l = gn0 / MODW, n0 = gn0 % MODW;
            if (tid < 384) {
                const int cq = tid % 24, kg = tid / 24;
                const float* w = kp->in[IN_ADAW] + ((size_t)l * D + kg * 128) * MODW + n0 + cq * 4;
                f32x4 acc[5];
#pragma unroll
                for (int i = 0; i < 5; ++i) acc[i] = (f32x4){0.f, 0.f, 0.f, 0.f};
#pragma unroll 1
                for (int k0 = 0; k0 < 128; k0 += 16) { f32x4 wv[16];
#pragma unroll
                    for (int k = 0; k < 16; ++k) wv[k] = __builtin_nontemporal_load((const f32x4*)(w + (size_t)(k0 + k) * MODW));
#pragma unroll
                    for (int k = 0; k < 16; ++k) { const int kk = kg * 128 + k0 + k;
#pragma unroll
                        for (int i = 0; i < 5; ++i) acc[i] += wv[k] * sil[i * D + kk]; } }
#pragma unroll
                for (int i = 0; i < 5; ++i)
#pragma unroll
                    for (int e = 0; e < 4; ++e) red[(kg * 5 + i) * 96 + cq * 4 + e] = acc[i][e];
            }
            __syncthreads();
            if (tid < 480) { const int i = tid / 96, cn = tid % 96; float s = kp->in[IN_ADAB][l * MODW + n0 + cn];
#pragma unroll
                for (int kg = 0; kg < 16; ++kg) s += red[(kg * 5 + i) * 96 + cn];
                MOD[((size_t)l * 5 + i) * MODW + n0 + cn] = s; }
            __syncthreads();
        }
    }
    {
        float2* cs = (float2*)(ws + WS_CS);
        for (int idx = vcu * NTHR + tid; idx < SEQ * 32; idx += G * NTHR) {
            const int t = idx / 32, i = idx % 32, f = i & 15;
            const float base = ((f & 3) == 0) ? 1.0f : ((f & 3) == 1) ? 0.5623413251903491f : ((f & 3) == 2) ? 0.31622776601683794f : 0.1778279410038923f;
            const float dec = ((f >> 2) == 0) ? 1.0f : ((f >> 2) == 1) ? 0.1f : ((f >> 2) == 2) ? 0.01f : 0.001f;
            const float pos = (i < 16) ? (float)(t / GRIDW) : (float)(t % GRIDW);
            const float ang = pos * (base * dec);
            cs[idx] = make_float2(__cosf(ang), __sinf(ang));
        }
    }
    {
        for (int idx = vcu * NTHR + tid; idx < 2 * 64 * 256; idx += G * NTHR) { const int l = idx / (64 * 256), rem = idx % (64 * 256), row = INC + rem / 256, ch = rem % 256;
            *(u32x4*)((bf16_t*)(ws + WS_WIN) + ((size_t)l * ZLD + row) * D + ch * 8) = (u32x4){0u, 0u, 0u, 0u}; }
    }
    {
        LAS float* scr = (LAS float*)(lds + 32768) + wave * (64 * 33);
        const int gw = vcu * NWAVES + wave, NGW = G * NWAVES;
        for (int it = gw; it < CV_SEG0; it += NGW) conv_item0(kp, ws, 0, it, scr, lane);
    }
}

__device__ __forceinline__ void conv_itemq(KP kp, unsigned char* ws, int it, LAS float* scr, int lane) {
    if (it < CV_E1) { tr_item<0>(kp->in[IN_WOUT], D, D, (bf16_t*)(ws + WS_WOUT), D, nullptr, nullptr, scr, it, lane); return; }
    if (it < CV_E2) { tr_item<2>(kp->in[IN_WUP], D, UFF, (bf16_t*)(ws + WS_WUP), D, nullptr, nullptr, scr, it - CV_E1, lane); return; }
    if (it < CV_E3) { tr_item<0>(kp->in[IN_WDOWN], DFF, D, (bf16_t*)(ws + WS_WDOWN), DFF, nullptr, nullptr, scr, it - CV_E2, lane); return; }
    if (it < CV_E4) { conv_item0(kp, ws, 1, it - CV_E3, scr, lane); return; }
    if (it < CV_E5) { tr_item<0>(kp->in[IN_WOUT] + (size_t)D * D, D, D, (bf16_t*)(ws + WS_WOUT) + (size_t)D * D, D, nullptr, nullptr, scr, it - CV_E4, lane); return; }
    if (it < CV_E6) { tr_item<2>(kp->in[IN_WUP] + (size_t)D * UFF, D, UFF, (bf16_t*)(ws + WS_WUP) + (size_t)UFF * D, D, nullptr, nullptr, scr, it - CV_E5, lane); return; }
    tr_item<0>(kp->in[IN_WDOWN] + (size_t)DFF * D, DFF, D, (bf16_t*)(ws + WS_WDOWN) + (size_t)D * DFF, DFF, nullptr, nullptr, scr, it - CV_E6, lane);
}
constexpr int CV_CHUNK = 32;
__device__ __forceinline__ int conv_claim_chunk(unsigned char* ws, LAS unsigned char* lds, int tid) {
    volatile LAS unsigned* slot = (volatile LAS unsigned*)(lds + MISC_OFF + 16);
    __syncthreads();
    if (tid == 0) { const unsigned b_ = __hip_atomic_fetch_add((unsigned*)(ws + WS_CVQ), (unsigned)CV_CHUNK, __ATOMIC_RELAXED, __HIP_MEMORY_SCOPE_AGENT); slot[0] = b_; slot[2] = b_ + (unsigned)CV_CHUNK; }
    __syncthreads();
    return (int)__builtin_amdgcn_readfirstlane(slot[0]);
}
__device__ __forceinline__ void conv_chunk(KP kp, unsigned char* ws, LAS unsigned char* lds, int tid, int base) {
    const int lane = tid & 63, wave = tid >> 6; LAS float* scr = (LAS float*)(lds + 32768) + wave * (64 * 33);
    for (int j = wave; j < CV_CHUNK; j += NWAVES) { const int it = base + j; if (it < CV_E7) conv_itemq(kp, ws, it, scr, lane); }
}
__device__ __forceinline__ void conv_drain(KP kp, unsigned char* ws, LAS unsigned char* lds, int tid, int limit) {
    volatile LAS unsigned* slot = (volatile LAS unsigned*)(lds + MISC_OFF + 16);
    if ((int)__builtin_amdgcn_readfirstlane(slot[2]) >= limit) return;
    for (;;) {
        __syncthreads();
        if (tid == 0) { const unsigned v_ = __hip_atomic_load((unsigned*)(ws + WS_CVQ), __ATOMIC_RELAXED, __HIP_MEMORY_SCOPE_AGENT); slot[1] = v_; slot[2] = v_; }
        __syncthreads();
        if ((int)__builtin_amdgcn_readfirstlane(slot[1]) >= limit) break;
        const int base = conv_claim_chunk(ws, lds, tid); conv_chunk(kp, ws, lds, tid, base);
    }
}
__device__ __forceinline__ void conv_fill(KP kp, unsigned char* ws, LAS unsigned char* lds, int tid, int nchunks) {
    for (int n = 0; n < nchunks; ++n) { const int base = conv_claim_chunk(ws, lds, tid); if (base >= CV_E7) break; conv_chunk(kp, ws, lds, tid, base); }
}

constexpr int RP_GA = 0, RP_NB = 5 * D, RP_SH = 10 * D;
__device__ __forceinline__ void rowpass_row(const float* __restrict__ xin, const bf16_t* __restrict__ xinb, const bf16_t* __restrict__ y, const float* __restrict__ yp, float* __restrict__ xout, bf16_t* __restrict__ xoutb, bf16_t* __restrict__ hout,
                                            const LAS float* tab, int lane) {
    f32x4 xv[8];
    if (xinb) {
#pragma unroll
        for (int j = 0; j < 8; ++j) { const u32x2 w = __builtin_nontemporal_load((const u32x2*)(xinb + j * 256 + lane * 4)); xv[j] = (f32x4){__uint_as_float(w.x << 16), __uint_as_float(w.x & 0xffff0000u), __uint_as_float(w.y << 16), __uint_as_float(w.y & 0xffff0000u)}; }
    } else {
#pragma unroll
        for (int j = 0; j < 8; ++j) xv[j] = __builtin_nontemporal_load((const f32x4*)(xin + j * 256 + lane * 4));
    }
    if (y) {
        f32x4 yv[8]; float ss = 0.f;
#pragma unroll
        for (int j = 0; j < 8; ++j) { const u32x2 yw = *(const u32x2*)(y + j * 256 + lane * 4);
            yv[j] = (f32x4){__uint_as_float(yw.x << 16), __uint_as_float(yw.x & 0xffff0000u), __uint_as_float(yw.y << 16), __uint_as_float(yw.y & 0xffff0000u)};
            if (yp) {
                const bf16_t* ypb = (const bf16_t*)yp;
#pragma unroll
                for (int p = 0; p < 3; ++p) { const u32x2 pw = *(const u32x2*)(ypb + (size_t)p * RC * D + j * 256 + lane * 4);
                    yv[j] += (f32x4){__uint_as_float(pw.x << 16), __uint_as_float(pw.x & 0xffff0000u), __uint_as_float(pw.y << 16), __uint_as_float(pw.y & 0xffff0000u)}; } }
            ss += (yv[j].x * yv[j].x + yv[j].y * yv[j].y) + (yv[j].z * yv[j].z + yv[j].w * yv[j].w); }
        ss = wsum(ss, lane); const float rs = 1.0f / sqrtf(ss * (1.f / D) + EPS);
#pragma unroll
        for (int j = 0; j < 8; ++j) { const f32x4 ga = *(const LAS f32x4*)(tab + RP_GA + j * 256 + lane * 4); xv[j] += ga * (yv[j] * rs); }
    }
    if (xout) {
#pragma unroll
        for (int j = 0; j < 8; ++j) __builtin_nontemporal_store(xv[j], (f32x4*)(xout + j * 256 + lane * 4));
    }
    if (xoutb) {
#pragma unroll
        for (int j = 0; j < 8; ++j) { u32x2 w; w.x = cvt_pk_bf16(xv[j].x, xv[j].y); w.y = cvt_pk_bf16(xv[j].z, xv[j].w); __builtin_nontemporal_store(w, (u32x2*)(xoutb + j * 256 + lane * 4)); }
    }
    if (hout) {
        float ss = 0.f;
#pragma unroll
        for (int j = 0; j < 8; ++j) ss += (xv[j].x * xv[j].x + xv[j].y * xv[j].y) + (xv[j].z * xv[j].z + xv[j].w * xv[j].w);
        ss = wsum(ss, lane); const float rs = 1.0f / sqrtf(ss * (1.f / D) + EPS);
#pragma unroll
        for (int j = 0; j < 8; ++j) { const f32x4 nb = *(const LAS f32x4*)(tab + RP_NB + j * 256 + lane * 4), sh = *(const LAS f32x4*)(tab + RP_SH + j * 256 + lane * 4);
            const f32x4 o = (xv[j] * rs) * nb + sh; u32x2 w; w.x = cvt_pk_bf16(o.x, o.y); w.y = cvt_pk_bf16(o.z, o.w);
            *(u32x2*)(hout + j * 256 + lane * 4) = w; }
    }
}
__device__ __forceinline__ void phase_rowpass(KP kp, unsigned char* ws, LAS unsigned char* lds, int tid_, int kind, int l, int vcu, int G) {
    const int lane = tid_ & 63, wave = __builtin_amdgcn_readfirstlane(tid_ >> 6);
    const float* MOD = (const float*)(ws + WS_MOD);
    float* XR = (float*)(ws + WS_XR); const bf16_t* Y = (const bf16_t*)(ws + WS_Y); bf16_t* H = (bf16_t*)(ws + WS_H);
    const bool last = (l == 1);
    const int nrows = (kind == 0) ? R : (last ? RX : R);
    LAS float* T = (LAS float*)lds;
    {
        const int ln = (kind == 2 && !last) ? 1 : l;
        const float* ygain = (kind == 1) ? kp->in[IN_GPOSTMIX] + l * D : kp->in[IN_GPOSTFFN] + l * D;
        const float* ngain = (kind == 0) ? kp->in[IN_GPREMIX] : (kind == 1 ? kp->in[IN_GPREFFN] + l * D : kp->in[IN_GPREMIX] + 1 * D);
        const int goff = (kind == 1) ? 2 * D : 5 * D, shoff = (kind == 1) ? 3 * D : 0, scoff = (kind == 1) ? 4 * D : 1 * D;
        __syncthreads();
        for (int idx = tid_; idx < 5 * (D / 4); idx += NTHR) { const int b = idx / (D / 4), c4 = (idx % (D / 4)) * 4;
            const float* m = MOD + ((size_t)l * 5 + b) * MODW; const float* mn = MOD + ((size_t)ln * 5 + b) * MODW;
            if (kind != 0) *(LAS f32x4*)(T + RP_GA + b * D + c4) = *(const f32x4*)(m + goff + c4) * *(const f32x4*)(ygain + c4);
            if (!(kind == 2 && last)) { *(LAS f32x4*)(T + RP_NB + b * D + c4) = *(const f32x4*)(ngain + c4) * (*(const f32x4*)(mn + scoff + c4) + 1.f);
                                        *(LAS f32x4*)(T + RP_SH + b * D + c4) = *(const f32x4*)(mn + shoff + c4); } }
        __syncthreads();
    }
    for (int r = vcu * NWAVES + wave; r < nrows; r += G * NWAVES) {
        int b, t, L, isc; rowinfo(r, b, t, L, isc); const int mi = isc ? 4 : b;
        int ln = lane; asm volatile("" : "+v"(ln));
        size_t zo = 0; asm volatile("" : "+s"(zo));
        const LAS float* tab = T + mi * D;
        const float* ypr = (isc && l == 0) ? (const float*)((const bf16_t*)(ws + WS_YP) + (size_t)(r - RX) * D + zo) : nullptr;
        const float* xin0 = (isc ? kp->in[IN_CTX] + (size_t)(r - RX) * D : kp->in[IN_X] + (size_t)r * D) + zo;
        bf16_t* XB = (bf16_t*)XR;
        if (kind == 0) rowpass_row(xin0, nullptr, nullptr, nullptr, nullptr, nullptr, H + (size_t)r * D, tab, ln);
        else if (kind == 1) rowpass_row(xin0, (l == 0) ? nullptr : XB + (size_t)r * D + zo, Y + (size_t)r * D, ypr, nullptr, XB + (size_t)r * D, H + (size_t)r * D, tab, ln);
        else if (!last) rowpass_row(nullptr, XB + (size_t)r * D + zo, Y + (size_t)r * D, ypr, nullptr, XB + (size_t)r * D, H + (size_t)r * D, tab, ln);
        else rowpass_row(nullptr, XB + (size_t)r * D + zo, Y + (size_t)r * D, nullptr, kp->out + (size_t)r * D, nullptr, nullptr, tab, ln);
    }
    __syncthreads();
}

__device__ __forceinline__ void pre_rope(KP kp, unsigned char* ws, int tid_, int vcu, int G) {
    bf16_t* Z = (bf16_t*)(ws + WS_Z); bf16_t* KR = (bf16_t*)(ws + WS_KR); const float2* cs = (const float2*)(ws + WS_CS);
    const int gt = vcu * NTHR + tid_, NGT = G * NTHR;
    for (int idx0 = gt; idx0 < RX * 68; idx0 += 2 * NGT) {
        u32x4 q1[2], q2[2]; f32x4 cq[2][4]; bf16_t* dst[2]; bool ok[2];
#pragma unroll
        for (int k = 0; k < 2; ++k) { const int idx = idx0 + k * NGT; ok[k] = idx < RX * 68; const int id = ok[k] ? idx : gt;
            const int ic = id & 3, v = (id >> 2) % 17, r = id / 68, t = r % SEQ; const int col = (v < 16) ? Z_Q + v * 64 : Z_KR;
            const bf16_t* src = Z + (size_t)r * ZLD + col + ic * 8; q1[k] = ld16(src); q2[k] = ld16(src + 32);
            const f32x4* cp = (const f32x4*)(cs + t * 32 + ic * 8);
#pragma unroll
            for (int q = 0; q < 4; ++q) cq[k][q] = cp[q];
            dst[k] = (v < 16) ? Z + (size_t)r * ZLD + col + ic * 8 : KR + (size_t)r * 64 + ic * 8; }
#pragma unroll
        for (int k = 0; k < 2; ++k) { float x1[8], x2[8], o1[8], o2[8]; unpack8(q1[k], x1); unpack8(q2[k], x2);
#pragma unroll
            for (int q = 0; q < 4; ++q) { const f32x4 c2 = cq[k][q];
                o1[2 * q] = x1[2 * q] * c2.x - x2[2 * q] * c2.y; o2[2 * q] = x1[2 * q] * c2.y + x2[2 * q] * c2.x;
                o1[2 * q + 1] = x1[2 * q + 1] * c2.z - x2[2 * q + 1] * c2.w; o2[2 * q + 1] = x1[2 * q + 1] * c2.w + x2[2 * q + 1] * c2.z; }
            if (ok[k]) { st16(dst[k], pack8(o1)); st16(dst[k] + 32, pack8(o2)); } }
    }
    for (int idx = gt; idx < RC * 8; idx += NGT) { const int r = RX + idx / 8, ch = idx % 8; st16(KR + (size_t)r * 64 + ch * 8, ld16(Z + (size_t)r * ZLD + Z_KR + ch * 8)); }
}
__device__ __forceinline__ void pre_conv(KP kp, unsigned char* ws, int tid_, int l, int vcu, int G) {
    const bf16_t* Z = (const bf16_t*)(ws + WS_Z); bf16_t* MIX = (bf16_t*)(ws + WS_MIX);
    const float* cw = kp->in[IN_CONVW] + (size_t)l * 3 * 512;
    const int gt = vcu * NTHR + tid_, NGT = G * NTHR;
    for (int idx0 = gt; idx0 < R * 64; idx0 += 2 * NGT) {
        u32x4 gcq[2][3], hq[2][3], gbq[2]; int rr[2], cc[2]; bool ok[2];
#pragma unroll
        for (int k = 0; k < 2; ++k) { const int idx = idx0 + k * NGT; ok[k] = idx < R * 64; const int id = ok[k] ? idx : gt;
            const int ch = id & 63, r = id >> 6, c0 = ch * 8; int b, t, L, isc; rowinfo(r, b, t, L, isc); rr[k] = r; cc[k] = c0;
#pragma unroll
            for (int j = 0; j < 3; ++j) { const int tt = t + j - 1; const bool in = (tt >= 0 && tt < L); const bf16_t* zr = Z + (size_t)(in ? r + j - 1 : r) * ZLD;
                gcq[k][j] = in ? ld16(zr + Z_GC + c0) : (u32x4){0u, 0u, 0u, 0u}; hq[k][j] = ld16(zr + Z_H + c0); }
            gbq[k] = ld16(Z + (size_t)r * ZLD + Z_GB + c0); }
#pragma unroll
        for (int k = 0; k < 2; ++k) { float s[8];
#pragma unroll
            for (int e = 0; e < 8; ++e) s[e] = 0.f;
#pragma unroll
            for (int j = 0; j < 3; ++j) { float gc[8], hh[8]; unpack8(gcq[k][j], gc); unpack8(hq[k][j], hh);
                const f32x4 w0 = *(const f32x4*)(cw + j * 512 + cc[k]), w1 = *(const f32x4*)(cw + j * 512 + cc[k] + 4);
                s[0] += w0.x * gc[0] * hh[0]; s[1] += w0.y * gc[1] * hh[1]; s[2] += w0.z * gc[2] * hh[2]; s[3] += w0.w * gc[3] * hh[3];
                s[4] += w1.x * gc[4] * hh[4]; s[5] += w1.y * gc[5] * hh[5]; s[6] += w1.z * gc[6] * hh[6]; s[7] += w1.w * gc[7] * hh[7]; }
            float gb[8]; unpack8(gbq[k], gb);
#pragma unroll
            for (int e = 0; e < 8; ++e) s[e] *= gb[e];
            if (ok[k]) st16(MIX + (size_t)rr[k] * D + 1536 + cc[k], pack8(s)); }
    }
}
__device__ __forceinline__ void pre_pool(KP kp, unsigned char* ws, int tid_, int l, int vcu, int G) {
    const bf16_t* Z = (const bf16_t*)(ws + WS_Z); bf16_t* MIX = (bf16_t*)(ws + WS_MIX);
    const int gt = vcu * NTHR + tid_, NGT = G * NTHR;
    for (int idx = gt; idx < (R / 8) * 64; idx += NGT) {
        const int ch = idx & 63, strip = idx >> 6, r0 = strip * 8, c0 = ch * 8, g = c0 >> 7, half = 1 << g; int b, t0, L, isc; rowinfo(r0, b, t0, L, isc);
        u32x4 q[24];
#pragma unroll
        for (int i = 0; i < 24; ++i) { const int tt = t0 - 8 + i; const bool ok = (tt >= 0 && tt < L && i >= 8 - half && i < 16 + half);
            q[i] = ok ? ld16(Z + (size_t)(r0 - 8 + i) * ZLD + Z_POOL + c0) : (u32x4){0u, 0u, 0u, 0u}; }
        float sum[8];
#pragma unroll
        for (int e = 0; e < 8; ++e) sum[e] = 0.f;
#pragma unroll
        for (int i = 0; i < 16; ++i) { if (i >= 8 - half && i < 8 + half) { float v[8]; unpack8(q[i], v);
#pragma unroll
                for (int e = 0; e < 8; ++e) sum[e] += v[e]; } }
#pragma unroll
        for (int j = 0; j < 8; ++j) {
            const int t = t0 + j; int lo = t - half; if (lo < 0) lo = 0; int hi = t + half; if (hi > L) hi = L;
            const float inv = 1.0f / (float)(hi - lo);
            float self[8], o[8]; unpack8(q[8 + j], self);
#pragma unroll
            for (int e = 0; e < 8; ++e) o[e] = sum[e] * inv - self[e];
            st16(MIX + (size_t)(r0 + j) * D + c0, pack8(o));
            if (j < 7) {
                float dv[8], av[8];
                const u32x4 dq = (half == 1) ? q[7 + j] : (half == 2) ? q[6 + j] : (half == 4) ? q[4 + j] : q[j];
                const u32x4 aq = (half == 1) ? q[9 + j] : (half == 2) ? q[10 + j] : (half == 4) ? q[12 + j] : q[16 + j];
                unpack8(dq, dv); unpack8(aq, av);
#pragma unroll
                for (int e = 0; e < 8; ++e) sum[e] += av[e] - dv[e]; }
        }
    }
}
__device__ __forceinline__ void phase_act(KP kp, unsigned char* ws, int tid_, int l, int vcu, int G, size_t out_off = WS_ACT) {
    const bf16_t* U = (const bf16_t*)(ws + WS_U); bf16_t* ACT = (bf16_t*)(ws + out_off);
    const float* cw = kp->in[IN_FFNCONVW] + (size_t)l * 3 * UFF;
    const int nrows = (l == 1) ? RX : R;
    const int gt = vcu * NTHR + tid_, NGT = G * NTHR;
    for (int idx = gt; idx < (nrows / 8) * 704; idx += NGT) {
        const int chn = idx % 704, strip = idx / 704, r0 = strip * 8, j0 = chn * 8; int b, t0, L, isc; rowinfo(r0, b, t0, L, isc);
        const bf16_t* ub = U + (size_t)r0 * UFF + j0;
        u32x4 gq[10], vq[10];
#pragma unroll
        for (int i = 0; i < 10; ++i) { const int tt = t0 + i - 1; const bool ok = (tt >= 0 && tt < L);
            gq[i] = ok ? ld16(ub + (ptrdiff_t)(i - 1) * UFF) : (u32x4){0u, 0u, 0u, 0u}; vq[i] = ok ? ld16(ub + (ptrdiff_t)(i - 1) * UFF + DFF) : (u32x4){0u, 0u, 0u, 0u}; }
        float wg[3][8], wv[3][8];
#pragma unroll
        for (int k = 0; k < 3; ++k) { const f32x4 a0 = *(const f32x4*)(cw + k * UFF + j0), a1 = *(const f32x4*)(cw + k * UFF + j0 + 4), b0 = *(const f32x4*)(cw + k * UFF + DFF + j0), b1 = *(const f32x4*)(cw + k * UFF + DFF + j0 + 4);
            wg[k][0] = a0.x; wg[k][1] = a0.y; wg[k][2] = a0.z; wg[k][3] = a0.w; wg[k][4] = a1.x; wg[k][5] = a1.y; wg[k][6] = a1.z; wg[k][7] = a1.w;
            wv[k][0] = b0.x; wv[k][1] = b0.y; wv[k][2] = b0.z; wv[k][3] = b0.w; wv[k][4] = b1.x; wv[k][5] = b1.y; wv[k][6] = b1.z; wv[k][7] = b1.w; }
#pragma unroll
        for (int i = 0; i < 8; ++i) {
            float pg[8], cg_[8], ng[8], pv[8], cv[8], nv[8], o[8];
            unpack8(gq[i], pg); unpack8(gq[i + 1], cg_); unpack8(gq[i + 2], ng); unpack8(vq[i], pv); unpack8(vq[i + 1], cv); unpack8(vq[i + 2], nv);
#pragma unroll
            for (int e = 0; e < 8; ++e) { const float gsum = wg[0][e] * pg[e] + wg[1][e] * cg_[e] + wg[2][e] * ng[e]; const float vsum = wv[0][e] * pv[e] + wv[1][e] * cv[e] + wv[2][e] * nv[e];
                o[e] = gsum * __builtin_amdgcn_rcpf(1.f + __expf(-gsum)) * vsum; }
            st16(ACT + (size_t)(r0 + i) * DFF + j0, pack8(o));
        }
    }
}

__device__ __forceinline__ void phase_act_edges(KP kp, unsigned char* ws, int tid_, int l, int vcu, int G) {
    const bf16_t* EDGE = (const bf16_t*)(ws + WS_EDGE); bf16_t* ACT = (bf16_t*)(ws + WS_ACT);
    const float* cw = kp->in[IN_FFNCONVW] + (size_t)l * 3 * UFF;
    const int ntile = ((l == 1) ? RX : R) / 256;
    const int gt = vcu * NTHR + tid_, NGT = G * NTHR;
    for (int idx = gt; idx < ntile * 2 * 704; idx += NGT) {
        const int chn = idx % 704, which = (idx / 704) & 1, pm = idx / 1408, j0 = chn * 8;
        const bool seq_first = (pm >= RX / 256) || (pm % (SEQ / 256) == 0), seq_last = (pm >= RX / 256) || (pm % (SEQ / 256) == SEQ / 256 - 1);
        const bf16_t* e0 = EDGE + (size_t)pm * 4 * UFF + j0;
        const bf16_t* pr = which == 0 ? (seq_first ? nullptr : e0 - (size_t)4 * UFF + (size_t)3 * UFF) : e0 + (size_t)2 * UFF;
        const bf16_t* cu = which == 0 ? e0 : e0 + (size_t)3 * UFF;
        const bf16_t* nx = which == 0 ? e0 + (size_t)1 * UFF : (seq_last ? nullptr : e0 + (size_t)4 * UFF);
        float pg[8], pv[8], cg_[8], cv[8], ng[8], nv[8], o[8];
        if (pr) { unpack8(ld16(pr), pg); unpack8(ld16(pr + DFF), pv); } else {
#pragma unroll
            for (int e = 0; e < 8; ++e) { pg[e] = 0.f; pv[e] = 0.f; } }
        unpack8(ld16(cu), cg_); unpack8(ld16(cu + DFF), cv);
        if (nx) { unpack8(ld16(nx), ng); unpack8(ld16(nx + DFF), nv); } else {
#pragma unroll
            for (int e = 0; e < 8; ++e) { ng[e] = 0.f; nv[e] = 0.f; } }
#pragma unroll
        for (int e = 0; e < 8; ++e) { const float gsum = cw[0 * UFF + j0 + e] * pg[e] + cw[1 * UFF + j0 + e] * cg_[e] + cw[2 * UFF + j0 + e] * ng[e];
            const float vsum = cw[0 * UFF + DFF + j0 + e] * pv[e] + cw[1 * UFF + DFF + j0 + e] * cv[e] + cw[2 * UFF + DFF + j0 + e] * nv[e];
            o[e] = gsum * __builtin_amdgcn_rcpf(1.f + __expf(-gsum)) * vsum; }
        st16(ACT + (size_t)(pm * 256 + (which ? 255 : 0)) * DFF + j0, pack8(o));
    }
}

namespace pg8 {
constexpr int BM = 256, BK = 64, HALF = 128, HTB = HALF * BK * 2, STAGE_BYTES = 8 * HTB, NXCD = 8, WGM = 8;
__host__ __device__ __forceinline__ int lds_byte(int r, int c) { const int st = (r >> 4) * 2 + (c >> 5), rr = r & 15, cc = c & 31, ob = rr * 64 + cc * 2; return st * 1024 + (ob ^ (((ob >> 9) & 1) << 5)); }
__host__ __device__ __forceinline__ void stage_rc(int b, int& R_, int& C_) { const int st = b / 1024, sb = b % 1024, swz = sb ^ (((sb >> 9) & 1) << 5); R_ = (st >> 1) * 16 + swz / 64; C_ = (st & 1) * 32 + (swz % 64) / 2; }
__host__ __device__ __forceinline__ int perm32(int rho) { const int n = rho >> 4, i = rho & 15; return 8 * (i >> 2) + 4 * n + (i & 3); }
struct Unit { int pm, pn, kt0, nkt, part; };
struct Gemm { const bf16_t* A; const bf16_t* Bt; int lda, ldb, K; };
struct TileOrder {
    int nM, nN, nwg, G, c, nt, nMs, ksplit;
    __device__ void init(int nM_, int nN_, int G_, int c_, int nt_, int nMs_ = 0, int ksplit_ = 1) { nM = nM_; nN = nN_; nwg = nM * nN; G = G_; c = c_; nt = nt_; nMs = nMs_; ksplit = ksplit_; }
    __device__ __forceinline__ bool next(int i, Unit& u) const {
        const int L = i * G + c; const int nsp = nMs * nN * ksplit; if (L >= nwg + nsp) return false;
        const bool sp = (L >= nwg);
        const int j = sp ? L - nwg : 0, part = j % ksplit, t = j / ksplit, nk = nt / ksplit;
        int wgid = sp ? 0 : L; { const int q = nwg / NXCD, r = nwg % NXCD, xcd = wgid % NXCD, off = wgid / NXCD; wgid = (xcd < r ? xcd * (q + 1) : r * (q + 1) + (xcd - r) * q) + off; }
        const int nig = WGM * nN, gid = wgid / nig, fm = gid * WGM, gsz = (nM - fm) < WGM ? (nM - fm) : WGM;
        const int pm0 = fm + ((wgid % nig) % gsz), pn0 = (wgid % nig) / gsz;
        u.pm = sp ? nM + t / nN : pm0; u.pn = sp ? t % nN : pn0; u.kt0 = sp ? part * nk : 0; u.nkt = sp ? nk : nt; u.part = sp ? part : 0;
        return true;
    }
};
typedef f32x4 Acc[2][2][4][2];
template <class T, class = void> struct epi_aperm { static constexpr bool value = false; };
template <class T> struct epi_aperm<T, decltype((void)T::APERM)> { static constexpr bool value = true; };
template <class T, class = void> struct epi_prefetch { static constexpr bool value = false; };
template <class T> struct epi_prefetch<T, decltype((void)T::PREFETCH)> { static constexpr bool value = true; };
template <class Epi, class Sched, bool ALIGN_EPI>
__device__ __forceinline__ void gemm_phase(LAS unsigned char* lds, const Gemm g, const Sched& S, const Epi& E, int tid) {
    const int wid = __builtin_amdgcn_readfirstlane(tid >> 6), lane = tid & 63, wr = wid >> 2, wc = wid & 3, fr = lane & 15, fq = lane >> 4;
    unsigned voffA[2], voffB[2];
#pragma unroll
    for (int i = 0; i < 2; ++i) { int R_, C_; stage_rc(tid * 16 + i * 8192, R_, C_); const int Rb = Epi::PERM ? ((R_ & ~31) + perm32(R_ & 31)) : R_;
        const int Ra = epi_aperm<Epi>::value ? ((R_ & ~63) + ((R_ & 15) << 2) + ((R_ >> 4) & 3)) : R_;
        voffA[i] = (unsigned)(Ra * g.lda + C_) * 2u; voffB[i] = (unsigned)(Rb * g.ldb + C_) * 2u; }
    const size_t kstep = (size_t)(BK * 2);
    const size_t hstepA = (size_t)HALF * g.lda * 2, hstepB = (size_t)HALF * g.ldb * 2;
    const size_t tstepA = 2 * hstepA, tstepB = 2 * hstepB;
    const unsigned ldsw = (unsigned)wid * 1024u;
    const int aoff = lds_byte(wr * 64 + fr, fq * 8), boff = lds_byte(wc * 32 + fr, fq * 8);
#define PG8_SA(b, h) (((b) * 2 + (h)) * HTB)
#define PG8_SB(b, h) ((4 + (b) * 2 + (h)) * HTB)
#define PG8_STAGE(bufoff, gbase, voff) do { _Pragma("unroll") for (int _i = 0; _i < 2; ++_i) \
        __builtin_amdgcn_global_load_lds((const unsigned*)((const char*)(gbase) + (voff)[_i]), (LAS unsigned*)(lds + (bufoff) + ldsw + _i * 8192), 16, 0, 0); } while (0)
#define PG8_LDA(dst, b, h) do { _Pragma("unroll") for (int m = 0; m < 4; ++m) _Pragma("unroll") for (int k = 0; k < 2; ++k) dst[m][k] = *(const LAS bf16x8*)(lds + PG8_SA(b, h) + aoff + m * 2048 + k * 1024); } while (0)
#define PG8_LDB(dst, b, h) do { _Pragma("unroll") for (int n = 0; n < 2; ++n) _Pragma("unroll") for (int k = 0; k < 2; ++k) dst[n][k] = *(const LAS bf16x8*)(lds + PG8_SB(b, h) + boff + n * 2048 + k * 1024); } while (0)
#define PG8_MMA(ai, bj, At, Bt) do { __builtin_amdgcn_s_setprio(1); _Pragma("unroll") for (int m = 0; m < 4; ++m) _Pragma("unroll") for (int n = 0; n < 2; ++n) _Pragma("unroll") for (int k = 0; k < 2; ++k) \
        acc[ai][bj][m][n] = __builtin_amdgcn_mfma_f32_16x16x32_bf16(Bt[n][k], At[m][k], acc[ai][bj][m][n], 0, 0, 0); __builtin_amdgcn_s_setprio(0); } while (0)
#define PG8_WAIT_V(n) asm volatile("s_waitcnt vmcnt(" #n ")" ::: "memory")
#define PG8_WAIT_L(n) asm volatile("s_waitcnt lgkmcnt(" #n ")" ::: "memory")
#define PG8_BAR __builtin_amdgcn_s_barrier()
#define PG8_SCHED __builtin_amdgcn_sched_barrier(0)
    Unit cur, nxt; int ui = 0;
    if (!S.next(0, cur)) return;
#ifdef PROBE_G
    unsigned long long pe_tot = 0;
#endif
    f32x4 acc[2][2][4][2];
#pragma unroll
    for (int a = 0; a < 2; ++a)
#pragma unroll
        for (int b = 0; b < 2; ++b)
#pragma unroll
            for (int m = 0; m < 4; ++m)
#pragma unroll
                for (int n = 0; n < 2; ++n) acc[a][b][m][n] = (f32x4){0.f, 0.f, 0.f, 0.f};
    bf16x8 At[4][2], B0[2][2], B1[2][2];
    const char* cA = (const char*)g.A + (size_t)cur.pm * tstepA + (size_t)cur.kt0 * kstep; const char* cB = (const char*)g.Bt + (size_t)cur.pn * tstepB + (size_t)cur.kt0 * kstep;
    int nt = cur.nkt;
    if constexpr (epi_prefetch<Epi>::value) E.prefetch(cur, 0, wid, lane);
    PG8_STAGE(PG8_SB(0, 0), cB, voffB); PG8_STAGE(PG8_SB(0, 1), cB + hstepB, voffB); PG8_STAGE(PG8_SA(0, 0), cA, voffA); PG8_STAGE(PG8_SA(0, 1), cA + hstepA, voffA);
    if (wr == 1) PG8_BAR;
    PG8_WAIT_V(2); PG8_BAR;
    PG8_STAGE(PG8_SB(1, 0), cB + kstep, voffB); PG8_STAGE(PG8_SA(1, 0), cA + kstep, voffA); PG8_STAGE(PG8_SB(1, 1), cB + hstepB + kstep, voffB);
    PG8_WAIT_V(6); PG8_BAR;
    for (;;) {
        const bool has_next = S.next(ui + 1, nxt);
        const char* nA = has_next ? (const char*)g.A + (size_t)nxt.pm * tstepA + (size_t)nxt.kt0 * kstep : cA; const char* nB = has_next ? (const char*)g.Bt + (size_t)nxt.pn * tstepB + (size_t)nxt.kt0 * kstep : cB;
#pragma unroll 1
        for (int t = 0; t < nt; t += 2) {
            const bool last = (t == nt - 2);
            const char* a1 = cA + (size_t)(t + 1) * kstep;
            const char* a2 = last ? nA : cA + (size_t)(t + 2) * kstep; const char* b2 = last ? nB : cB + (size_t)(t + 2) * kstep;
            const char* a3 = a2 + kstep; const char* b3 = b2 + kstep;
            PG8_LDB(B0, 0, 0); PG8_LDB(B1, 0, 1); PG8_SCHED; PG8_LDA(At, 0, 0); PG8_STAGE(PG8_SA(1, 1), a1 + hstepA, voffA);
            PG8_WAIT_V(8); PG8_WAIT_L(0); PG8_BAR; PG8_MMA(0, 0, At, B0); PG8_MMA(0, 1, At, B1); PG8_BAR; PG8_SCHED;
            PG8_LDA(At, 0, 1); PG8_STAGE(PG8_SB(0, 0), b2, voffB); PG8_STAGE(PG8_SB(0, 1), b2 + hstepB, voffB); PG8_STAGE(PG8_SA(0, 0), a2, voffA);
            PG8_WAIT_V(8); PG8_WAIT_L(0); PG8_BAR; PG8_MMA(1, 0, At, B0); PG8_MMA(1, 1, At, B1); PG8_BAR; PG8_SCHED;
            PG8_LDB(B0, 1, 0); PG8_LDB(B1, 1, 1); PG8_SCHED; PG8_LDA(At, 1, 0); PG8_STAGE(PG8_SA(0, 1), a2 + hstepA, voffA);
            PG8_WAIT_V(8); PG8_WAIT_L(0); PG8_BAR; PG8_MMA(0, 0, At, B0); PG8_MMA(0, 1, At, B1); PG8_BAR; PG8_SCHED;
            PG8_LDA(At, 1, 1); PG8_STAGE(PG8_SB(1, 0), b3, voffB); PG8_STAGE(PG8_SB(1, 1), b3 + hstepB, voffB); PG8_STAGE(PG8_SA(1, 0), a3, voffA);
            PG8_WAIT_V(8); PG8_WAIT_L(0); PG8_BAR; PG8_MMA(1, 0, At, B0); PG8_MMA(1, 1, At, B1); PG8_BAR; PG8_SCHED;
        }
        if constexpr (ALIGN_EPI) { if (wr == 0) PG8_BAR; }
#ifdef PROBE_G
        const unsigned long long pe0 = __builtin_amdgcn_s_memrealtime();
#endif
        if constexpr (epi_prefetch<Epi>::value) E.run(acc, cur, wr, wc, fr, fq, ui & 1); else E(acc, cur, wr, wc, fr, fq);
#ifdef PROBE_G
        pe_tot += __builtin_amdgcn_s_memrealtime() - pe0;
#endif
        if (!has_next) break;
#pragma unroll
        for (int a = 0; a < 2; ++a)
#pragma unroll
            for (int b = 0; b < 2; ++b)
#pragma unroll
                for (int m = 0; m < 4; ++m)
#pragma unroll
                    for (int n = 0; n < 2; ++n) acc[a][b][m][n] = (f32x4){0.f, 0.f, 0.f, 0.f};
        if constexpr (epi_prefetch<Epi>::value) E.prefetch(nxt, (ui + 1) & 1, wid, lane);
        cur = nxt; cA = nA; cB = nB; nt = cur.nkt; ++ui;
        if constexpr (ALIGN_EPI) { if (wr == 1) PG8_BAR; }
    }
    PG8_WAIT_V(0);
    if constexpr (!ALIGN_EPI) { if (wr == 0) PG8_BAR; }
    PG8_BAR;
#ifdef PROBE_G
    if (tid == 0) *(volatile LAS unsigned long long*)(lds + MISC_OFF + 32) = pe_tot;
#endif
#undef PG8_SA
#undef PG8_SB
#undef PG8_STAGE
#undef PG8_LDA
#undef PG8_LDB
#undef PG8_MMA
#undef PG8_WAIT_V
#undef PG8_WAIT_L
#undef PG8_BAR
#undef PG8_SCHED
}

struct EpiF32 {
    static constexpr bool PERM = false;
    float* C; int ldc; float* Cp; int pm_split; size_t part_stride;
    __device__ __forceinline__ void operator()(const Acc& acc, const Unit& u, int wr, int wc, int fr, int fq) const {
        const int col0 = u.pn * BM + wc * 32 + 4 * fq;
        float* base = C; int row0 = u.pm * BM + wr * 64 + fr;
        if (u.part > 0) { base = Cp + (size_t)(u.part - 1) * part_stride; row0 -= pm_split * BM; }
#pragma unroll
        for (int ai = 0; ai < 2; ++ai)
#pragma unroll
            for (int m = 0; m < 4; ++m) { float* rowp = base + (size_t)(row0 + ai * HALF + m * 16) * ldc + col0;
#pragma unroll
                for (int bj = 0; bj < 2; ++bj)
#pragma unroll
                    for (int n = 0; n < 2; ++n) *(f32x4*)(rowp + bj * HALF + n * 16) = acc[ai][bj][m][n]; }
    }
};
struct EpiY {
    static constexpr bool PERM = true;
    bf16_t* Y; float* Cp; int pm_split; size_t part_stride;
    __device__ __forceinline__ void operator()(const Acc& acc, const Unit& u, int wr, int wc, int fr, int fq) const {
        const int row0 = u.pm * BM + wr * 64 + fr, col0 = u.pn * BM + wc * 32 + 8 * fq;
        if (u.part > 0) {
            bf16_t* base = (bf16_t*)Cp + (size_t)(u.part - 1) * part_stride;
#pragma unroll
            for (int ai = 0; ai < 2; ++ai)
#pragma unroll
                for (int m = 0; m < 4; ++m) { bf16_t* rowp = base + (size_t)(row0 - pm_split * BM + ai * HALF + m * 16) * D + col0;
#pragma unroll
                    for (int bj = 0; bj < 2; ++bj) { const f32x4 v0 = acc[ai][bj][m][0], v1 = acc[ai][bj][m][1];
                        u32x4 w; w.x = cvt_pk_bf16(v0[0], v0[1]); w.y = cvt_pk_bf16(v0[2], v0[3]); w.z = cvt_pk_bf16(v1[0], v1[1]); w.w = cvt_pk_bf16(v1[2], v1[3]);
                        *(u32x4*)(rowp + bj * HALF) = w; } }
        } else if (u.part == 0) {
#pragma unroll
            for (int ai = 0; ai < 2; ++ai)
#pragma unroll
                for (int m = 0; m < 4; ++m) { bf16_t* rowp = Y + (size_t)(row0 + ai * HALF + m * 16) * D + col0;
#pragma unroll
                    for (int bj = 0; bj < 2; ++bj) { const f32x4 v0 = acc[ai][bj][m][0], v1 = acc[ai][bj][m][1];
                        u32x4 w; w.x = cvt_pk_bf16(v0[0], v0[1]); w.y = cvt_pk_bf16(v0[2], v0[3]); w.z = cvt_pk_bf16(v1[0], v1[1]); w.w = cvt_pk_bf16(v1[2], v1[3]);
                        *(u32x4*)(rowp + bj * HALF) = w; } }
        } else {
            float* base = Cp + (size_t)(u.part - 1) * part_stride;
#pragma unroll
            for (int ai = 0; ai < 2; ++ai)
#pragma unroll
                for (int m = 0; m < 4; ++m) { float* rowp = base + (size_t)(row0 - pm_split * BM + ai * HALF + m * 16) * D + col0;
#pragma unroll
                    for (int bj = 0; bj < 2; ++bj) { *(f32x4*)(rowp + bj * HALF) = acc[ai][bj][m][0]; *(f32x4*)(rowp + bj * HALF + 4) = acc[ai][bj][m][1]; } }
        }
    }
};
struct EpiAct {
    static constexpr bool PERM = true;
    bf16_t* ACT; bf16_t* EDGE; const float* cw; LAS float* hl;
    static constexpr bool PREFETCH = true;
    static constexpr bool APERM = true;
    __device__ __forceinline__ void prefetch(const Unit& u, int slot, int wid, int lane) const {
        if (wid < 3) __builtin_amdgcn_global_load_lds((const unsigned*)(cw + (size_t)wid * UFF + (lane >> 5) * DFF + u.pn * 128 + 4 * (lane & 31)), (LAS unsigned*)(hl + 2048 + slot * 768 + wid * 256), 16, 0, 0);
    }
    __device__ __forceinline__ void run(const Acc& acc, const Unit& u, int wr, int wc, int fr, int fq, int slot) const {
        const LAS float* wl = hl + 2048 + slot * 768;
        const int ch0 = u.pn * 128 + wc * 32 + 8 * fq;
        const int colh = wc * 32 + 8 * fq;
#pragma unroll
        for (int ai = 0; ai < 2; ++ai) { const int blk = ai * 2 + wr;
            if (fr == 0) {
#pragma unroll
                for (int bj = 0; bj < 2; ++bj)
#pragma unroll
                    for (int n = 0; n < 2; ++n) *(LAS f32x4*)(hl + (blk * 2 + 0) * 256 + bj * 128 + colh + 4 * n) = acc[ai][bj][0][n]; }
            if (fr == 15) {
#pragma unroll
                for (int bj = 0; bj < 2; ++bj)
#pragma unroll
                    for (int n = 0; n < 2; ++n) *(LAS f32x4*)(hl + (blk * 2 + 1) * 256 + bj * 128 + colh + 4 * n) = acc[ai][bj][3][n]; } }
        asm volatile("s_waitcnt lgkmcnt(0)" ::: "memory"); __builtin_amdgcn_s_barrier(); asm volatile("" ::: "memory");
        const int rowt = u.pm * BM;
#pragma unroll
        for (int ai = 0; ai < 2; ++ai) { const int blk = ai * 2 + wr;
            float o[4][8];
#pragma unroll
            for (int n = 0; n < 2; ++n) {
#pragma unroll
                for (int bj = 0; bj < 2; ++bj) {
                    f32x4 W[3];
#pragma unroll
                    for (int k = 0; k < 3; ++k) W[k] = *(const LAS f32x4*)(wl + k * 256 + bj * 128 + colh + 4 * n);
                    const f32x4 HU = (blk > 0) ? *(const LAS f32x4*)(hl + ((blk - 1) * 2 + 1) * 256 + bj * 128 + colh + 4 * n) : (f32x4){0.f, 0.f, 0.f, 0.f};
                    const f32x4 HD = (blk < 3) ? *(const LAS f32x4*)(hl + ((blk + 1) * 2 + 0) * 256 + bj * 128 + colh + 4 * n) : (f32x4){0.f, 0.f, 0.f, 0.f};
#pragma unroll
                    for (int e = 0; e < 4; ++e) {
                        const float w0 = W[0][e], w1 = W[1][e], w2 = W[2][e];
                        const float v0 = acc[ai][bj][0][n][e], v1 = acc[ai][bj][1][n][e], v2 = acc[ai][bj][2][n][e], v3 = acc[ai][bj][3][n][e];
                        const float up0 = __int_as_float(__builtin_amdgcn_update_dpp(__float_as_int(HU[e]), __float_as_int(v3), 0x111, 0xf, 0xf, false));
                        const float dn3 = __int_as_float(__builtin_amdgcn_update_dpp(__float_as_int(HD[e]), __float_as_int(v0), 0x101, 0xf, 0xf, false));
                        float r_[4];
                        r_[0] = w0 * up0 + w1 * v0 + w2 * v1; r_[1] = w0 * v0 + w1 * v1 + w2 * v2; r_[2] = w0 * v1 + w1 * v2 + w2 * v3; r_[3] = w0 * v2 + w1 * v3 + w2 * dn3;
#pragma unroll
                        for (int m = 0; m < 4; ++m) { if (bj == 0) o[m][4 * n + e] = r_[m] * __builtin_amdgcn_rcpf(1.f + __expf(-r_[m])); else o[m][4 * n + e] *= r_[m]; }
                    }
                }
                __builtin_amdgcn_sched_barrier(0);
            }
#pragma unroll
            for (int m = 0; m < 4; ++m) { const int rl = ai * HALF + wr * 64 + 4 * fr + m;
                if (rl != 0 && rl != 255) *(u32x4*)(ACT + (size_t)(rowt + rl) * DFF + ch0) = pack8(o[m]); }
            __builtin_amdgcn_sched_barrier(0);
        }
#pragma unroll
        for (int ai = 0; ai < 2; ++ai) {
#pragma unroll
            for (int m = 0; m < 4; ++m) { const int rl = ai * HALF + wr * 64 + 4 * fr + m;
                const int ek = (rl == 0) ? 0 : (rl == 1) ? 1 : (rl == 254) ? 2 : (rl == 255) ? 3 : -1;
                if (ek >= 0) {
#pragma unroll
                    for (int bj = 0; bj < 2; ++bj) { const f32x4 v0 = acc[ai][bj][m][0], v1 = acc[ai][bj][m][1];
                        u32x4 w; w.x = cvt_pk_bf16(v0[0], v0[1]); w.y = cvt_pk_bf16(v0[2], v0[3]); w.z = cvt_pk_bf16(v1[0], v1[1]); w.w = cvt_pk_bf16(v1[2], v1[3]);
                        *(u32x4*)(EDGE + ((size_t)u.pm * 4 + ek) * UFF + bj * DFF + ch0) = w; } }
            }
        }
        asm volatile("s_waitcnt lgkmcnt(0)" ::: "memory"); __builtin_amdgcn_s_barrier(); asm volatile("" ::: "memory");
    }
};
struct EpiBf16 {
    static constexpr bool PERM = true;
    bf16_t* O; int ldc;
    __device__ __forceinline__ void operator()(const Acc& acc, const Unit& u, int wr, int wc, int fr, int fq) const {
        const int row0 = u.pm * BM + wr * 64 + fr, col0 = u.pn * BM + wc * 32 + 8 * fq;
#pragma unroll
        for (int ai = 0; ai < 2; ++ai)
#pragma unroll
            for (int m = 0; m < 4; ++m) { bf16_t* rowp = O + (size_t)(row0 + ai * HALF + m * 16) * ldc + col0;
#pragma unroll
                for (int bj = 0; bj < 2; ++bj) { const f32x4 v0 = acc[ai][bj][m][0], v1 = acc[ai][bj][m][1];
                    u32x4 w; w.x = cvt_pk_bf16(v0[0], v0[1]); w.y = cvt_pk_bf16(v0[2], v0[3]); w.z = cvt_pk_bf16(v1[0], v1[1]); w.w = cvt_pk_bf16(v1[2], v1[3]);
                    *(u32x4*)(rowp + bj * HALF) = w; } }
    }
};
struct EpiZ {
    static constexpr bool PERM = true;
    bf16_t* Z; float* rsq;
    __device__ __forceinline__ void operator()(const Acc& acc, const Unit& u, int wr, int wc, int fr, int fq) const {
        const int row0 = u.pm * BM + wr * 64 + fr, col0 = u.pn * BM + wc * 32 + 8 * fq;
#pragma unroll
        for (int ai = 0; ai < 2; ++ai)
#pragma unroll
            for (int m = 0; m < 4; ++m) { bf16_t* rowp = Z + (size_t)(row0 + ai * HALF + m * 16) * ZLD + col0;
#pragma unroll
                for (int bj = 0; bj < 2; ++bj) { const f32x4 v0 = acc[ai][bj][m][0], v1 = acc[ai][bj][m][1];
                    u32x4 w; w.x = cvt_pk_bf16(v0[0], v0[1]); w.y = cvt_pk_bf16(v0[2], v0[3]); w.z = cvt_pk_bf16(v1[0], v1[1]); w.w = cvt_pk_bf16(v1[2], v1[3]);
                    *(u32x4*)(rowp + bj * HALF) = w; } }
        if (u.pn >= 8 && u.pn <= 10) {
#pragma unroll
            for (int bj = 0; bj < 2; ++bj) { const int cb = u.pn * BM + bj * HALF + wc * 32;
                const int region = (cb >= Z_CQ && cb < Z_CKV) ? 0 : ((cb >= Z_CKV && cb < Z_KR) ? 1 : -1);
                if (region >= 0) {
#pragma unroll
                    for (int ai = 0; ai < 2; ++ai)
#pragma unroll
                        for (int m = 0; m < 4; ++m) { const f32x4 v0 = acc[ai][bj][m][0], v1 = acc[ai][bj][m][1];
                            float s = (v0[0] * v0[0] + v0[1] * v0[1]) + (v0[2] * v0[2] + v0[3] * v0[3]) + (v1[0] * v1[0] + v1[1] * v1[1]) + (v1[2] * v1[2] + v1[3] * v1[3]);
                            s += sx(s, 16, fq * 16 + fr); s += sx(s, 32, fq * 16 + fr);
                            if (fq == 0) atomicAdd(rsq + (size_t)(row0 + ai * HALF + m * 16) * 2 + region, s); } } }
        }
    }
};
struct EpiQ {
    static constexpr bool PERM = true;
    bf16_t* QM; const float* rsq; const float2* cs;
    __device__ __forceinline__ void operator()(const Acc& acc, const Unit& u, int wr, int wc, int fr, int fq) const {
        const int row0 = u.pm * BM + wr * 64 + fr;
        float rsv[8];
#pragma unroll
        for (int i = 0; i < 8; ++i) rsv[i] = rsq[(size_t)(row0 + (i >> 2) * HALF + (i & 3) * 16) * 2];
        if (u.pn < 2) {
#pragma unroll
            for (int ai = 0; ai < 2; ++ai)
#pragma unroll
                for (int m = 0; m < 4; ++m) { const int row = row0 + ai * HALF + m * 16; const float rs = __builtin_amdgcn_rsqf(rsv[ai * 4 + m] * (1.f / 384.f) + EPS);
#pragma unroll
                    for (int bj = 0; bj < 2; ++bj) { const f32x4 v0 = acc[ai][bj][m][0] * rs, v1 = acc[ai][bj][m][1] * rs;
                        u32x4 w; w.x = cvt_pk_bf16(v0[0], v0[1]); w.y = cvt_pk_bf16(v0[2], v0[3]); w.z = cvt_pk_bf16(v1[0], v1[1]); w.w = cvt_pk_bf16(v1[2], v1[3]);
                        *(u32x4*)(QM + (size_t)row * 768 + (2 * u.pn + bj) * 192 + wc * 32 + 8 * fq) = w; }
                    asm volatile("" ::: "memory"); }
        } else {
            const bool rope = (u.pm < RX / BM);
            f32x4 cb[2][4];
            if (rope) { const f32x4* cp = (const f32x4*)(cs + (row0 % SEQ) * 32 + 8 * fq);
#pragma unroll
                for (int q = 0; q < 4; ++q) cb[0][q] = cp[q]; }
#pragma unroll
            for (int it = 0; it < 8; ++it) { const int ai = it >> 2, m = it & 3; const int row = row0 + ai * HALF + m * 16; const float rs = __builtin_amdgcn_rsqf(rsv[it] * (1.f / 384.f) + EPS);
                if (rope && it < 7) { const int rown = row0 + ((it + 1) >> 2) * HALF + ((it + 1) & 3) * 16; const f32x4* cp = (const f32x4*)(cs + (rown % SEQ) * 32 + 8 * fq);
#pragma unroll
                    for (int q = 0; q < 4; ++q) cb[(it + 1) & 1][q] = cp[q]; }
                float x1[8], x2[8], o1[8], o2[8];
#pragma unroll
                for (int e = 0; e < 4; ++e) { x1[e] = acc[ai][0][m][0][e] * rs; x1[4 + e] = acc[ai][0][m][1][e] * rs; x2[e] = acc[ai][1][m][0][e] * rs; x2[4 + e] = acc[ai][1][m][1][e] * rs; }
                if (rope) {
#pragma unroll
                    for (int q = 0; q < 4; ++q) { const f32x4 c2 = cb[it & 1][q];
                        o1[2 * q] = x1[2 * q] * c2.x - x2[2 * q] * c2.y; o2[2 * q] = x1[2 * q] * c2.y + x2[2 * q] * c2.x;
                        o1[2 * q + 1] = x1[2 * q + 1] * c2.z - x2[2 * q + 1] * c2.w; o2[2 * q + 1] = x1[2 * q + 1] * c2.w + x2[2 * q + 1] * c2.z; }
                } else {
#pragma unroll
                    for (int e = 0; e < 8; ++e) { o1[e] = x1[e]; o2[e] = x2[e]; } }
                bf16_t* dst = QM + (size_t)row * 768 + wc * 192 + 128 + 8 * fq;
                st16(dst, pack8(o1)); st16(dst + 32, pack8(o2));
                __builtin_amdgcn_sched_barrier(0); }
        }
    }
};
struct EpiKV {
    static constexpr bool PERM = true;
    bf16_t* KN; bf16_t* VM; const float* rsq;
    __device__ __forceinline__ void operator()(const Acc& acc, const Unit& u, int wr, int wc, int fr, int fq) const {
        const int row0 = u.pm * BM + wr * 64 + fr;
        float rsv[8];
#pragma unroll
        for (int i = 0; i < 8; ++i) rsv[i] = rsq[(size_t)(row0 + (i >> 2) * HALF + (i & 3) * 16) * 2 + 1];
#pragma unroll
        for (int ai = 0; ai < 2; ++ai)
#pragma unroll
            for (int m = 0; m < 4; ++m) { const int row = row0 + ai * HALF + m * 16; const float rs = __builtin_amdgcn_rsqf(rsv[ai * 4 + m] * (1.f / 256.f) + EPS);
#pragma unroll
                for (int bj = 0; bj < 2; ++bj) { const f32x4 v0 = acc[ai][bj][m][0] * rs, v1 = acc[ai][bj][m][1] * rs;
                    u32x4 w; w.x = cvt_pk_bf16(v0[0], v0[1]); w.y = cvt_pk_bf16(v0[2], v0[3]); w.z = cvt_pk_bf16(v1[0], v1[1]); w.w = cvt_pk_bf16(v1[2], v1[3]);
                    *(u32x4*)((bj ? VM : KN) + (size_t)row * 512 + u.pn * 128 + wc * 32 + 8 * fq) = w; }
                asm volatile("" ::: "memory"); }
    }
};
template <class Epi>
__device__ __forceinline__ void run(LAS unsigned char* lds, const Gemm g, int nM, int nN, int G, int c, const Epi& E, int tid, int nMs = 0, int ksplit = 1) {
    TileOrder S; S.init(nM, nN, G, c, g.K / BK, nMs, ksplit);
    gemm_phase<Epi, TileOrder, true>(lds, g, S, E, tid);
}
}


namespace att {
constexpr int SHM_V = 64 * 128 * 2;
#define SBAR() __builtin_amdgcn_sched_barrier(0)
__device__ __forceinline__ int crow(int r, int hi) { return (r & 3) + 8 * (r >> 2) + 4 * hi; }
__device__ __forceinline__ void partialSM(f32x16& p0, f32x16& p1, float& m_reg, float& mn, float& alpha, float C, float thr_raw) {
    float pmax = p0[0];
#pragma unroll
    for (int r = 1; r < 16; ++r) pmax = fmaxf(pmax, p0[r]);
#pragma unroll
    for (int r = 0; r < 16; ++r) pmax = fmaxf(pmax, p1[r]);
    { auto rr = __builtin_amdgcn_permlane32_swap(__float_as_uint(pmax), __float_as_uint(pmax), false, false); pmax = fmaxf(__uint_as_float(rr[0]), __uint_as_float(rr[1])); }
    if (__builtin_expect(__all(pmax - m_reg <= thr_raw), 1)) { mn = m_reg; alpha = 1.f; }
    else { mn = fmaxf(m_reg, pmax); alpha = __builtin_amdgcn_exp2f((m_reg - mn) * C); m_reg = mn; }
    const float mnC = -mn * C;
#pragma unroll
    for (int r = 0; r < 16; ++r) p0[r] = fmaf(p0[r], C, mnC);
#pragma unroll
    for (int r = 0; r < 16; ++r) p1[r] = fmaf(p1[r], C, mnC);
#pragma unroll
    for (int r = 0; r < 16; ++r) p0[r] = __builtin_amdgcn_exp2f(p0[r]);
}
__device__ __forceinline__ void finishSM(f32x16& p0, f32x16& p1, float alpha, float& l_reg, bf16x8& pa0, bf16x8& pa1, bf16x8& pa2, bf16x8& pa3) {
#pragma unroll
    for (int r = 0; r < 16; ++r) p1[r] = __builtin_amdgcn_exp2f(p1[r]);
    float ps = 0.f;
#pragma unroll
    for (int r = 0; r < 16; ++r) ps += p0[r];
#pragma unroll
    for (int r = 0; r < 16; ++r) ps += p1[r];
    { auto rr = __builtin_amdgcn_permlane32_swap(__float_as_uint(ps), __float_as_uint(ps), false, false); ps = __uint_as_float(rr[0]) + __uint_as_float(rr[1]); }
    l_reg = l_reg * alpha + ps;
#define PK4(P_, BASE, OUT) do { unsigned a0 = cvt_pk_bf16(P_[BASE + 0], P_[BASE + 1]), a1 = cvt_pk_bf16(P_[BASE + 2], P_[BASE + 3]);   \
    unsigned b0 = cvt_pk_bf16(P_[BASE + 4], P_[BASE + 5]), b1 = cvt_pk_bf16(P_[BASE + 6], P_[BASE + 7]);                              \
    auto r0 = __builtin_amdgcn_permlane32_swap(a0, b0, false, false); auto r1 = __builtin_amdgcn_permlane32_swap(a1, b1, false, false); \
    u32x4 w = {r0[0], r1[0], r0[1], r1[1]}; OUT = *reinterpret_cast<bf16x8*>(&w); } while (0)
    PK4(p0, 0, pa0); PK4(p0, 8, pa1); PK4(p1, 0, pa2); PK4(p1, 8, pa3);
#undef PK4
}
template <int NDQ> __device__ __forceinline__ int kaddr(int row, int cb) { return row * (32 * NDQ) + (cb ^ (((row >> 1) & 7) << 4)); }
template <int NDQ, int NQR>
__device__ __forceinline__ void qkt(f32x16& p0, f32x16& p1, const char* Ks, const bf16x8* qr, const char* ql, int r32, int hi) {
    p0 = f32x16{}; p1 = f32x16{};
#pragma unroll
    for (int d0 = 0; d0 < NDQ; ++d0) { const int cb = d0 * 32 + hi * 16;
        const bf16x8 b0 = *reinterpret_cast<const bf16x8*>(Ks + kaddr<NDQ>(r32, cb));
        const bf16x8 b1 = *reinterpret_cast<const bf16x8*>(Ks + kaddr<NDQ>(32 + r32, cb));
        bf16x8 q; if (d0 < NQR) q = qr[d0]; else q = *reinterpret_cast<const bf16x8*>(ql + (d0 - NQR) * 1024);
        p0 = __builtin_amdgcn_mfma_f32_32x32x16_bf16(b0, q, p0, 0, 0, 0);
        p1 = __builtin_amdgcn_mfma_f32_32x32x16_bf16(b1, q, p1, 0, 0, 0); }
}
__device__ __forceinline__ int v_st(int k, int c) { const int kk = (k & ~0xC) | ((k & 4) << 1) | ((k & 8) >> 1); return ((kk >> 3) * 4 + (c >> 5)) * 512 + ((kk & 7) * 32 + (c & 31)) * 2; }
__device__ __forceinline__ int v_rd_base(int lane) { return ((lane & 3) << 3) | (((lane >> 2) & 3) << 6) | (((lane >> 4) & 1) << 5) | (((lane >> 5) & 1) << 8); }
constexpr int v_rd_off(int d0, int ks, int half) { return d0 * 512 + ks * 4096 + half * 2048; }
template <int OFF> __device__ __forceinline__ s16x4 tr_read(int vb) { s16x4 r; asm volatile("ds_read_b64_tr_b16 %0, %1 offset:%2" : "=&v"(r) : "v"(vb), "i"(OFF) : "memory"); return r; }
template <int D0> __device__ __forceinline__ void pv_one(f32x16& od, int vb, bf16x8 pa0, bf16x8 pa1, bf16x8 pa2, bf16x8 pa3) {
    const s16x4 l0 = tr_read<v_rd_off(D0, 0, 0)>(vb), h0 = tr_read<v_rd_off(D0, 0, 1)>(vb), l1 = tr_read<v_rd_off(D0, 1, 0)>(vb), h1 = tr_read<v_rd_off(D0, 1, 1)>(vb);
    const s16x4 l2 = tr_read<v_rd_off(D0, 2, 0)>(vb), h2 = tr_read<v_rd_off(D0, 2, 1)>(vb), l3 = tr_read<v_rd_off(D0, 3, 0)>(vb), h3 = tr_read<v_rd_off(D0, 3, 1)>(vb);
    asm volatile("s_waitcnt lgkmcnt(0)" ::: "memory"); SBAR();
#define PKV(L_, H_) (bf16x8){L_[0], L_[1], L_[2], L_[3], H_[0], H_[1], H_[2], H_[3]}
    od = __builtin_amdgcn_mfma_f32_32x32x16_bf16(pa0, PKV(l0, h0), od, 0, 0, 0);
    od = __builtin_amdgcn_mfma_f32_32x32x16_bf16(pa1, PKV(l1, h1), od, 0, 0, 0);
    od = __builtin_amdgcn_mfma_f32_32x32x16_bf16(pa2, PKV(l2, h2), od, 0, 0, 0);
    od = __builtin_amdgcn_mfma_f32_32x32x16_bf16(pa3, PKV(l3, h3), od, 0, 0, 0);
#undef PKV
}
__device__ __forceinline__ void pv_d0(f32x16* o, int vb, bf16x8 pa0, bf16x8 pa1, bf16x8 pa2, bf16x8 pa3) {
    pv_one<0>(o[0], vb, pa0, pa1, pa2, pa3); pv_one<1>(o[1], vb, pa0, pa1, pa2, pa3); pv_one<2>(o[2], vb, pa0, pa1, pa2, pa3); pv_one<3>(o[3], vb, pa0, pa1, pa2, pa3);
}
template <int NDQ, int SD>
__device__ __forceinline__ void attn_body(const bf16_t* __restrict__ Qw, int ldq, const bf16_t* __restrict__ Kg, int ldk, const bf16_t* __restrict__ Krg, const bf16_t* __restrict__ Vg, int ldv,
                                          int xrow0, int nxt, int crow0, int NT, float C, char* lds, int tid, f32x16 (&o)[4], float (&rli)[16]) {
    constexpr int SHM_K = 64 * 32 * NDQ;
    const int wid = tid >> 6, lane = tid & 63, r32 = lane & 31, hi = lane >> 5;
    char* V_lds = lds; char* K_lds = lds + 2 * SHM_V;
    float* wsf = (float*)(lds + 2 * SHM_V + 2 * SHM_K) + wid * 64; float* li_l = wsf; float* al_l = wsf + 32;
    const float thr_raw = 8.f * 1.4426950408889634f / C;
    constexpr int NQR = (NDQ > 8) ? 6 : NDQ;
    char* ql = lds + 2 * SHM_V + 2 * SHM_K + 2048 + wid * ((NDQ - NQR) * 1024) + lane * 16;
    float m_reg = -1e30f, l_reg = 0.f; bf16x8 qr[NQR];
#pragma unroll
    for (int d0 = 0; d0 < 4; ++d0) o[d0] = f32x16{};
    const bf16_t* Ql = Qw + (size_t)r32 * ldq + hi * 8;
    __syncthreads();
#pragma unroll
    for (int d0 = 0; d0 < NDQ; ++d0) { const bf16x8 q = *reinterpret_cast<const bf16x8*>(Ql + d0 * 16); if (d0 < NQR) qr[d0] = q; else *reinterpret_cast<bf16x8*>(ql + (d0 - NQR) * 1024) = q; }
    const int sr = tid >> 4, sc = (tid & 15) * 8, vst0 = v_st(sr, sc), vst1 = v_st(32 + sr, sc);
    const int k8r = tid >> 3, k8c = (tid & 7) * 8;
    const int vb0 = (int)(uintptr_t)V_lds + v_rd_base(lane);
    bf16x8 vsA0, vsA1, ksA0, ksA1, ksA2, vsB0, vsB1, ksB0, ksB1, ksB2;
#define KROW(j) ((j) < nxt ? xrow0 + 64 * (j) : crow0 + 64 * ((j) - nxt))
#define SLOAD(S_, j) do { const int row0_ = KROW(j); \
        vs##S_##0 = *reinterpret_cast<const bf16x8*>(Vg + (size_t)(row0_ + sr) * ldv + sc); vs##S_##1 = *reinterpret_cast<const bf16x8*>(Vg + (size_t)(row0_ + 32 + sr) * ldv + sc); \
        if constexpr (NDQ == 4) { ks##S_##0 = *reinterpret_cast<const bf16x8*>(Kg + (size_t)(row0_ + k8r) * ldk + k8c); } \
        else { ks##S_##0 = *reinterpret_cast<const bf16x8*>(Kg + (size_t)(row0_ + sr) * ldk + sc); ks##S_##1 = *reinterpret_cast<const bf16x8*>(Kg + (size_t)(row0_ + 32 + sr) * ldk + sc); \
               ks##S_##2 = *reinterpret_cast<const bf16x8*>(Krg + (size_t)(row0_ + k8r) * 64 + k8c); } } while (0)
#define SWRITE(b, S_) do { *(bf16x8*)(V_lds + (b) * SHM_V + vst0) = vs##S_##0; *(bf16x8*)(V_lds + (b) * SHM_V + vst1) = vs##S_##1; \
        if constexpr (NDQ == 4) { *(bf16x8*)(K_lds + (b) * SHM_K + kaddr<NDQ>(k8r, k8c * 2)) = ks##S_##0; } \
        else { *(bf16x8*)(K_lds + (b) * SHM_K + kaddr<NDQ>(sr, sc * 2)) = ks##S_##0; *(bf16x8*)(K_lds + (b) * SHM_K + kaddr<NDQ>(32 + sr, sc * 2)) = ks##S_##1; \
               *(bf16x8*)(K_lds + (b) * SHM_K + kaddr<NDQ>(k8r, 256 + k8c * 2)) = ks##S_##2; } } while (0)
#define SLOAD_B(j) do { if constexpr (SD == 2) SLOAD(B, j); else SLOAD(A, j); } while (0)
#define SWRITE_B(b) do { if constexpr (SD == 2) SWRITE(b, B); else SWRITE(b, A); } while (0)
#define SWAIT() do { if constexpr (SD == 1) asm volatile("s_waitcnt vmcnt(0)" ::: "memory"); else if constexpr (NDQ == 4) asm volatile("s_waitcnt vmcnt(3)" ::: "memory"); else asm volatile("s_waitcnt vmcnt(5)" ::: "memory"); } while (0)
#define RESC(a) do { if (__any((a) < 1.f)) { if (hi == 0) al_l[r32] = (a); asm volatile("s_waitcnt lgkmcnt(0)" ::: "memory"); \
        _Pragma("unroll") for (int d = 0; d < 4; ++d) _Pragma("unroll") for (int r = 0; r < 16; ++r) o[d][r] *= al_l[crow(r, hi)]; } } while (0)
    f32x16 pA0, pA1, pB0, pB1; float mnA, mnB, alA, alB; bf16x8 pa0, pa1, pa2, pa3;
    SLOAD(A, 0); asm volatile("s_waitcnt vmcnt(0)" ::: "memory"); SWRITE(0, A); __syncthreads();
    qkt<NDQ, NQR>(pA0, pA1, K_lds, qr, ql, r32, hi); partialSM(pA0, pA1, m_reg, mnA, alA, C, thr_raw);
    SLOAD_B(1); if constexpr (SD == 2) { if (2 < NT) SLOAD(A, 2); }
    SWAIT(); SWRITE_B(1); __syncthreads();
    for (int j = 1; j + 1 < NT; j += 2) {
        SBAR(); qkt<NDQ, NQR>(pB0, pB1, K_lds + SHM_K, qr, ql, r32, hi);
        finishSM(pA0, pA1, alA, l_reg, pa0, pa1, pa2, pa3); SBAR();
        SLOAD_B(j + SD); SBAR();
        pv_d0(o, vb0, pa0, pa1, pa2, pa3); partialSM(pB0, pB1, m_reg, mnB, alB, C, thr_raw);
        __syncthreads(); SWAIT(); SWRITE(0, A);
        RESC(alB); __syncthreads();
        SBAR(); qkt<NDQ, NQR>(pA0, pA1, K_lds, qr, ql, r32, hi);
        finishSM(pB0, pB1, alB, l_reg, pa0, pa1, pa2, pa3); SBAR();
        if (SD == 1 || j + 3 < NT) SLOAD(A, j + 1 + SD); SBAR();
        pv_d0(o, vb0 + SHM_V, pa0, pa1, pa2, pa3); partialSM(pA0, pA1, m_reg, mnA, alA, C, thr_raw);
        __syncthreads(); SWAIT(); SWRITE_B(1);
        RESC(alA); __syncthreads();
    }
    SBAR(); qkt<NDQ, NQR>(pB0, pB1, K_lds + SHM_K, qr, ql, r32, hi);
    finishSM(pA0, pA1, alA, l_reg, pa0, pa1, pa2, pa3); SBAR();
    pv_d0(o, vb0, pa0, pa1, pa2, pa3); partialSM(pB0, pB1, m_reg, mnB, alB, C, thr_raw);
    __syncthreads(); RESC(alB);
    finishSM(pB0, pB1, alB, l_reg, pa0, pa1, pa2, pa3); SBAR();
    pv_d0(o, vb0 + SHM_V, pa0, pa1, pa2, pa3);
    if (hi == 0) li_l[r32] = l_reg; asm volatile("s_waitcnt lgkmcnt(0)" ::: "memory");
#pragma unroll
    for (int r = 0; r < 16; ++r) rli[r] = __builtin_amdgcn_rcpf(li_l[crow(r, hi)]);
#undef KROW
#undef SLOAD
#undef SWRITE
#undef SWAIT
#undef SLOAD_B
#undef SWRITE_B
#undef RESC
}
__device__ __forceinline__ void unit_diff(KP kp, unsigned char* ws, int l, int b, int h, int qrow0, int isc, char* lds, int tid, float* scratch) {
    const int wid = tid >> 6, lane = tid & 63, r32 = lane & 31, hi = lane >> 5;
    const bf16_t* Z = (const bf16_t*)(ws + WS_Z); bf16_t* MIX = (bf16_t*)(ws + WS_MIX);
    const int xrow0 = b * SEQ, nxt = isc ? 0 : SEQ / 64, crow0 = RX + b * CTX, NT = nxt + CTX / 64;
    const float C = 0.125f * 1.4426950408889634f;
    const float lam_init = (l == 0) ? 0.2f : 0.35550906759096907f;
    float* myscr = scratch + (size_t)wid * 64 * 64 + lane;
    f32x16 o[4]; float rli[16];
    attn_body<4, 2>(Z + (size_t)(qrow0 + wid * 32) * ZLD + Z_Q + h * 128, ZLD, Z + Z_K + h * 128, ZLD, nullptr, Z + Z_V + h * 128, ZLD, xrow0, nxt, crow0, NT, C, lds, tid, o, rli);
#pragma unroll
    for (int d0 = 0; d0 < 4; ++d0)
#pragma unroll
        for (int r = 0; r < 16; ++r) myscr[(d0 * 16 + r) * 64] = o[d0][r] * rli[r];
    attn_body<4, 2>(Z + (size_t)(qrow0 + wid * 32) * ZLD + Z_Q + h * 128 + 64, ZLD, Z + Z_K + h * 128 + 64, ZLD, nullptr, Z + Z_V + h * 128, ZLD, xrow0, nxt, crow0, NT, C, lds, tid, o, rli);
    size_t so = 0; asm volatile("" : "+v"(so) :: "memory"); const float* rdscr = myscr + so;
    const float* lamp = kp->in[IN_DIFFLAM] + l * 256;
    float l1 = lamp[lane] * lamp[64 + lane], l2 = lamp[128 + lane] * lamp[192 + lane]; l1 = wsum(l1, lane); l2 = wsum(l2, lane);
    const float lam = expf(l1) - expf(l2) + lam_init;
    const float* subg = kp->in[IN_SUBLN] + l * 128; const float post = 1.f - lam_init;
    float sg[4];
#pragma unroll
    for (int d0 = 0; d0 < 4; ++d0) sg[d0] = subg[d0 * 32 + r32] * post;
#pragma unroll
    for (int r = 0; r < 16; ++r) {
        float dv[4], ss = 0.f;
#pragma unroll
        for (int d0 = 0; d0 < 4; ++d0) { dv[d0] = rdscr[(d0 * 16 + r) * 64] - lam * (o[d0][r] * rli[r]); ss += dv[d0] * dv[d0]; }
        ss += sx(ss, 1, lane); ss += sx(ss, 2, lane); ss += sx(ss, 4, lane); ss += sx(ss, 8, lane); ss += sx(ss, 16, lane);
        const float rs = 1.0f / sqrtf(ss * (1.f / 128.f) + EPS);
        bf16_t* mp = MIX + (size_t)(qrow0 + wid * 32 + crow(r, hi)) * D + 512 + h * 128 + r32;
#pragma unroll
        for (int d0 = 0; d0 < 4; ++d0) mp[d0 * 32] = f2bf(dv[d0] * rs * sg[d0]);
    }
}
__device__ __forceinline__ void unit_mla(unsigned char* ws, int b, int h, int qrow0, int isc, char* lds, int tid) {
    const int wid = tid >> 6, lane = tid & 63, r32 = lane & 31, hi = lane >> 5;
    const bf16_t* QM = (const bf16_t*)(ws + WS_QM); const bf16_t* KN = (const bf16_t*)(ws + WS_KN); const bf16_t* KR = (const bf16_t*)(ws + WS_KR); const bf16_t* VM = (const bf16_t*)(ws + WS_VM);
    bf16_t* MIX = (bf16_t*)(ws + WS_MIX);
    const int xrow0 = b * SEQ, nxt = isc ? 0 : SEQ / 64, crow0 = RX + b * CTX, NT = nxt + CTX / 64;
    const float C = 0.07216878364870322f * 1.4426950408889634f;
    f32x16 o[4]; float rli[16];
    attn_body<12, 1>(QM + (size_t)(qrow0 + wid * 32) * 768 + h * 192, 768, KN + h * 128, 512, KR, VM + h * 128, 512, xrow0, nxt, crow0, NT, C, lds, tid, o, rli);
#pragma unroll
    for (int r = 0; r < 16; ++r) { bf16_t* mp = MIX + (size_t)(qrow0 + wid * 32 + crow(r, hi)) * D + 1024 + h * 128 + r32;
#pragma unroll
        for (int d0 = 0; d0 < 4; ++d0) mp[d0 * 32] = f2bf(o[d0][r] * rli[r]); }
}
__device__ __forceinline__ void phase_attn(KP kp, unsigned char* ws, int tid, int l, char* lds, int vcu, int G, int bx) {
    const int nunits = (l == 0) ? 288 : 256;
    float* scratch = (float*)(ws + WS_O1) + (size_t)bx * (8 * 64 * 64);
    for (int k = 0; k * G < nunits; ++k) {
        const int u = k * G + ((vcu + k * 128) % G); if (u >= nunits) continue;
        int tidu = tid; asm volatile("" : "+v"(tidu));
        size_t wo = 0; asm volatile("" : "+s"(wo)); unsigned char* wsu = kp->ws + wo; int lu = l; asm volatile("" : "+s"(lu));
        const bool isc = (u >= 256); const int v = isc ? (u - 256) & 15 : (u & 127);
        const bool mla = isc ? (u >= 272) : (u >= 128);
        const int b = isc ? (v >> 2) : (v >> 5), h = isc ? (v & 3) : ((v >> 3) & 3), q0 = isc ? RX + b * CTX : b * SEQ + (v & 7) * 256;
        if (!mla) unit_diff(kp, wsu, lu, b, h, q0, isc ? 1 : 0, lds, tidu, scratch);
        else unit_mla(wsu, b, h, q0, isc ? 1 : 0, lds, tidu);
    }
}
#undef SBAR
}


#define XB_TMO      128
#define XB_XCNT(j)  (256  + 64 * (j))
#define XB_XSUB(j)  (1280 + 64 * (j))
#define XB_XGEN(j)  (2304 + 64 * (j))
#define XB_TOP      3328
#define XB_TOPGEN   3392
#define XCD_BAR_WORDS 3456
#define XB_SPIN_CAP (1u << 18)
__device__ __forceinline__ unsigned xb_ld(unsigned* p)              { return __hip_atomic_load(p, __ATOMIC_RELAXED, __HIP_MEMORY_SCOPE_AGENT); }
__device__ __forceinline__ unsigned xb_add(unsigned* p, unsigned v) { return __hip_atomic_fetch_add(p, v, __ATOMIC_RELAXED, __HIP_MEMORY_SCOPE_AGENT); }
__device__ __forceinline__ unsigned xb_xcc_id() { return (unsigned)__builtin_amdgcn_s_getreg((3 << 11) | 20) & 0xFu; }
#define XB_SPIN(cond, bar) do { unsigned _sp = 0; while (cond) { __builtin_amdgcn_s_sleep(1); \
    if ((++_sp & 255u) == 0u) { if (xb_ld(&(bar)[XB_TMO])) break; if (_sp > XB_SPIN_CAP) { atomicAdd(&(bar)[XB_TMO], 1u); break; } } } } while (0)
__device__ __forceinline__ void xcd_barrier_complete(unsigned* bar, unsigned x, unsigned G, unsigned& nloc, unsigned& nx) {
    unsigned sum, cnt, mine, sp = 0u;
    for (;;) {
        sum = 0u; cnt = 0u; mine = 0u;
#pragma unroll
        for (unsigned j = 0; j < 16; ++j) { const unsigned c = xb_ld(&bar[XB_XCNT(j)]); sum += c; cnt += (c > 0u) ? 1u : 0u; mine = (j == x) ? c : mine; }
        if (sum == G) break;
        __builtin_amdgcn_s_sleep(1);
        if ((++sp & 255u) == 0u) { if (xb_ld(&bar[XB_TMO])) break; if (sp > XB_SPIN_CAP) { atomicAdd(&bar[XB_TMO], 1u); break; } }
    }
    nloc = mine > 0u ? mine : 1u; nx = cnt > 0u ? cnt : 1u;
}
__device__ __forceinline__ void xcd_barrier(unsigned* bar, volatile LAS unsigned* st, int tid, unsigned G) {
    asm volatile("s_waitcnt vmcnt(0)" ::: "memory");
    __syncthreads();
    if (tid == 0) {
        const unsigned x = xb_xcc_id();
        __builtin_amdgcn_s_waitcnt(0);
        unsigned nloc = st[0], nx = st[1];
        if (nloc == 0u) { xcd_barrier_complete(bar, x, G, nloc, nx); st[0] = nloc; st[1] = nx; }
        const unsigned qv = xb_ld((unsigned*)((char*)bar + (WS_CVQ - WS_BAR)));
        const unsigned old = xb_add(&bar[XB_XSUB(x)], 1u);
        const unsigned gen = old / nloc;
        if (old + 1u == (gen + 1u) * nloc) {
            __builtin_amdgcn_fence(__ATOMIC_RELEASE, "agent");
            asm volatile("s_waitcnt vmcnt(0)" ::: "memory");
            const unsigned og = xb_add(&bar[XB_TOP], 1u);
            const unsigned tg = og / nx;
            if (og + 1u == (tg + 1u) * nx) xb_add(&bar[XB_TOPGEN], 1u);
            else XB_SPIN(xb_ld(&bar[XB_TOPGEN]) == tg, bar);
            __builtin_amdgcn_fence(__ATOMIC_ACQUIRE, "agent");
            xb_add(&bar[XB_XGEN(x)], 1u);
            asm volatile("s_waitcnt vmcnt(0)" ::: "memory");
        } else {
            XB_SPIN(xb_ld(&bar[XB_XGEN(x)]) == gen, bar);
            __builtin_amdgcn_fence(__ATOMIC_ACQUIRE, "agent");
            asm volatile("s_waitcnt vmcnt(0)" ::: "memory");
        }
        if (qv > st[6]) st[6] = qv;
    }
    __syncthreads();
}

#ifdef PROBE_A
#define PH_STAMP(ph) do { if (bx0 == 0 && tid_ == 0) ((unsigned long long*)(ws + 32768))[ph] = __builtin_amdgcn_s_memrealtime(); } while (0)
#else
#define PH_STAMP(ph) do { } while (0)
#endif
#define PH_VARS(ph) \
    KP kp = kp0; asm volatile("" : "+s"(kp)); \
    int wv_ = wave0; asm volatile("" : "+s"(wv_)); unsigned z_ = 0u; asm volatile("" : "+s"(z_)); int tid_ = wv_ * 64 + (int)__builtin_amdgcn_mbcnt_hi(~0u, __builtin_amdgcn_mbcnt_lo(~0u, z_)); asm volatile("" : "+v"(tid_)); \
    size_t wsoff = 0; asm volatile("" : "+s"(wsoff)); unsigned char* ws = kp->ws + wsoff; \
    int G = G0, bx = bx0, vcu = vcu0; asm volatile("" : "+s"(G), "+s"(bx), "+s"(vcu)); \
    (void)bx; (void)vcu; (void)G;
#define XSYNC(ph) PH_VARS(ph) xcd_barrier((unsigned*)(ws + WS_BAR), (volatile LAS unsigned*)(lds + MISC_OFF), tid_, (unsigned)G); PH_STAMP(ph);
#define CSYNC(ph) cg::this_grid().sync(); PH_VARS(ph) PH_STAMP(ph);

template <int l>
__device__ __forceinline__ void layer_phases(KP kp0, LAS unsigned char* lds, char* lds_gen, int G0, int bx0, int vcu0, int wave0) {
    constexpr int pb = PH_L0 + l * PH_PER_LAYER;
    constexpr int nrM = (l == 1 ? RX : R) / 256;
    { XSYNC(pb + PHL_WIN)
      pg8::run(lds, pg8::Gemm{(const bf16_t*)(ws + WS_H), (const bf16_t*)(ws + WS_WIN) + (size_t)l * ZLD * D, D, D, D}, R / 256, ZLD / 256, G, bx, pg8::EpiZ{(bf16_t*)(ws + WS_Z), (float*)(ws + WS_RSQ) + (size_t)l * R * 2}, tid_);
#ifdef PROBE_G
      if (PROBE_G == pb + PHL_WIN && bx0 == 0 && tid_ == 0) { ((unsigned long long*)(ws + 32768))[28] = 0ull; ((unsigned long long*)(ws + 32768))[29] = *(volatile LAS unsigned long long*)(lds + MISC_OFF + 32); }
#endif

      if (bx >= (R / 256) * (ZLD / 256) - 2 * G) conv_fill(kp, ws, lds, tid_, 3); }
    { XSYNC(pb + PHL_PRE)
      { const float* rsq = (const float*)(ws + WS_RSQ) + (size_t)l * R * 2;
        pg8::run(lds, pg8::Gemm{(const bf16_t*)(ws + WS_Z) + Z_CQ, (const bf16_t*)(ws + WS_WUQ) + (size_t)l * 768 * 384, ZLD, 384, 384}, R / 256, 3, G, bx, pg8::EpiQ{(bf16_t*)(ws + WS_QM), rsq, (const float2*)(ws + WS_CS)}, tid_); }
      { int tid2 = tid_; asm volatile("" : "+v"(tid2)); size_t wsoff2 = 0; asm volatile("" : "+s"(wsoff2)); unsigned char* ws2 = kp->ws + wsoff2;
        pg8::run(lds, pg8::Gemm{(const bf16_t*)(ws2 + WS_Z) + Z_CKV, (const bf16_t*)(ws2 + WS_WUKV) + (size_t)l * 1024 * 256, ZLD, 256, 256}, R / 256, 4, G, (bx + G - 108) % G, pg8::EpiKV{(bf16_t*)(ws2 + WS_KN), (bf16_t*)(ws2 + WS_VM), (const float*)(ws2 + WS_RSQ) + (size_t)l * R * 2}, tid2); }
#ifdef PROBE_G
      if (PROBE_G == pb + PHL_PRE && bx0 == 0 && tid_ == 0) { ((unsigned long long*)(ws + 32768))[28] = 0ull; ((unsigned long long*)(ws + 32768))[29] = *(volatile LAS unsigned long long*)(lds + MISC_OFF + 32); }
#endif
#ifdef PROBE_A
      if (l == 0) { __syncthreads(); if (bx0 == 0 && tid_ == 0) { ((unsigned long long*)(ws + 32768))[24] = ((unsigned long long*)(ws + 32768))[pb + PHL_PRE]; ((unsigned long long*)(ws + 32768))[25] = __builtin_amdgcn_s_memrealtime(); } }
#endif
      if (G == 256) { if (bx >= 108) pre_rope(kp, ws, tid_, bx - 108, G - 108); }
      else pre_rope(kp, ws, tid_, vcu, G);
#ifdef PROBE_A
      if (l == 0) { __syncthreads(); if (bx0 == 0 && tid_ == 0) ((unsigned long long*)(ws + 32768))[26] = __builtin_amdgcn_s_memrealtime(); }
#endif
      if (G != 256) pre_pool(kp, ws, tid_, l, vcu, G);
#ifdef PROBE_A
      if (l == 0) { __syncthreads(); if (bx0 == 0 && tid_ == 0) ((unsigned long long*)(ws + 32768))[27] = __builtin_amdgcn_s_memrealtime(); }
#endif
      if (G != 256) pre_conv(kp, ws, tid_, l, vcu, G);
#ifdef PROBE_PRE
      if (l == 0) { __syncthreads(); if (tid_ == 0) ((unsigned long long*)(ws + 32768))[128 + bx0] = __builtin_amdgcn_s_memrealtime(); }
#endif
    }
    { XSYNC(pb + PHL_ATTN)
      att::phase_attn(kp, ws, tid_, l, lds_gen, vcu, G, bx);
      constexpr int em0 = (l == 0) ? 160 : 128;
      if (G == 256 && vcu >= em0) {
        int tid3 = tid_; asm volatile("" : "+v"(tid3)); size_t wsoff3 = 0; asm volatile("" : "+s"(wsoff3)); unsigned char* ws3 = kp->ws + wsoff3;
        pre_pool(kp, ws3, tid3, l, vcu - em0, 256 - em0); pre_conv(kp, ws3, tid3, l, vcu - em0, 256 - em0); }
#ifdef PROBE_ATT
      if (l == PROBE_ATT - 1) { __syncthreads(); if (tid_ == 0) ((unsigned long long*)(ws + 32768))[128 + vcu0] = __builtin_amdgcn_s_memrealtime(); }
#endif
      if (G != 256 || (vcu >= 128 && (l == 1 || vcu < 160))) conv_drain(kp, ws, lds, tid_, l == 0 ? CV_E1 : CV_E5); }
    { XSYNC(pb + PHL_WOUT)
      pg8::run(lds, pg8::Gemm{(const bf16_t*)(ws + WS_MIX), (const bf16_t*)(ws + WS_WOUT) + (size_t)l * D * D, D, D, D}, RX / 256, D / 256, G, bx, pg8::EpiY{(bf16_t*)(ws + WS_Y), (float*)(ws + WS_YP), RX / 256, (size_t)RC * D}, tid_, l == 0 ? RC / 256 : 0, 4); }
    { XSYNC(pb + PHL_ROWB)
      phase_rowpass(kp, ws, lds, tid_, 1, l, vcu, G);
      conv_drain(kp, ws, lds, tid_, l == 0 ? CV_E2 : CV_E6); }
    { XSYNC(pb + PHL_UP)
      pg8::run(lds, pg8::Gemm{(const bf16_t*)(ws + WS_H), (const bf16_t*)(ws + WS_WUP) + (size_t)l * UFF * D, D, D, D}, nrM, UFF / 256, G, bx, pg8::EpiAct{(bf16_t*)(ws + WS_ACT), (bf16_t*)(ws + WS_EDGE), kp->in[IN_FFNCONVW] + (size_t)l * 3 * UFF, (LAS float*)(lds + pg8::STAGE_BYTES)
                  }, tid_);
#ifdef PROBE_G
      if (PROBE_G == pb + PHL_UP && bx0 == 0 && tid_ == 0) { ((unsigned long long*)(ws + 32768))[28] = 0ull; ((unsigned long long*)(ws + 32768))[29] = *(volatile LAS unsigned long long*)(lds + MISC_OFF + 32); }
#endif

      if (bx >= (nrM * (UFF / 256)) % G) conv_fill(kp, ws, lds, tid_, 2); }
    { XSYNC(pb + PHL_ACT)
      phase_act_edges(kp, ws, tid_, l, vcu, G);
      conv_drain(kp, ws, lds, tid_, l == 0 ? CV_E3 : CV_E7); }
    { XSYNC(pb + PHL_DOWN)
      pg8::run(lds, pg8::Gemm{(const bf16_t*)(ws + WS_ACT), (const bf16_t*)(ws + WS_WDOWN) + (size_t)l * D * DFF, DFF, DFF, DFF}, RX / 256, D / 256, G, bx, pg8::EpiY{(bf16_t*)(ws + WS_Y), (float*)(ws + WS_YP), RX / 256, (size_t)RC * D}, tid_, l == 0 ? RC / 256 : 0, 4);
#ifdef PROBE_G
      if (PROBE_G == pb + PHL_DOWN && bx0 == 0 && tid_ == 0) { ((unsigned long long*)(ws + 32768))[28] = 0ull; ((unsigned long long*)(ws + 32768))[29] = *(volatile LAS unsigned long long*)(lds + MISC_OFF + 32); }
#endif
 }
    { XSYNC(pb + PHL_ROWC)
      phase_rowpass(kp, ws, lds, tid_, 2, l, vcu, G);
      if (l == 0) conv_drain(kp, ws, lds, tid_, CV_E4); }
}

__global__ void __launch_bounds__(NTHR, 2) mk_fwd(Params P) {
    extern __shared__ __attribute__((aligned(16))) unsigned char lds_raw[];
    LAS unsigned char* lds = (LAS unsigned char*)lds_raw;
    KP kp0 = (KP)__builtin_amdgcn_kernarg_segment_ptr();
    const int G0 = gridDim.x, bx0 = blockIdx.x;
    const int wave0 = __builtin_amdgcn_readfirstlane((int)__builtin_amdgcn_workitem_id_x() >> 6);
    const int vcu0 = (G0 % 8 == 0) ? (bx0 % 8) * (G0 / 8) + bx0 / 8 : bx0;
    if (kp0->pad == 0x7fffffff) cg::this_grid().sync();
    { PH_VARS(PH_PRO) PH_STAMP(PH_PRO);
      if (tid_ < 2) ((volatile LAS unsigned*)(lds + MISC_OFF))[tid_] = 0u;
      if (tid_ == 2) ((volatile LAS unsigned*)(lds + MISC_OFF))[6] = 0u;
      if (tid_ == 0) (void)xb_add((unsigned*)(ws + WS_BAR) + XB_XCNT(xb_xcc_id()), 1u);
      __syncthreads();
      phase_prologue(kp, ws, tid_, lds, vcu, G); }
    { XSYNC(PH_ROWA)
      phase_rowpass(kp, ws, lds, tid_, 0, 0, vcu, G); }
    layer_phases<0>(kp0, lds, (char*)lds_raw, G0, bx0, vcu0, wave0);
    layer_phases<1>(kp0, lds, (char*)lds_raw, G0, bx0, vcu0, wave0);
#ifdef PROBE_ACT
    { XSYNC(PH_TOTAL)
      phase_act(kp, ws, tid_, 1, vcu, G, WS_END); }
    { XSYNC(PH_TOTAL)
      const bf16_t* A1 = (const bf16_t*)(ws + WS_ACT); const bf16_t* A2 = (const bf16_t*)(ws + WS_END); float mx = 0.f;
      for (size_t i = (size_t)vcu * NTHR + tid_; i < (size_t)RX * DFF / 8; i += (size_t)G * NTHR) { float a[8], b[8]; unpack8(ld16(A1 + i * 8), a); unpack8(ld16(A2 + i * 8), b);
#pragma unroll
          for (int e = 0; e < 8; ++e) mx = fmaxf(mx, fabsf(a[e] - b[e])); }
      atomicMax((unsigned*)(ws + 40960), __float_as_uint(mx)); }
    { XSYNC(PH_TOTAL)
      if (bx0 == 0 && tid_ == 0) kp->out[0] += 0.3f + __uint_as_float(*(volatile unsigned*)(ws + 40960)); }
#endif
#ifdef PROBE_A
#ifdef PROBE_SYNC
    { XSYNC(PH_TOTAL)
      unsigned long long t0 = __builtin_amdgcn_s_memrealtime();
      for (int i = 0; i < 10; ++i) xcd_barrier((unsigned*)(ws + WS_BAR), (volatile LAS unsigned*)(lds + MISC_OFF), tid_, (unsigned)G);
      unsigned long long t1 = __builtin_amdgcn_s_memrealtime();
      if (bx0 == 0 && tid_ == 0) kp->out[0] += 0.3f + (float)(t1 - t0) * (0.01f / 800.f); }
#else
    { XSYNC(PH_TOTAL)
      if (bx0 == 0) {
        unsigned long long* ts = (unsigned long long*)(ws + 32768);
        __syncthreads();
#ifdef PROBE_ATT
        unsigned long long mq = 0, mk = 0; const unsigned long long t0_ = ts[PH_L0 + (PROBE_ATT - 1) * PH_PER_LAYER + PHL_ATTN];
        for (int i = 0; i < 128; ++i) { const unsigned long long d = ts[128 + i] - t0_; mq = d > mq ? d : mq; } for (int i = 128; i < 256; ++i) { const unsigned long long d = ts[128 + i] - t0_; mk = d > mk ? d : mk; }
        const float ta = (float)mq * (0.01f / 800.f), tb = (float)mk * (0.01f / 800.f);
#elif defined(PROBE_PRE)
        unsigned long long mq = 0, mk = 0; for (int i = 0; i < 108; ++i) { const unsigned long long d = ts[128 + i] - ts[3]; mq = d > mq ? d : mq; } for (int i = 108; i < 256; ++i) { const unsigned long long d = ts[128 + i] - ts[3]; mk = d > mk ? d : mk; }
        const float ta = (float)mq * (0.01f / 800.f), tb = (float)mk * (0.01f / 800.f);
#else
        const float ta = (float)(ts[PROBE_A + 1] - ts[PROBE_A]) * (0.01f / 800.f), tb = (float)(ts[PROBE_B + 1] - ts[PROBE_B]) * (0.01f / 800.f);
#endif
        if (tid_ == 0) kp->out[0] += 0.3f + ta;
        for (int i = 1 + tid_; i <= 65536; i += NTHR) kp->out[i] += tb;
      } }
#endif
#endif
}

extern "C" void kernel_launch(void* const* d_in, const int* in_sizes, int n_in, void* d_out, int out_size, void* d_ws, size_t ws_size, hipStream_t stream) {
    static int grid = 0;
    if (grid == 0) {
        if (n_in != 24 || ws_size < WS_END) { fprintf(stderr, "kernel_launch: bad args n_in %d ws %zu (need %zu)\n", n_in, ws_size, (size_t)WS_END); grid = -1; return; }
        if (hipFuncSetAttribute((const void*)mk_fwd, hipFuncAttributeMaxDynamicSharedMemorySize, LDS_BYTES) != hipSuccess) { fprintf(stderr, "hipFuncSetAttribute failed\n"); grid = -1; return; }
        int dev = 0, cus = 0, per_cu = 0;
        if (hipGetDevice(&dev) != hipSuccess || hipDeviceGetAttribute(&cus, hipDeviceAttributeMultiprocessorCount, dev) != hipSuccess) { grid = -1; return; }
        if (hipOccupancyMaxActiveBlocksPerMultiprocessor(&per_cu, (const void*)mk_fwd, NTHR, LDS_BYTES) != hipSuccess || per_cu < 1) { fprintf(stderr, "occupancy query failed (%d)\n", per_cu); grid = -1; return; }
        grid = cus * per_cu;
    }
    if (grid < 0) return;
    unsigned char* ws = (unsigned char*)d_ws;
    (void)hipMemsetAsync(ws + WS_CTL, 0, 256 * 1024, stream);
    Params P{};
    for (int i = 0; i < 24; ++i) P.in[i] = (const float*)d_in[i];
    P.out = (float*)d_out; P.ws = ws; P.ph_lo = 0; P.ph_hi = PH_TOTAL; P.mask = 15; P.pad = 0;
    void* args[] = {&P};
    const hipError_t e = hipLaunchCooperativeKernel((const void*)mk_fwd, dim3(grid), dim3(NTHR), args, LDS_BYTES, stream);
    if (e != hipSuccess) fprintf(stderr, "cooperative launch failed: %s (grid %d)\n", hipGetErrorString(e), grid);
}
```

```cpp
#include <hip/hip_runtime.h>
#include <hip/hip_cooperative_groups.h>
#include <cstdint>
#include <cstdio>
#include <cmath>
namespace cg = cooperative_groups;

#define LAS __attribute__((address_space(3)))
typedef unsigned short bf16_t;
typedef short bf16x8 __attribute__((ext_vector_type(8)));
typedef short s16x4 __attribute__((ext_vector_type(4)));
typedef float f32x4 __attribute__((ext_vector_type(4)));
typedef float f32x2 __attribute__((ext_vector_type(2)));
typedef float f32x16 __attribute__((ext_vector_type(16)));
typedef unsigned u32x4 __attribute__((ext_vector_type(4)));
typedef unsigned u32x2 __attribute__((ext_vector_type(2)));

constexpr int D = 2048, NB = 4, SEQ = 2048, CTX = 256, GRIDW = 64;
constexpr int RX = NB * SEQ, RC = NB * CTX, R = RX + RC;
constexpr int INC = 4288, ZLD = 4352, DFF = 5632, UFF = 2 * DFF, MODW = 6 * D;
constexpr float EPS = 1e-6f;
constexpr int Z_POOL = 0, Z_Q = 512, Z_K = 1024, Z_V = 1536, Z_CQ = 2048, Z_CKV = 2432, Z_KR = 2688, Z_GB = 2752, Z_GC = 3264, Z_H = 3776;
constexpr int NWAVES = 8, NTHR = 512;
constexpr int LDS_BYTES = 147456, MISC_OFF = LDS_BYTES - 64;

constexpr size_t MiB = 1u << 20;
constexpr size_t WS_CTL = 0, CTL_BYTES = 1 * MiB;
constexpr size_t WS_BAR = 0;
constexpr size_t WS_CVQ = 48 * 1024;
constexpr size_t WS_RSQ = 64 * 1024;
constexpr size_t WS_MOD = 1 * MiB;
constexpr size_t WS_CS = 2 * MiB;
constexpr size_t WS_POOLW = 3 * MiB;
constexpr size_t WS_WUQ = 4 * MiB;
constexpr size_t WS_WUKV = 6 * MiB;
constexpr size_t WS_WIN = 8 * MiB;
constexpr size_t WS_WOUT = 42 * MiB;
constexpr size_t WS_WUP = 58 * MiB;
constexpr size_t WS_WDOWN = 146 * MiB;
constexpr size_t WS_XR = 190 * MiB;
constexpr size_t WS_H = 262 * MiB;
constexpr size_t WS_BIG = 298 * MiB;
constexpr size_t WS_Z = WS_BIG;
constexpr size_t WS_QM = WS_BIG + 77 * MiB;
constexpr size_t WS_KN = WS_BIG + 91 * MiB;
constexpr size_t WS_VM = WS_BIG + 100 * MiB;
constexpr size_t WS_KR = WS_BIG + 109 * MiB;
constexpr size_t WS_MIX = WS_BIG + 111 * MiB;
constexpr size_t WS_Y = WS_BIG + 147 * MiB;
constexpr size_t WS_U = WS_BIG;
constexpr size_t WS_ACT = WS_BIG + 219 * MiB;
constexpr size_t WS_O1 = WS_ACT + 99 * MiB;
constexpr size_t WS_YP = WS_O1 + 32 * MiB;
constexpr size_t WS_EDGE = WS_YP + 24 * MiB;
constexpr size_t WS_END = WS_EDGE + 4 * MiB;
static_assert(WS_U + (size_t)R * UFF * 2 <= WS_ACT, "U overlay");
static_assert(WS_RSQ + (size_t)2 * R * 2 * 4 <= 256 * 1024, "control words inside the per-call memset");

struct Params {
    const float* in[24];
    float* out;
    unsigned char* ws;
    int ph_lo, ph_hi;
    int mask, pad;
};
typedef const __attribute__((address_space(4))) Params* KP;
enum { IN_X = 0, IN_C, IN_CTX, IN_CCTX, IN_ADAW, IN_ADAB, IN_GPREMIX, IN_GPOSTMIX, IN_GPREFFN, IN_GPOSTFFN, IN_WIN, IN_POOLW, IN_POOLSCALE, IN_DIFFLAM, IN_SUBLN,
       IN_GQ, IN_WUQ, IN_GKV, IN_WUKV, IN_CONVW, IN_WOUT, IN_WUP, IN_FFNCONVW, IN_WDOWN };
enum { PH_PRO = 0, PH_ROWA = 1, PH_L0 = 2, PHL_WIN = 0, PHL_PRE = 1, PHL_ATTN = 2, PHL_WOUT = 3, PHL_ROWB = 4, PHL_UP = 5, PHL_ACT = 6, PHL_DOWN = 7, PHL_ROWC = 8, PH_PER_LAYER = 9, PH_TOTAL = 2 + 2 * 9 };

__device__ __forceinline__ void rowinfo(int r, int& b, int& t, int& L, int& isc) {
    if (r < RX) { b = r / SEQ; t = r % SEQ; L = SEQ; isc = 0; } else { const int rc = r - RX; b = rc / CTX; t = rc % CTX; L = CTX; isc = 1; }
}
__device__ __forceinline__ float wave_sum(float v) {
#pragma unroll
    for (int o = 1; o < 64; o <<= 1) v += __shfl_xor(v, o);
    return v;
}
__device__ __forceinline__ float wave_max(float v) {
#pragma unroll
    for (int o = 1; o < 64; o <<= 1) v = fmaxf(v, __shfl_xor(v, o));
    return v;
}
__device__ __forceinline__ float sx(float v, int o, int lane) { return __int_as_float(__builtin_amdgcn_ds_bpermute((lane ^ o) << 2, __float_as_int(v))); }
__device__ __forceinline__ float wsum(float v, int lane) {
#pragma unroll
    for (int o = 1; o < 64; o <<= 1) v += sx(v, o, lane);
    return v;
}
typedef __bf16 bf16x2_t __attribute__((ext_vector_type(2)));
__device__ __forceinline__ unsigned cvt_pk_bf16(float lo, float hi) { const f32x2 v = {lo, hi}; const bf16x2_t b = __builtin_convertvector(v, bf16x2_t); return __builtin_bit_cast(unsigned, b); }
__device__ __forceinline__ bf16_t f2bf(float f) { return (bf16_t)(cvt_pk_bf16(f, 0.f) & 0xffffu); }
__device__ __forceinline__ float bf2f(bf16_t h) { return __uint_as_float(((unsigned)h) << 16); }
__device__ __forceinline__ void unpack8(const u32x4 w, float* f) {
    f[0] = __uint_as_float(w.x << 16); f[1] = __uint_as_float(w.x & 0xffff0000u); f[2] = __uint_as_float(w.y << 16); f[3] = __uint_as_float(w.y & 0xffff0000u);
    f[4] = __uint_as_float(w.z << 16); f[5] = __uint_as_float(w.z & 0xffff0000u); f[6] = __uint_as_float(w.w << 16); f[7] = __uint_as_float(w.w & 0xffff0000u);
}
__device__ __forceinline__ u32x4 pack8(const float* f) { u32x4 w; w.x = cvt_pk_bf16(f[0], f[1]); w.y = cvt_pk_bf16(f[2], f[3]); w.z = cvt_pk_bf16(f[4], f[5]); w.w = cvt_pk_bf16(f[6], f[7]); return w; }
__device__ __forceinline__ u32x4 ld16(const bf16_t* p) { return *(const u32x4*)p; }
__device__ __forceinline__ void st16(bf16_t* p, u32x4 v) { *(u32x4*)p = v; }

__host__ __device__ __forceinline__ int uq_pos(int n) { const int h = n / 192, j = n % 192; if (j < 128) return (h >> 1) * 256 + (h & 1) * 128 + j; const int jj = j - 128; return jj < 32 ? 512 + h * 32 + jj : 640 + h * 32 + (jj - 32); }

__host__ __device__ __forceinline__ int up_pos(int n) { const int m = n < DFF ? n : n - DFF; return (m >> 7) * 256 + (n < DFF ? 0 : 128) + (m & 127); }
template <int MAP>
__device__ __forceinline__ void tr_item(const float* __restrict__ W, int K, int N, bf16_t* __restrict__ WT, int ldt, const float* __restrict__ ks, const float* __restrict__ ns, LAS float* scr, int item, int lane) {
    const int nblk = N / 32, kb = item / nblk, nb = item % nblk, k0 = 64 * kb, n0 = 32 * nb;
    const float nsv = ns ? ns[n0 + (lane & 31)] : 1.f;
    float wv[32];
#pragma unroll
    for (int i = 0; i < 32; ++i) wv[i] = __builtin_nontemporal_load(&W[(size_t)(k0 + 2 * i + (lane >> 5)) * N + n0 + (lane & 31)]);
#pragma unroll
    for (int i = 0; i < 32; ++i) { const int kk = 2 * i + (lane >> 5); float v = wv[i]; if (ks) v *= ks[k0 + kk]; scr[kk * 33 + (lane & 31)] = v * nsv; }
    asm volatile("s_waitcnt lgkmcnt(0)" ::: "memory");
    const int c = lane & 7;
#pragma unroll
    for (int j = 0; j < 4; ++j) { const int n = (lane >> 3) + 8 * j; const LAS float* s = scr + (8 * c) * 33 + n;
        u32x4 o; o.x = cvt_pk_bf16(s[0 * 33], s[1 * 33]); o.y = cvt_pk_bf16(s[2 * 33], s[3 * 33]); o.z = cvt_pk_bf16(s[4 * 33], s[5 * 33]); o.w = cvt_pk_bf16(s[6 * 33], s[7 * 33]);
        const int nn = n0 + n; const int dst = (MAP == 1) ? uq_pos(nn) : (MAP == 2) ? up_pos(nn) : nn;
        *(u32x4*)(WT + (size_t)dst * ldt + k0 + 8 * c) = o; }
    asm volatile("s_waitcnt lgkmcnt(0)" ::: "memory");
}

__device__ __forceinline__ void tr_item_poolfold(const float* __restrict__ W  , const float* __restrict__ pw  , const float* __restrict__ psc  ,
                                                 bf16_t* __restrict__ WT, LAS float* scr, int item, int lane) {
    const int kb = item / 16, nb = item % 16, k0 = 64 * kb, n0 = 32 * nb, g = n0 >> 7, d0 = n0 & 127, kg = lane >> 5, nl = lane & 31;
    const float* wa = W + (size_t)(k0 + nl) * INC + g * 128 + kg * 8;
    const float* pb = pw + (size_t)g * 128 * 128 + (size_t)(kg * 8) * 128 + d0 + nl;
    f32x4 av[8][4]; float bv[8][8];
#pragma unroll
    for (int ks = 0; ks < 8; ++ks) {
        av[ks][0] = *(const f32x4*)(wa + ks * 16); av[ks][1] = *(const f32x4*)(wa + ks * 16 + 4);
        av[ks][2] = *(const f32x4*)(wa + (size_t)32 * INC + ks * 16); av[ks][3] = *(const f32x4*)(wa + (size_t)32 * INC + ks * 16 + 4);
        if (ks < 4) {
#pragma unroll
            for (int j = 0; j < 8; ++j) bv[ks][j] = pb[(size_t)(ks * 16 + j) * 128]; } }
    __builtin_amdgcn_sched_barrier(0);
#pragma unroll
    for (int ks = 4; ks < 8; ++ks)
#pragma unroll
        for (int j = 0; j < 8; ++j) bv[ks][j] = pb[(size_t)(ks * 16 + j) * 128];
    f32x16 acc0, acc1;
#pragma unroll
    for (int i = 0; i < 16; ++i) { acc0[i] = 0.f; acc1[i] = 0.f; }
#pragma unroll
    for (int ks = 0; ks < 8; ++ks) {
        u32x4 A0, A1, B;
        A0.x = cvt_pk_bf16(av[ks][0].x, av[ks][0].y); A0.y = cvt_pk_bf16(av[ks][0].z, av[ks][0].w); A0.z = cvt_pk_bf16(av[ks][1].x, av[ks][1].y); A0.w = cvt_pk_bf16(av[ks][1].z, av[ks][1].w);
        A1.x = cvt_pk_bf16(av[ks][2].x, av[ks][2].y); A1.y = cvt_pk_bf16(av[ks][2].z, av[ks][2].w); A1.z = cvt_pk_bf16(av[ks][3].x, av[ks][3].y); A1.w = cvt_pk_bf16(av[ks][3].z, av[ks][3].w);
        B.x = cvt_pk_bf16(bv[ks][0], bv[ks][1]); B.y = cvt_pk_bf16(bv[ks][2], bv[ks][3]); B.z = cvt_pk_bf16(bv[ks][4], bv[ks][5]); B.w = cvt_pk_bf16(bv[ks][6], bv[ks][7]);
        acc0 = __builtin_amdgcn_mfma_f32_32x32x16_bf16(__builtin_bit_cast(bf16x8, A0), __builtin_bit_cast(bf16x8, B), acc0, 0, 0, 0);
        acc1 = __builtin_amdgcn_mfma_f32_32x32x16_bf16(__builtin_bit_cast(bf16x8, A1), __builtin_bit_cast(bf16x8, B), acc1, 0, 0, 0);
    }
    const float sc = psc[n0 + nl];
    bf16_t* wt = WT + (size_t)(n0 + nl) * D + k0 + 4 * kg;
#pragma unroll
    for (int q = 0; q < 4; ++q) {
        u32x2 o0, o1;
        o0.x = cvt_pk_bf16(acc0[4 * q] * sc, acc0[4 * q + 1] * sc); o0.y = cvt_pk_bf16(acc0[4 * q + 2] * sc, acc0[4 * q + 3] * sc);
        o1.x = cvt_pk_bf16(acc1[4 * q] * sc, acc1[4 * q + 1] * sc); o1.y = cvt_pk_bf16(acc1[4 * q + 2] * sc, acc1[4 * q + 3] * sc);
        *(u32x2*)(wt + 8 * q) = o0; *(u32x2*)(wt + 32 + 8 * q) = o1; }
}
constexpr int CV_IN = 32 * 134, CV_OUT = 32 * 64, CV_UP = 32 * 352, CV_DOWN = 88 * 64, CV_UQ = 6 * 24, CV_UKV = 4 * 32, CV_POOL = 0;
constexpr int CV_SEG0 = CV_UQ + CV_UKV + CV_POOL + CV_IN;
constexpr int CV_E1 = CV_OUT, CV_E2 = CV_E1 + CV_UP, CV_E3 = CV_E2 + CV_DOWN, CV_E4 = CV_E3 + CV_SEG0, CV_E5 = CV_E4 + CV_OUT, CV_E6 = CV_E5 + CV_UP, CV_E7 = CV_E6 + CV_DOWN;
__device__ __forceinline__ void conv_item0(KP kp, unsigned char* ws, int l, int r, LAS float* scr, int lane) {
    if (r < CV_UQ) { tr_item<1>(kp->in[IN_WUQ] + (size_t)l * 384 * 768, 384, 768, (bf16_t*)(ws + WS_WUQ) + (size_t)l * 768 * 384, 384, kp->in[IN_GQ] + l * 384, nullptr, scr, r, lane); return; } r -= CV_UQ;
    if (r < CV_UKV) { tr_item<0>(kp->in[IN_WUKV] + (size_t)l * 256 * 1024, 256, 1024, (bf16_t*)(ws + WS_WUKV) + (size_t)l * 1024 * 256, 256, kp->in[IN_GKV] + l * 256, nullptr, scr, r, lane); return; } r -= CV_UKV;
    if (r < CV_POOL) { const int g = r / 8, rr = r % 8;
        tr_item<0>(kp->in[IN_POOLW] + ((size_t)l * 4 + g) * 128 * 128, 128, 128, (bf16_t*)(ws + WS_POOLW) + ((size_t)l * 4 + g) * 128 * 128, 128, nullptr, kp->in[IN_POOLSCALE] + l * 512 + g * 128, scr, rr, lane); return; } r -= CV_POOL;
    if (r % 134 < 16) { tr_item_poolfold(kp->in[IN_WIN] + (size_t)l * D * INC, kp->in[IN_POOLW] + (size_t)l * 4 * 128 * 128, kp->in[IN_POOLSCALE] + l * 512, (bf16_t*)(ws + WS_WIN) + (size_t)l * ZLD * D, scr, (r / 134) * 16 + r % 134, lane); return; }
    tr_item<0>(kp->in[IN_WIN] + (size_t)l * D * INC, D, INC, (bf16_t*)(ws + WS_WIN) + (size_t)l * ZLD * D, D, nullptr, nullptr, scr, r, lane);
}
__device__ __forceinline__ void phase_prologue(KP kp, unsigned char* ws, int tid_, LAS unsigned char* lds, int vcu, int G) {
    const int tid = tid_, lane = tid & 63, wave = tid >> 6;
    {
        LAS float* red = (LAS float*)lds;
        LAS float* sil = (LAS float*)(lds + 32768);
        float* MOD = (float*)(ws + WS_MOD);
        for (int i = tid; i < 5 * D; i += NTHR) { const int row = i / D, k = i % D; const float v = (row < 4) ? kp->in[IN_C][row * D + k] : kp->in[IN_CCTX][k]; sil[i] = v / (1.f + __expf(-v)); }
        __syncthreads();
        for (int cb = vcu; cb < 256; cb += G) {
            const int gn0 = cb * 96, l = gn0 / MODW, n0 = gn0 % MODW;
            if (tid < 384) {
                const int cq = tid % 24, kg = tid / 24;
                const float* w = kp->in[IN_ADAW] + ((size_t)l * D + kg * 128) * MODW + n0 + cq * 4;
                f32x4 acc[5];
#pragma unroll
                for (int i = 0; i < 5; ++i) acc[i] = (f32x4){0.f, 0.f, 0.f, 0.f};
#pragma unroll 1
                for (int k0 = 0; k0 < 128; k0 += 16) { f32x4 wv[16];
#pragma unroll
                    for (int k = 0; k < 16; ++k) wv[k] = __builtin_nontemporal_load((const f32x4*)(w + (size_t)(k0 + k) * MODW));
#pragma unroll
                    for (int k = 0; k < 16; ++k) { const int kk = kg * 128 + k0 + k;
#pragma unroll
                        for (int i = 0; i < 5; ++i) acc[i] += wv[k] * sil[i * D + kk]; } }
#pragma unroll
                for (int i = 0; i < 5; ++i)
#pragma unroll
                    for (int e = 0; e < 4; ++e) red[(kg * 5 + i) * 96 + cq * 4 + e] = acc[i][e];
            }
            __syncthreads();
            if (tid < 480) { const int i = tid / 96, cn = tid % 96; float s = kp->in[IN_ADAB][l * MODW + n0 + cn];
#pragma unroll
                for (int kg = 0; kg < 16; ++kg) s += red[(kg * 5 + i) * 96 + cn];
                MOD[((size_t)l * 5 + i) * MODW + n0 + cn] = s; }
            __syncthreads();
        }
    }
    {
        float2* cs = (float2*)(ws + WS_CS);
        for (int idx = vcu * NTHR + tid; idx < SEQ * 32; idx += G * NTHR) {
            const int t = idx / 32, i = idx % 32, f = i & 15;
            const float base = ((f & 3) == 0) ? 1.0f : ((f & 3) == 1) ? 0.5623413251903491f : ((f & 3) == 2) ? 0.31622776601683794f : 0.1778279410038923f;
            const float dec = ((f >> 2) == 0) ? 1.0f : ((f >> 2) == 1) ? 0.1f : ((f >> 2) == 2) ? 0.01f : 0.001f;
            const float pos = (i < 16) ? (float)(t / GRIDW) : (float)(t % GRIDW);
            const float ang = pos * (base * dec);
            cs[idx] = make_float2(__cosf(ang), __sinf(ang));
        }
    }
    {
        for (int idx = vcu * NTHR + tid; idx < 2 * 64 * 256; idx += G * NTHR) { const int l = idx / (64 * 256), rem = idx % (64 * 256), row = INC + rem / 256, ch = rem % 256;
            *(u32x4*)((bf16_t*)(ws + WS_WIN) + ((size_t)l * ZLD + row) * D + ch * 8) = (u32x4){0u, 0u, 0u, 0u}; }
    }
    {
        LAS float* scr = (LAS float*)(lds + 32768) + wave * (64 * 33);
        const int gw = vcu * NWAVES + wave, NGW = G * NWAVES;
        for (int it = gw; it < CV_SEG0; it += NGW) conv_item0(kp, ws, 0, it, scr, lane);
    }
}

__device__ __forceinline__ void conv_itemq(KP kp, unsigned char* ws, int it, LAS float* scr, int lane) {
    if (it < CV_E1) { tr_item<0>(kp->in[IN_WOUT], D, D, (bf16_t*)(ws + WS_WOUT), D, nullptr, nullptr, scr, it, lane); return; }
    if (it < CV_E2) { tr_item<2>(kp->in[IN_WUP], D, UFF, (bf16_t*)(ws + WS_WUP), D, nullptr, nullptr, scr, it - CV_E1, lane); return; }
    if (it < CV_E3) { tr_item<0>(kp->in[IN_WDOWN], DFF, D, (bf16_t*)(ws + WS_WDOWN), DFF, nullptr, nullptr, scr, it - CV_E2, lane); return; }
    if (it < CV_E4) { conv_item0(kp, ws, 1, it - CV_E3, scr, lane); return; }
    if (it < CV_E5) { tr_item<0>(kp->in[IN_WOUT] + (size_t)D * D, D, D, (bf16_t*)(ws + WS_WOUT) + (size_t)D * D, D, nullptr, nullptr, scr, it - CV_E4, lane); return; }
    if (it < CV_E6) { tr_item<2>(kp->in[IN_WUP] + (size_t)D * UFF, D, UFF, (bf16_t*)(ws + WS_WUP) + (size_t)UFF * D, D, nullptr, nullptr, scr, it - CV_E5, lane); return; }
    tr_item<0>(kp->in[IN_WDOWN] + (size_t)DFF * D, DFF, D, (bf16_t*)(ws + WS_WDOWN) + (size_t)D * DFF, DFF, nullptr, nullptr, scr, it - CV_E6, lane);
}
constexpr int CV_CHUNK = 32;
__device__ __forceinline__ int conv_claim_chunk(unsigned char* ws, LAS unsigned char* lds, int tid) {
    volatile LAS unsigned* slot = (volatile LAS unsigned*)(lds + MISC_OFF + 16);
    __syncthreads();
    if (tid == 0) { const unsigned b_ = __hip_atomic_fetch_add((unsigned*)(ws + WS_CVQ), (unsigned)CV_CHUNK, __ATOMIC_RELAXED, __HIP_MEMORY_SCOPE_AGENT); slot[0] = b_; slot[2] = b_ + (unsigned)CV_CHUNK; }
    __syncthreads();
    return (int)__builtin_amdgcn_readfirstlane(slot[0]);
}
__device__ __forceinline__ void conv_chunk(KP kp, unsigned char* ws, LAS unsigned char* lds, int tid, int base) {
    const int lane = tid & 63, wave = tid >> 6; LAS float* scr = (LAS float*)(lds + 32768) + wave * (64 * 33);
    for (int j = wave; j < CV_CHUNK; j += NWAVES) { const int it = base + j; if (it < CV_E7) conv_itemq(kp, ws, it, scr, lane); }
}
__device__ __forceinline__ void conv_drain(KP kp, unsigned char* ws, LAS unsigned char* lds, int tid, int limit) {
    volatile LAS unsigned* slot = (volatile LAS unsigned*)(lds + MISC_OFF + 16);
    if ((int)__builtin_amdgcn_readfirstlane(slot[2]) >= limit) return;
    for (;;) {
        __syncthreads();
        if (tid == 0) { const unsigned v_ = __hip_atomic_load((unsigned*)(ws + WS_CVQ), __ATOMIC_RELAXED, __HIP_MEMORY_SCOPE_AGENT); slot[1] = v_; slot[2] = v_; }
        __syncthreads();
        if ((int)__builtin_amdgcn_readfirstlane(slot[1]) >= limit) break;
        const int base = conv_claim_chunk(ws, lds, tid); conv_chunk(kp, ws, lds, tid, base);
    }
}
__device__ __forceinline__ void conv_fill(KP kp, unsigned char* ws, LAS unsigned char* lds, int tid, int nchunks) {
    for (int n = 0; n < nchunks; ++n) { const int base = conv_claim_chunk(ws, lds, tid); if (base >= CV_E7) break; conv_chunk(kp, ws, lds, tid, base); }
}

constexpr int RP_GA = 0, RP_NB = 5 * D, RP_SH = 10 * D;
__device__ __forceinline__ void rowpass_row(const float* __restrict__ xin, const bf16_t* __restrict__ xinb, const bf16_t* __restrict__ y, const float* __restrict__ yp, float* __restrict__ xout, bf16_t* __restrict__ xoutb, bf16_t* __restrict__ hout,
                                            const LAS float* tab, int lane) {
    f32x4 xv[8];
    if (xinb) {
#pragma unroll
        for (int j = 0; j < 8; ++j) { const u32x2 w = __builtin_nontemporal_load((const u32x2*)(xinb + j * 256 + lane * 4)); xv[j] = (f32x4){__uint_as_float(w.x << 16), __uint_as_float(w.x & 0xffff0000u), __uint_as_float(w.y << 16), __uint_as_float(w.y & 0xffff0000u)}; }
    } else {
#pragma unroll
        for (int j = 0; j < 8; ++j) xv[j] = __builtin_nontemporal_load((const f32x4*)(xin + j * 256 + lane * 4));
    }
    if (y) {
        f32x4 yv[8]; float ss = 0.f;
#pragma unroll
        for (int j = 0; j < 8; ++j) { const u32x2 yw = *(const u32x2*)(y + j * 256 + lane * 4);
            yv[j] = (f32x4){__uint_as_float(yw.x << 16), __uint_as_float(yw.x & 0xffff0000u), __uint_as_float(yw.y << 16), __uint_as_float(yw.y & 0xffff0000u)};
            if (yp) {
                const bf16_t* ypb = (const bf16_t*)yp;
#pragma unroll
                for (int p = 0; p < 3; ++p) { const u32x2 pw = *(const u32x2*)(ypb + (size_t)p * RC * D + j * 256 + lane * 4);
                    yv[j] += (f32x4){__uint_as_float(pw.x << 16), __uint_as_float(pw.x & 0xffff0000u), __uint_as_float(pw.y << 16), __uint_as_float(pw.y & 0xffff0000u)}; } }
            ss += (yv[j].x * yv[j].x + yv[j].y * yv[j].y) + (yv[j].z * yv[j].z + yv[j].w * yv[j].w); }
        ss = wsum(ss, lane); const float rs = 1.0f / sqrtf(ss * (1.f / D) + EPS);
#pragma unroll
        for (int j = 0; j < 8; ++j) { const f32x4 ga = *(const LAS f32x4*)(tab + RP_GA + j * 256 + lane * 4); xv[j] += ga * (yv[j] * rs); }
    }
    if (xout) {
#pragma unroll
        for (int j = 0; j < 8; ++j) __builtin_nontemporal_store(xv[j], (f32x4*)(xout + j * 256 + lane * 4));
    }
    if (xoutb) {
#pragma unroll
        for (int j = 0; j < 8; ++j) { u32x2 w; w.x = cvt_pk_bf16(xv[j].x, xv[j].y); w.y = cvt_pk_bf16(xv[j].z, xv[j].w); __builtin_nontemporal_store(w, (u32x2*)(xoutb + j * 256 + lane * 4)); }
    }
    if (hout) {
        float ss = 0.f;
#pragma unroll
        for (int j = 0; j < 8; ++j) ss += (xv[j].x * xv[j].x + xv[j].y * xv[j].y) + (xv[j].z * xv[j].z + xv[j].w * xv[j].w);
        ss = wsum(ss, lane); const float rs = 1.0f / sqrtf(ss * (1.f / D) + EPS);
#pragma unroll
        for (int j = 0; j < 8; ++j) { const f32x4 nb = *(const LAS f32x4*)(tab + RP_NB + j * 256 + lane * 4), sh = *(const LAS f32x4*)(tab + RP_SH + j * 256 + lane * 4);
            const f32x4 o = (xv[j] * rs) * nb + sh; u32x2 w; w.x = cvt_pk_bf16(o.x, o.y); w.y = cvt_pk_bf16(o.z, o.w);
            *(u32x2*)(hout + j * 256 + lane * 4) = w; }
    }
}
__device__ __forceinline__ void phase_rowpass(KP kp, unsigned char* ws, LAS unsigned char* lds, int tid_, int kind, int l, int vcu, int G) {
    const int lane = tid_ & 63, wave = __builtin_amdgcn_readfirstlane(tid_ >> 6);
    const float* MOD = (const float*)(ws + WS_MOD);
    float* XR = (float*)(ws + WS_XR); const bf16_t* Y = (const bf16_t*)(ws + WS_Y); bf16_t* H = (bf16_t*)(ws + WS_H);
    const bool last = (l == 1);
    const int nrows = (kind == 0) ? R : (last ? RX : R);
    LAS float* T = (LAS float*)lds;
    {
        const int ln = (kind == 2 && !last) ? 1 : l;
        const float* ygain = (kind == 1) ? kp->in[IN_GPOSTMIX] + l * D : kp->in[IN_GPOSTFFN] + l * D;
        const float* ngain = (kind == 0) ? kp->in[IN_GPREMIX] : (kind == 1 ? kp->in[IN_GPREFFN] + l * D : kp->in[IN_GPREMIX] + 1 * D);
        const int goff = (kind == 1) ? 2 * D : 5 * D, shoff = (kind == 1) ? 3 * D : 0, scoff = (kind == 1) ? 4 * D : 1 * D;
        __syncthreads();
        for (int idx = tid_; idx < 5 * (D / 4); idx += NTHR) { const int b = idx / (D / 4), c4 = (idx % (D / 4)) * 4;
            const float* m = MOD + ((size_t)l * 5 + b) * MODW; const float* mn = MOD + ((size_t)ln * 5 + b) * MODW;
            if (kind != 0) *(LAS f32x4*)(T + RP_GA + b * D + c4) = *(const f32x4*)(m + goff + c4) * *(const f32x4*)(ygain + c4);
            if (!(kind == 2 && last)) { *(LAS f32x4*)(T + RP_NB + b * D + c4) = *(const f32x4*)(ngain + c4) * (*(const f32x4*)(mn + scoff + c4) + 1.f);
                                        *(LAS f32x4*)(T + RP_SH + b * D + c4) = *(const f32x4*)(mn + shoff + c4); } }
        __syncthreads();
    }
    for (int r = vcu * NWAVES + wave; r < nrows; r += G * NWAVES) {
        int b, t, L, isc; rowinfo(r, b, t, L, isc); const int mi = isc ? 4 : b;
        int ln = lane; asm volatile("" : "+v"(ln));
        size_t zo = 0; asm volatile("" : "+s"(zo));
        const LAS float* tab = T + mi * D;
        const float* ypr = (isc && l == 0) ? (const float*)((const bf16_t*)(ws + WS_YP) + (size_t)(r - RX) * D + zo) : nullptr;
        const float* xin0 = (isc ? kp->in[IN_CTX] + (size_t)(r - RX) * D : kp->in[IN_X] + (size_t)r * D) + zo;
        bf16_t* XB = (bf16_t*)XR;
        if (kind == 0) rowpass_row(xin0, nullptr, nullptr, nullptr, nullptr, nullptr, H + (size_t)r * D, tab, ln);
        else if (kind == 1) rowpass_row(xin0, (l == 0) ? nullptr : XB + (size_t)r * D + zo, Y + (size_t)r * D, ypr, nullptr, XB + (size_t)r * D, H + (size_t)r * D, tab, ln);
        else if (!last) rowpass_row(nullptr, XB + (size_t)r * D + zo, Y + (size_t)r * D, ypr, nullptr, XB + (size_t)r * D, H + (size_t)r * D, tab, ln);
        else rowpass_row(nullptr, XB + (size_t)r * D + zo, Y + (size_t)r * D, nullptr, kp->out + (size_t)r * D, nullptr, nullptr, tab, ln);
    }
    __syncthreads();
}

__device__ __forceinline__ void pre_rope(KP kp, unsigned char* ws, int tid_, int vcu, int G) {
    bf16_t* Z = (bf16_t*)(ws + WS_Z); bf16_t* KR = (bf16_t*)(ws + WS_KR); const float2* cs = (const float2*)(ws + WS_CS);
    const int gt = vcu * NTHR + tid_, NGT = G * NTHR;
    for (int idx0 = gt; idx0 < RX * 68; idx0 += 2 * NGT) {
        u32x4 q1[2], q2[2]; f32x4 cq[2][4]; bf16_t* dst[2]; bool ok[2];
#pragma unroll
        for (int k = 0; k < 2; ++k) { const int idx = idx0 + k * NGT; ok[k] = idx < RX * 68; const int id = ok[k] ? idx : gt;
            const int ic = id & 3, v = (id >> 2) % 17, r = id / 68, t = r % SEQ; const int col = (v < 16) ? Z_Q + v * 64 : Z_KR;
            const bf16_t* src = Z + (size_t)r * ZLD + col + ic * 8; q1[k] = ld16(src); q2[k] = ld16(src + 32);
            const f32x4* cp = (const f32x4*)(cs + t * 32 + ic * 8);
#pragma unroll
            for (int q = 0; q < 4; ++q) cq[k][q] = cp[q];
            dst[k] = (v < 16) ? Z + (size_t)r * ZLD + col + ic * 8 : KR + (size_t)r * 64 + ic * 8; }
#pragma unroll
        for (int k = 0; k < 2; ++k) { float x1[8], x2[8], o1[8], o2[8]; unpack8(q1[k], x1); unpack8(q2[k], x2);
#pragma unroll
            for (int q = 0; q < 4; ++q) { const f32x4 c2 = cq[k][q];
                o1[2 * q] = x1[2 * q] * c2.x - x2[2 * q] * c2.y; o2[2 * q] = x1[2 * q] * c2.y + x2[2 * q] * c2.x;
                o1[2 * q + 1] = x1[2 * q + 1] * c2.z - x2[2 * q + 1] * c2.w; o2[2 * q + 1] = x1[2 * q + 1] * c2.w + x2[2 * q + 1] * c2.z; }
            if (ok[k]) { st16(dst[k], pack8(o1)); st16(dst[k] + 32, pack8(o2)); } }
    }
    for (int idx = gt; idx < RC * 8; idx += NGT) { const int r = RX + idx / 8, ch = idx % 8; st16(KR + (size_t)r * 64 + ch * 8, ld16(Z + (size_t)r * ZLD + Z_KR + ch * 8)); }
}
__device__ __forceinline__ void pre_conv(KP kp, unsigned char* ws, int tid_, int l, int vcu, int G) {
    const bf16_t* Z = (const bf16_t*)(ws + WS_Z); bf16_t* MIX = (bf16_t*)(ws + WS_MIX);
    const float* cw = kp->in[IN_CONVW] + (size_t)l * 3 * 512;
    const int gt = vcu * NTHR + tid_, NGT = G * NTHR;
    for (int idx0 = gt; idx0 < R * 64; idx0 += 2 * NGT) {
        u32x4 gcq[2][3], hq[2][3], gbq[2]; int rr[2], cc[2]; bool ok[2];
#pragma unroll
        for (int k = 0; k < 2; ++k) { const int idx = idx0 + k * NGT; ok[k] = idx < R * 64; const int id = ok[k] ? idx : gt;
            const int ch = id & 63, r = id >> 6, c0 = ch * 8; int b, t, L, isc; rowinfo(r, b, t, L, isc); rr[k] = r; cc[k] = c0;
#pragma unroll
            for (int j = 0; j < 3; ++j) { const int tt = t + j - 1; const bool in = (tt >= 0 && tt < L); const bf16_t* zr = Z + (size_t)(in ? r + j - 1 : r) * ZLD;
                gcq[k][j] = in ? ld16(zr + Z_GC + c0) : (u32x4){0u, 0u, 0u, 0u}; hq[k][j] = ld16(zr + Z_H + c0); }
            gbq[k] = ld16(Z + (size_t)r * ZLD + Z_GB + c0); }
#pragma unroll
        for (int k = 0; k < 2; ++k) { float s[8];
#pragma unroll
            for (int e = 0; e < 8; ++e) s[e] = 0.f;
#pragma unroll
            for (int j = 0; j < 3; ++j) { float gc[8], hh[8]; unpack8(gcq[k][j], gc); unpack8(hq[k][j], hh);
                const f32x4 w0 = *(const f32x4*)(cw + j * 512 + cc[k]), w1 = *(const f32x4*)(cw + j * 512 + cc[k] + 4);
                s[0] += w0.x * gc[0] * hh[0]; s[1] += w0.y * gc[1] * hh[1]; s[2] += w0.z * gc[2] * hh[2]; s[3] += w0.w * gc[3] * hh[3];
                s[4] += w1.x * gc[4] * hh[4]; s[5] += w1.y * gc[5] * hh[5]; s[6] += w1.z * gc[6] * hh[6]; s[7] += w1.w * gc[7] * hh[7]; }
            float gb[8]; unpack8(gbq[k], gb);
#pragma unroll
            for (int e = 0; e < 8; ++e) s[e] *= gb[e];
            if (ok[k]) st16(MIX + (size_t)rr[k] * D + 1536 + cc[k], pack8(s)); }
    }
}
__device__ __forceinline__ void pre_pool(KP kp, unsigned char* ws, int tid_, int l, int vcu, int G) {
    const bf16_t* Z = (const bf16_t*)(ws + WS_Z); bf16_t* MIX = (bf16_t*)(ws + WS_MIX);
    const int gt = vcu * NTHR + tid_, NGT = G * NTHR;
    for (int idx = gt; idx < (R / 8) * 64; idx += NGT) {
        const int ch = idx & 63, strip = idx >> 6, r0 = strip * 8, c0 = ch * 8, g = c0 >> 7, half = 1 << g; int b, t0, L, isc; rowinfo(r0, b, t0, L, isc);
        u32x4 q[24];
#pragma unroll
        for (int i = 0; i < 24; ++i) { const int tt = t0 - 8 + i; const bool ok = (tt >= 0 && tt < L && i >= 8 - half && i < 16 + half);
            q[i] = ok ? ld16(Z + (size_t)(r0 - 8 + i) * ZLD + Z_POOL + c0) : (u32x4){0u, 0u, 0u, 0u}; }
        float sum[8];
#pragma unroll
        for (int e = 0; e < 8; ++e) sum[e] = 0.f;
#pragma unroll
        for (int i = 0; i < 16; ++i) { if (i >= 8 - half && i < 8 + half) { float v[8]; unpack8(q[i], v);
#pragma unroll
                for (int e = 0; e < 8; ++e) sum[e] += v[e]; } }
#pragma unroll
        for (int j = 0; j < 8; ++j) {
            const int t = t0 + j; int lo = t - half; if (lo < 0) lo = 0; int hi = t + half; if (hi > L) hi = L;
            const float inv = 1.0f / (float)(hi - lo);
            float self[8], o[8]; unpack8(q[8 + j], self);
#pragma unroll
            for (int e = 0; e < 8; ++e) o[e] = sum[e] * inv - self[e];
            st16(MIX + (size_t)(r0 + j) * D + c0, pack8(o));
            if (j < 7) {
                float dv[8], av[8];
                const u32x4 dq = (half == 1) ? q[7 + j] : (half == 2) ? q[6 + j] : (half == 4) ? q[4 + j] : q[j];
                const u32x4 aq = (half == 1) ? q[9 + j] : (half == 2) ? q[10 + j] : (half == 4) ? q[12 + j] : q[16 + j];
                unpack8(dq, dv); unpack8(aq, av);
#pragma unroll
                for (int e = 0; e < 8; ++e) sum[e] += av[e] - dv[e]; }
        }
    }
}
__device__ __forceinline__ void phase_act(KP kp, unsigned char* ws, int tid_, int l, int vcu, int G, size_t out_off = WS_ACT) {
    const bf16_t* U = (const bf16_t*)(ws + WS_U); bf16_t* ACT = (bf16_t*)(ws + out_off);
    const float* cw = kp->in[IN_FFNCONVW] + (size_t)l * 3 * UFF;
    const int nrows = (l == 1) ? RX : R;
    const int gt = vcu * NTHR + tid_, NGT = G * NTHR;
    for (int idx = gt; idx < (nrows / 8) * 704; idx += NGT) {
        const int chn = idx % 704, strip = idx / 704, r0 = strip * 8, j0 = chn * 8; int b, t0, L, isc; rowinfo(r0, b, t0, L, isc);
        const bf16_t* ub = U + (size_t)r0 * UFF + j0;
        u32x4 gq[10], vq[10];
#pragma unroll
        for (int i = 0; i < 10; ++i) { const int tt = t0 + i - 1; const bool ok = (tt >= 0 && tt < L);
            gq[i] = ok ? ld16(ub + (ptrdiff_t)(i - 1) * UFF) : (u32x4){0u, 0u, 0u, 0u}; vq[i] = ok ? ld16(ub + (ptrdiff_t)(i - 1) * UFF + DFF) : (u32x4){0u, 0u, 0u, 0u}; }
        float wg[3][8], wv[3][8];
#pragma unroll
        for (int k = 0; k < 3; ++k) { const f32x4 a0 = *(const f32x4*)(cw + k * UFF + j0), a1 = *(const f32x4*)(cw + k * UFF + j0 + 4), b0 = *(const f32x4*)(cw + k * UFF + DFF + j0), b1 = *(const f32x4*)(cw + k * UFF + DFF + j0 + 4);
            wg[k][0] = a0.x; wg[k][1] = a0.y; wg[k][2] = a0.z; wg[k][3] = a0.w; wg[k][4] = a1.x; wg[k][5] = a1.y; wg[k][6] = a1.z; wg[k][7] = a1.w;
            wv[k][0] = b0.x; wv[k][1] = b0.y; wv[k][2] = b0.z; wv[k][3] = b0.w; wv[k][4] = b1.x; wv[k][5] = b1.y; wv[k][6] = b1.z; wv[k][7] = b1.w; }
#pragma unroll
        for (int i = 0; i < 8; ++i) {
            float pg[8], cg_[8], ng[8], pv[8], cv[8], nv[8], o[8];
            unpack8(gq[i], pg); unpack8(gq[i + 1], cg_); unpack8(gq[i + 2], ng); unpack8(vq[i], pv); unpack8(vq[i + 1], cv); unpack8(vq[i + 2], nv);
#pragma unroll
            for (int e = 0; e < 8; ++e) { const float gsum = wg[0][e] * pg[e] + wg[1][e] * cg_[e] + wg[2][e] * ng[e]; const float vsum = wv[0][e] * pv[e] + wv[1][e] * cv[e] + wv[2][e] * nv[e];
                o[e] = gsum * __builtin_amdgcn_rcpf(1.f + __expf(-gsum)) * vsum; }
            st16(ACT + (size_t)(r0 + i) * DFF + j0, pack8(o));
        }
    }
}

__device__ __forceinline__ void phase_act_edges(KP kp, unsigned char* ws, int tid_, int l, int vcu, int G) {
    const bf16_t* EDGE = (const bf16_t*)(ws + WS_EDGE); bf16_t* ACT = (bf16_t*)(ws + WS_ACT);
    const float* cw = kp->in[IN_FFNCONVW] + (size_t)l * 3 * UFF;
    const int ntile = ((l == 1) ? RX : R) / 256;
    const int gt = vcu * NTHR + tid_, NGT = G * NTHR;
    for (int idx = gt; idx < ntile * 2 * 704; idx += NGT) {
        const int chn = idx % 704, which = (idx / 704) & 1, pm = idx / 1408, j0 = chn * 8;
        const bool seq_first = (pm >= RX / 256) || (pm % (SEQ / 256) == 0), seq_last = (pm >= RX / 256) || (pm % (SEQ / 256) == SEQ / 256 - 1);
        const bf16_t* e0 = EDGE + (size_t)pm * 4 * UFF + j0;
        const bf16_t* pr = which == 0 ? (seq_first ? nullptr : e0 - (size_t)4 * UFF + (size_t)3 * UFF) : e0 + (size_t)2 * UFF;
        const bf16_t* cu = which == 0 ? e0 : e0 + (size_t)3 * UFF;
        const bf16_t* nx = which == 0 ? e0 + (size_t)1 * UFF : (seq_last ? nullptr : e0 + (size_t)4 * UFF);
        float pg[8], pv[8], cg_[8], cv[8], ng[8], nv[8], o[8];
        if (pr) { unpack8(ld16(pr), pg); unpack8(ld16(pr + DFF), pv); } else {
#pragma unroll
            for (int e = 0; e < 8; ++e) { pg[e] = 0.f; pv[e] = 0.f; } }
        unpack8(ld16(cu), cg_); unpack8(ld16(cu + DFF), cv);
        if (nx) { unpack8(ld16(nx), ng); unpack8(ld16(nx + DFF), nv); } else {
#pragma unroll
            for (int e = 0; e < 8; ++e) { ng[e] = 0.f; nv[e] = 0.f; } }
#pragma unroll
        for (int e = 0; e < 8; ++e) { const float gsum = cw[0 * UFF + j0 + e] * pg[e] + cw[1 * UFF + j0 + e] * cg_[e] + cw[2 * UFF + j0 + e] * ng[e];
            const float vsum = cw[0 * UFF + DFF + j0 + e] * pv[e] + cw[1 * UFF + DFF + j0 + e] * cv[e] + cw[2 * UFF + DFF + j0 + e] * nv[e];
            o[e] = gsum * __builtin_amdgcn_rcpf(1.f + __expf(-gsum)) * vsum; }
        st16(ACT + (size_t)(pm * 256 + (which ? 255 : 0)) * DFF + j0, pack8(o));
    }
}

namespace pg8 {
constexpr int BM = 256, BK = 64, HALF = 128, HTB = HALF * BK * 2, STAGE_BYTES = 8 * HTB, NXCD = 8, WGM = 8;
__host__ __device__ __forceinline__ int lds_byte(int r, int c) { const int st = (r >> 4) * 2 + (c >> 5), rr = r & 15, cc = c & 31, ob = rr * 64 + cc * 2; return st * 1024 + (ob ^ (((ob >> 9) & 1) << 5)); }
__host__ __device__ __forceinline__ void stage_rc(int b, int& R_, int& C_) { const int st = b / 1024, sb = b % 1024, swz = sb ^ (((sb >> 9) & 1) << 5); R_ = (st >> 1) * 16 + swz / 64; C_ = (st & 1) * 32 + (swz % 64) / 2; }
__host__ __device__ __forceinline__ int perm32(int rho) { const int n = rho >> 4, i = rho & 15; return 8 * (i >> 2) + 4 * n + (i & 3); }
struct Unit { int pm, pn, kt0, nkt, part; };
struct Gemm { const bf16_t* A; const bf16_t* Bt; int lda, ldb, K; };
struct TileOrder {
    int nM, nN, nwg, G, c, nt, nMs, ksplit;
    __device__ void init(int nM_, int nN_, int G_, int c_, int nt_, int nMs_ = 0, int ksplit_ = 1) { nM = nM_; nN = nN_; nwg = nM * nN; G = G_; c = c_; nt = nt_; nMs = nMs_; ksplit = ksplit_; }
    __device__ __forceinline__ bool next(int i, Unit& u) const {
        const int L = i * G + c; const int nsp = nMs * nN * ksplit; if (L >= nwg + nsp) return false;
        const bool sp = (L >= nwg);
        const int j = sp ? L - nwg : 0, part = j % ksplit, t = j / ksplit, nk = nt / ksplit;
        int wgid = sp ? 0 : L; { const int q = nwg / NXCD, r = nwg % NXCD, xcd = wgid % NXCD, off = wgid / NXCD; wgid = (xcd < r ? xcd * (q + 1) : r * (q + 1) + (xcd - r) * q) + off; }
        const int nig = WGM * nN, gid = wgid / nig, fm = gid * WGM, gsz = (nM - fm) < WGM ? (nM - fm) : WGM;
        const int pm0 = fm + ((wgid % nig) % gsz), pn0 = (wgid % nig) / gsz;
        u.pm = sp ? nM + t / nN : pm0; u.pn = sp ? t % nN : pn0; u.kt0 = sp ? part * nk : 0; u.nkt = sp ? nk : nt; u.part = sp ? part : 0;
        return true;
    }
};
typedef f32x4 Acc[2][2][4][2];
template <class T, class = void> struct epi_aperm { static constexpr bool value = false; };
template <class T> struct epi_aperm<T, decltype((void)T::APERM)> { static constexpr bool value = true; };
template <class T, class = void> struct epi_prefetch { static constexpr bool value = false; };
template <class T> struct epi_prefetch<T, decltype((void)T::PREFETCH)> { static constexpr bool value = true; };
template <class Epi, class Sched, bool ALIGN_EPI>
__device__ __forceinline__ void gemm_phase(LAS unsigned char* lds, const Gemm g, const Sched& S, const Epi& E, int tid) {
    const int wid = __builtin_amdgcn_readfirstlane(tid >> 6), lane = tid & 63, wr = wid >> 2, wc = wid & 3, fr = lane & 15, fq = lane >> 4;
    unsigned voffA[2], voffB[2];
#pragma unroll
    for (int i = 0; i < 2; ++i) { int R_, C_; stage_rc(tid * 16 + i * 8192, R_, C_); const int Rb = Epi::PERM ? ((R_ & ~31) + perm32(R_ & 31)) : R_;
        const int Ra = epi_aperm<Epi>::value ? ((R_ & ~63) + ((R_ & 15) << 2) + ((R_ >> 4) & 3)) : R_;
        voffA[i] = (unsigned)(Ra * g.lda + C_) * 2u; voffB[i] = (unsigned)(Rb * g.ldb + C_) * 2u; }
    const size_t kstep = (size_t)(BK * 2);
    const size_t hstepA = (size_t)HALF * g.lda * 2, hstepB = (size_t)HALF * g.ldb * 2;
    const size_t tstepA = 2 * hstepA, tstepB = 2 * hstepB;
    const unsigned ldsw = (unsigned)wid * 1024u;
    const int aoff = lds_byte(wr * 64 + fr, fq * 8), boff = lds_byte(wc * 32 + fr, fq * 8);
#define PG8_SA(b, h) (((b) * 2 + (h)) * HTB)
#define PG8_SB(b, h) ((4 + (b) * 2 + (h)) * HTB)
#define PG8_STAGE(bufoff, gbase, voff) do { _Pragma("unroll") for (int _i = 0; _i < 2; ++_i) \
        __builtin_amdgcn_global_load_lds((const unsigned*)((const char*)(gbase) + (voff)[_i]), (LAS unsigned*)(lds + (bufoff) + ldsw + _i * 8192), 16, 0, 0); } while (0)
#define PG8_LDA(dst, b, h) do { _Pragma("unroll") for (int m = 0; m < 4; ++m) _Pragma("unroll") for (int k = 0; k < 2; ++k) dst[m][k] = *(const LAS bf16x8*)(lds + PG8_SA(b, h) + aoff + m * 2048 + k * 1024); } while (0)
#define PG8_LDB(dst, b, h) do { _Pragma("unroll") for (int n = 0; n < 2; ++n) _Pragma("unroll") for (int k = 0; k < 2; ++k) dst[n][k] = *(const LAS bf16x8*)(lds + PG8_SB(b, h) + boff + n * 2048 + k * 1024); } while (0)
#define PG8_MMA(ai, bj, At, Bt) do { __builtin_amdgcn_s_setprio(1); _Pragma("unroll") for (int m = 0; m < 4; ++m) _Pragma("unroll") for (int n = 0; n < 2; ++n) _Pragma("unroll") for (int k = 0; k < 2; ++k) \
        acc[ai][bj][m][n] = __builtin_amdgcn_mfma_f32_16x16x32_bf16(Bt[n][k], At[m][k], acc[ai][bj][m][n], 0, 0, 0); __builtin_amdgcn_s_setprio(0); } while (0)
#define PG8_WAIT_V(n) asm volatile("s_waitcnt vmcnt(" #n ")" ::: "memory")
#define PG8_WAIT_L(n) asm volatile("s_waitcnt lgkmcnt(" #n ")" ::: "memory")
#define PG8_BAR __builtin_amdgcn_s_barrier()
#define PG8_SCHED __builtin_amdgcn_sched_barrier(0)
    Unit cur, nxt; int ui = 0;
    if (!S.next(0, cur)) return;
#ifdef PROBE_G
    unsigned long long pe_tot = 0;
#endif
    f32x4 acc[2][2][4][2];
#pragma unroll
    for (int a = 0; a < 2; ++a)
#pragma unroll
        for (int b = 0; b < 2; ++b)
#pragma unroll
            for (int m = 0; m < 4; ++m)
#pragma unroll
                for (int n = 0; n < 2; ++n) acc[a][b][m][n] = (f32x4){0.f, 0.f, 0.f, 0.f};
    bf16x8 At[4][2], B0[2][2], B1[2][2];
    const char* cA = (const char*)g.A + (size_t)cur.pm * tstepA + (size_t)cur.kt0 * kstep; const char* cB = (const char*)g.Bt + (size_t)cur.pn * tstepB + (size_t)cur.kt0 * kstep;
    int nt = cur.nkt;
    if constexpr (epi_prefetch<Epi>::value) E.prefetch(cur, 0, wid, lane);
    PG8_STAGE(PG8_SB(0, 0), cB, voffB); PG8_STAGE(PG8_SB(0, 1), cB + hstepB, voffB); PG8_STAGE(PG8_SA(0, 0), cA, voffA); PG8_STAGE(PG8_SA(0, 1), cA + hstepA, voffA);
    if (wr == 1) PG8_BAR;
    PG8_WAIT_V(2); PG8_BAR;
    PG8_STAGE(PG8_SB(1, 0), cB + kstep, voffB); PG8_STAGE(PG8_SA(1, 0), cA + kstep, voffA); PG8_STAGE(PG8_SB(1, 1), cB + hstepB + kstep, voffB);
    PG8_WAIT_V(6); PG8_BAR;
    for (;;) {
        const bool has_next = S.next(ui + 1, nxt);
        const char* nA = has_next ? (const char*)g.A + (size_t)nxt.pm * tstepA + (size_t)nxt.kt0 * kstep : cA; const char* nB = has_next ? (const char*)g.Bt + (size_t)nxt.pn * tstepB + (size_t)nxt.kt0 * kstep : cB;
#pragma unroll 1
        for (int t = 0; t < nt; t += 2) {
            const bool last = (t == nt - 2);
            const char* a1 = cA + (size_t)(t + 1) * kstep;
            const char* a2 = last ? nA : cA + (size_t)(t + 2) * kstep; const char* b2 = last ? nB : cB + (size_t)(t + 2) * kstep;
            const char* a3 = a2 + kstep; const char* b3 = b2 + kstep;
            PG8_LDB(B0, 0, 0); PG8_LDB(B1, 0, 1); PG8_SCHED; PG8_LDA(At, 0, 0); PG8_STAGE(PG8_SA(1, 1), a1 + hstepA, voffA);
            PG8_WAIT_V(8); PG8_WAIT_L(0); PG8_BAR; PG8_MMA(0, 0, At, B0); PG8_MMA(0, 1, At, B1); PG8_BAR; PG8_SCHED;
            PG8_LDA(At, 0, 1); PG8_STAGE(PG8_SB(0, 0), b2, voffB); PG8_STAGE(PG8_SB(0, 1), b2 + hstepB, voffB); PG8_STAGE(PG8_SA(0, 0), a2, voffA);
            PG8_WAIT_V(8); PG8_WAIT_L(0); PG8_BAR; PG8_MMA(1, 0, At, B0); PG8_MMA(1, 1, At, B1); PG8_BAR; PG8_SCHED;
            PG8_LDB(B0, 1, 0); PG8_LDB(B1, 1, 1); PG8_SCHED; PG8_LDA(At, 1, 0); PG8_STAGE(PG8_SA(0, 1), a2 + hstepA, voffA);
            PG8_WAIT_V(8); PG8_WAIT_L(0); PG8_BAR; PG8_MMA(0, 0, At, B0); PG8_MMA(0, 1, At, B1); PG8_BAR; PG8_SCHED;
            PG8_LDA(At, 1, 1); PG8_STAGE(PG8_SB(1, 0), b3, voffB); PG8_STAGE(PG8_SB(1, 1), b3 + hstepB, voffB); PG8_STAGE(PG8_SA(1, 0), a3, voffA);
            PG8_WAIT_V(8); PG8_WAIT_L(0); PG8_BAR; PG8_MMA(1, 0, At, B0); PG8_MMA(1, 1, At, B1); PG8_BAR; PG8_SCHED;
        }
        if constexpr (ALIGN_EPI) { if (wr == 0) PG8_BAR; }
#ifdef PROBE_G
        const unsigned long long pe0 = __builtin_amdgcn_s_memrealtime();
#endif
        if constexpr (epi_prefetch<Epi>::value) E.run(acc, cur, wr, wc, fr, fq, ui & 1); else E(acc, cur, wr, wc, fr, fq);
#ifdef PROBE_G
        pe_tot += __builtin_amdgcn_s_memrealtime() - pe0;
#endif
        if (!has_next) break;
#pragma unroll
        for (int a = 0; a < 2; ++a)
#pragma unroll
            for (int b = 0; b < 2; ++b)
#pragma unroll
                for (int m = 0; m < 4; ++m)
#pragma unroll
                    for (int n = 0; n < 2; ++n) acc[a][b][m][n] = (f32x4){0.f, 0.f, 0.f, 0.f};
        if constexpr (epi_prefetch<Epi>::value) E.prefetch(nxt, (ui + 1) & 1, wid, lane);
        cur = nxt; cA = nA; cB = nB; nt = cur.nkt; ++ui;
        if constexpr (ALIGN_EPI) { if (wr == 1) PG8_BAR; }
    }
    PG8_WAIT_V(0);
    if constexpr (!ALIGN_EPI) { if (wr == 0) PG8_BAR; }
    PG8_BAR;
#ifdef PROBE_G
    if (tid == 0) *(volatile LAS unsigned long long*)(lds + MISC_OFF + 32) = pe_tot;
#endif
#undef PG8_SA
#undef PG8_SB
#undef PG8_STAGE
#undef PG8_LDA
#undef PG8_LDB
#undef PG8_MMA
#undef PG8_WAIT_V
#undef PG8_WAIT_L
#undef PG8_BAR
#undef PG8_SCHED
}

struct EpiF32 {
    static constexpr bool PERM = false;
    float* C; int ldc; float* Cp; int pm_split; size_t part_stride;
    __device__ __forceinline__ void operator()(const Acc& acc, const Unit& u, int wr, int wc, int fr, int fq) const {
        const int col0 = u.pn * BM + wc * 32 + 4 * fq;
        float* base = C; int row0 = u.pm * BM + wr * 64 + fr;
        if (u.part > 0) { base = Cp + (size_t)(u.part - 1) * part_stride; row0 -= pm_split * BM; }
#pragma unroll
        for (int ai = 0; ai < 2; ++ai)
#pragma unroll
            for (int m = 0; m < 4; ++m) { float* rowp = base + (size_t)(row0 + ai * HALF + m * 16) * ldc + col0;
#pragma unroll
                for (int bj = 0; bj < 2; ++bj)
#pragma unroll
                    for (int n = 0; n < 2; ++n) *(f32x4*)(rowp + bj * HALF + n * 16) = acc[ai][bj][m][n]; }
    }
};
struct EpiY {
    static constexpr bool PERM = true;
    bf16_t* Y; float* Cp; int pm_split; size_t part_stride;
    __device__ __forceinline__ void operator()(const Acc& acc, const Unit& u, int wr, int wc, int fr, int fq) const {
        const int row0 = u.pm * BM + wr * 64 + fr, col0 = u.pn * BM + wc * 32 + 8 * fq;
        if (u.part > 0) {
            bf16_t* base = (bf16_t*)Cp + (size_t)(u.part - 1) * part_stride;
#pragma unroll
            for (int ai = 0; ai < 2; ++ai)
#pragma unroll
                for (int m = 0; m < 4; ++m) { bf16_t* rowp = base + (size_t)(row0 - pm_split * BM + ai * HALF + m * 16) * D + col0;
#pragma unroll
                    for (int bj = 0; bj < 2; ++bj) { const f32x4 v0 = acc[ai][bj][m][0], v1 = acc[ai][bj][m][1];
                        u32x4 w; w.x = cvt_pk_bf16(v0[0], v0[1]); w.y = cvt_pk_bf16(v0[2], v0[3]); w.z = cvt_pk_bf16(v1[0], v1[1]); w.w = cvt_pk_bf16(v1[2], v1[3]);
                        *(u32x4*)(rowp + bj * HALF) = w; } }
        } else if (u.part == 0) {
#pragma unroll
            for (int ai = 0; ai < 2; ++ai)
#pragma unroll
                for (int m = 0; m < 4; ++m) { bf16_t* rowp = Y + (size_t)(row0 + ai * HALF + m * 16) * D + col0;
#pragma unroll
                    for (int bj = 0; bj < 2; ++bj) { const f32x4 v0 = acc[ai][bj][m][0], v1 = acc[ai][bj][m][1];
                        u32x4 w; w.x = cvt_pk_bf16(v0[0], v0[1]); w.y = cvt_pk_bf16(v0[2], v0[3]); w.z = cvt_pk_bf16(v1[0], v1[1]); w.w = cvt_pk_bf16(v1[2], v1[3]);
                        *(u32x4*)(rowp + bj * HALF) = w; } }
        } else {
            float* base = Cp + (size_t)(u.part - 1) * part_stride;
#pragma unroll
            for (int ai = 0; ai < 2; ++ai)
#pragma unroll
                for (int m = 0; m < 4; ++m) { float* rowp = base + (size_t)(row0 - pm_split * BM + ai * HALF + m * 16) * D + col0;
#pragma unroll
                    for (int bj = 0; bj < 2; ++bj) { *(f32x4*)(rowp + bj * HALF) = acc[ai][bj][m][0]; *(f32x4*)(rowp + bj * HALF + 4) = acc[ai][bj][m][1]; } }
        }
    }
};
struct EpiAct {
    static constexpr bool PERM = true;
    bf16_t* ACT; bf16_t* EDGE; const float* cw; LAS float* hl;
    static constexpr bool PREFETCH = true;
    static constexpr bool APERM = true;
    __device__ __forceinline__ void prefetch(const Unit& u, int slot, int wid, int lane) const {
        if (wid < 3) __builtin_amdgcn_global_load_lds((const unsigned*)(cw + (size_t)wid * UFF + (lane >> 5) * DFF + u.pn * 128 + 4 * (lane & 31)), (LAS unsigned*)(hl + 2048 + slot * 768 + wid * 256), 16, 0, 0);
    }
    __device__ __forceinline__ void run(const Acc& acc, const Unit& u, int wr, int wc, int fr, int fq, int slot) const {
        const LAS float* wl = hl + 2048 + slot * 768;
        const int ch0 = u.pn * 128 + wc * 32 + 8 * fq;
        const int colh = wc * 32 + 8 * fq;
#pragma unroll
        for (int ai = 0; ai < 2; ++ai) { const int blk = ai * 2 + wr;
            if (fr == 0) {
#pragma unroll
                for (int bj = 0; bj < 2; ++bj)
#pragma unroll
                    for (int n = 0; n < 2; ++n) *(LAS f32x4*)(hl + (blk * 2 + 0) * 256 + bj * 128 + colh + 4 * n) = acc[ai][bj][0][n]; }
            if (fr == 15) {
#pragma unroll
                for (int bj = 0; bj < 2; ++bj)
#pragma unroll
                    for (int n = 0; n < 2; ++n) *(LAS f32x4*)(hl + (blk * 2 + 1) * 256 + bj * 128 + colh + 4 * n) = acc[ai][bj][3][n]; } }
        asm volatile("s_waitcnt lgkmcnt(0)" ::: "memory"); __builtin_amdgcn_s_barrier(); asm volatile("" ::: "memory");
        const int rowt = u.pm * BM;
#pragma unroll
        for (int ai = 0; ai < 2; ++ai) { const int blk = ai * 2 + wr;
            float o[4][8];
#pragma unroll
            for (int n = 0; n < 2; ++n) {
#pragma unroll
                for (int bj = 0; bj < 2; ++bj) {
                    f32x4 W[3];
#pragma unroll
                    for (int k = 0; k < 3; ++k) W[k] = *(const LAS f32x4*)(wl + k * 256 + bj * 128 + colh + 4 * n);
                    const f32x4 HU = (blk > 0) ? *(const LAS f32x4*)(hl + ((blk - 1) * 2 + 1) * 256 + bj * 128 + colh + 4 * n) : (f32x4){0.f, 0.f, 0.f, 0.f};
                    const f32x4 HD = (blk < 3) ? *(const LAS f32x4*)(hl + ((blk + 1) * 2 + 0) * 256 + bj * 128 + colh + 4 * n) : (f32x4){0.f, 0.f, 0.f, 0.f};
#pragma unroll
                    for (int e = 0; e < 4; ++e) {
                        const float w0 = W[0][e], w1 = W[1][e], w2 = W[2][e];
                        const float v0 = acc[ai][bj][0][n][e], v1 = acc[ai][bj][1][n][e], v2 = acc[ai][bj][2][n][e], v3 = acc[ai][bj][3][n][e];
                        const float up0 = __int_as_float(__builtin_amdgcn_update_dpp(__float_as_int(HU[e]), __float_as_int(v3), 0x111, 0xf, 0xf, false));
                        const float dn3 = __int_as_float(__builtin_amdgcn_update_dpp(__float_as_int(HD[e]), __float_as_int(v0), 0x101, 0xf, 0xf, false));
                        float r_[4];
                        r_[0] = w0 * up0 + w1 * v0 + w2 * v1; r_[1] = w0 * v0 + w1 * v1 + w2 * v2; r_[2] = w0 * v1 + w1 * v2 + w2 * v3; r_[3] = w0 * v2 + w1 * v3 + w2 * dn3;
#pragma unroll
                        for (int m = 0; m < 4; ++m) { if (bj == 0) o[m][4 * n + e] = r_[m] * __builtin_amdgcn_rcpf(1.f + __expf(-r_[m])); else o[m][4 * n + e] *= r_[m]; }
                    }
                }
                __builtin_amdgcn_sched_barrier(0);
            }
#pragma unroll
            for (int m = 0; m < 4; ++m) { const int rl = ai * HALF + wr * 64 + 4 * fr + m;
                if (rl != 0 && rl != 255) *(u32x4*)(ACT + (size_t)(rowt + rl) * DFF + ch0) = pack8(o[m]); }
            __builtin_amdgcn_sched_barrier(0);
        }
#pragma unroll
        for (int ai = 0; ai < 2; ++ai) {
#pragma unroll
            for (int m = 0; m < 4; ++m) { const int rl = ai * HALF + wr * 64 + 4 * fr + m;
                const int ek = (rl == 0) ? 0 : (rl == 1) ? 1 : (rl == 254) ? 2 : (rl == 255) ? 3 : -1;
                if (ek >= 0) {
#pragma unroll
                    for (int bj = 0; bj < 2; ++bj) { const f32x4 v0 = acc[ai][bj][m][0], v1 = acc[ai][bj][m][1];
                        u32x4 w; w.x = cvt_pk_bf16(v0[0], v0[1]); w.y = cvt_pk_bf16(v0[2], v0[3]); w.z = cvt_pk_bf16(v1[0], v1[1]); w.w = cvt_pk_bf16(v1[2], v1[3]);
                        *(u32x4*)(EDGE + ((size_t)u.pm * 4 + ek) * UFF + bj * DFF + ch0) = w; } }
            }
        }
        asm volatile("s_waitcnt lgkmcnt(0)" ::: "memory"); __builtin_amdgcn_s_barrier(); asm volatile("" ::: "memory");
    }
};
struct EpiBf16 {
    static constexpr bool PERM = true;
    bf16_t* O; int ldc;
    __device__ __forceinline__ void operator()(const Acc& acc, const Unit& u, int wr, int wc, int fr, int fq) const {
        const int row0 = u.pm * BM + wr * 64 + fr, col0 = u.pn * BM + wc * 32 + 8 * fq;
#pragma unroll
        for (int ai = 0; ai < 2; ++ai)
#pragma unroll
            for (int m = 0; m < 4; ++m) { bf16_t* rowp = O + (size_t)(row0 + ai * HALF + m * 16) * ldc + col0;
#pragma unroll
                for (int bj = 0; bj < 2; ++bj) { const f32x4 v0 = acc[ai][bj][m][0], v1 = acc[ai][bj][m][1];
                    u32x4 w; w.x = cvt_pk_bf16(v0[0], v0[1]); w.y = cvt_pk_bf16(v0[2], v0[3]); w.z = cvt_pk_bf16(v1[0], v1[1]); w.w = cvt_pk_bf16(v1[2], v1[3]);
                    *(u32x4*)(rowp + bj * HALF) = w; } }
    }
};
struct EpiZ {
    static constexpr bool PERM = true;
    bf16_t* Z; float* rsq;
    __device__ __forceinline__ void operator()(const Acc& acc, const Unit& u, int wr, int wc, int fr, int fq) const {
        const int row0 = u.pm * BM + wr * 64 + fr, col0 = u.pn * BM + wc * 32 + 8 * fq;
#pragma unroll
        for (int ai = 0; ai < 2; ++ai)
#pragma unroll
            for (int m = 0; m < 4; ++m) { bf16_t* rowp = Z + (size_t)(row0 + ai * HALF + m * 16) * ZLD + col0;
#pragma unroll
                for (int bj = 0; bj < 2; ++bj) { const f32x4 v0 = acc[ai][bj][m][0], v1 = acc[ai][bj][m][1];
                    u32x4 w; w.x = cvt_pk_bf16(v0[0], v0[1]); w.y = cvt_pk_bf16(v0[2], v0[3]); w.z = cvt_pk_bf16(v1[0], v1[1]); w.w = cvt_pk_bf16(v1[2], v1[3]);
                    *(u32x4*)(rowp + bj * HALF) = w; } }
        if (u.pn >= 8 && u.pn <= 10) {
#pragma unroll
            for (int bj = 0; bj < 2; ++bj) { const int cb = u.pn * BM + bj * HALF + wc * 32;
                const int region = (cb >= Z_CQ && cb < Z_CKV) ? 0 : ((cb >= Z_CKV && cb < Z_KR) ? 1 : -1);
                if (region >= 0) {
#pragma unroll
                    for (int ai = 0; ai < 2; ++ai)
#pragma unroll
                        for (int m = 0; m < 4; ++m) { const f32x4 v0 = acc[ai][bj][m][0], v1 = acc[ai][bj][m][1];
                            float s = (v0[0] * v0[0] + v0[1] * v0[1]) + (v0[2] * v0[2] + v0[3] * v0[3]) + (v1[0] * v1[0] + v1[1] * v1[1]) + (v1[2] * v1[2] + v1[3] * v1[3]);
                            s += sx(s, 16, fq * 16 + fr); s += sx(s, 32, fq * 16 + fr);
                            if (fq == 0) atomicAdd(rsq + (size_t)(row0 + ai * HALF + m * 16) * 2 + region, s); } } }
        }
    }
};
struct EpiQ {
    static constexpr bool PERM = true;
    bf16_t* QM; const float* rsq; const float2* cs;
    __device__ __forceinline__ void operator()(const Acc& acc, const Unit& u, int wr, int wc, int fr, int fq) const {
        const int row0 = u.pm * BM + wr * 64 + fr;
        float rsv[8];
#pragma unroll
        for (int i = 0; i < 8; ++i) rsv[i] = rsq[(size_t)(row0 + (i >> 2) * HALF + (i & 3) * 16) * 2];
        if (u.pn < 2) {
#pragma unroll
            for (int ai = 0; ai < 2; ++ai)
#pragma unroll
                for (int m = 0; m < 4; ++m) { const int row = row0 + ai * HALF + m * 16; const float rs = __builtin_amdgcn_rsqf(rsv[ai * 4 + m] * (1.f / 384.f) + EPS);
#pragma unroll
                    for (int bj = 0; bj < 2; ++bj) { const f32x4 v0 = acc[ai][bj][m][0] * rs, v1 = acc[ai][bj][m][1] * rs;
                        u32x4 w; w.x = cvt_pk_bf16(v0[0], v0[1]); w.y = cvt_pk_bf16(v0[2], v0[3]); w.z = cvt_pk_bf16(v1[0], v1[1]); w.w = cvt_pk_bf16(v1[2], v1[3]);
                        *(u32x4*)(QM + (size_t)row * 768 + (2 * u.pn + bj) * 192 + wc * 32 + 8 * fq) = w; }
                    asm volatile("" ::: "memory"); }
        } else {
            const bool rope = (u.pm < RX / BM);
            f32x4 cb[2][4];
            if (rope) { const f32x4* cp = (const f32x4*)(cs + (row0 % SEQ) * 32 + 8 * fq);
#pragma unroll
                for (int q = 0; q < 4; ++q) cb[0][q] = cp[q]; }
#pragma unroll
            for (int it = 0; it < 8; ++it) { const int ai = it >> 2, m = it & 3; const int row = row0 + ai * HALF + m * 16; const float rs = __builtin_amdgcn_rsqf(rsv[it] * (1.f / 384.f) + EPS);
                if (rope && it < 7) { const int rown = row0 + ((it + 1) >> 2) * HALF + ((it + 1) & 3) * 16; const f32x4* cp = (const f32x4*)(cs + (rown % SEQ) * 32 + 8 * fq);
#pragma unroll
                    for (int q = 0; q < 4; ++q) cb[(it + 1) & 1][q] = cp[q]; }
                float x1[8], x2[8], o1[8], o2[8];
#pragma unroll
                for (int e = 0; e < 4; ++e) { x1[e] = acc[ai][0][m][0][e] * rs; x1[4 + e] = acc[ai][0][m][1][e] * rs; x2[e] = acc[ai][1][m][0][e] * rs; x2[4 + e] = acc[ai][1][m][1][e] * rs; }
                if (rope) {
#pragma unroll
                    for (int q = 0; q < 4; ++q) { const f32x4 c2 = cb[it & 1][q];
                        o1[2 * q] = x1[2 * q] * c2.x - x2[2 * q] * c2.y; o2[2 * q] = x1[2 * q] * c2.y + x2[2 * q] * c2.x;
                        o1[2 * q + 1] = x1[2 * q + 1] * c2.z - x2[2 * q + 1] * c2.w; o2[2 * q + 1] = x1[2 * q + 1] * c2.w + x2[2 * q + 1] * c2.z; }
                } else {
#pragma unroll
                    for (int e = 0; e < 8; ++e) { o1[e] = x1[e]; o2[e] = x2[e]; } }
                bf16_t* dst = QM + (size_t)row * 768 + wc * 192 + 128 + 8 * fq;
                st16(dst, pack8(o1)); st16(dst + 32, pack8(o2));
                __builtin_amdgcn_sched_barrier(0); }
        }
    }
};
struct EpiKV {
    static constexpr bool PERM = true;
    bf16_t* KN; bf16_t* VM; const float* rsq;
    __device__ __forceinline__ void operator()(const Acc& acc, const Unit& u, int wr, int wc, int fr, int fq) const {
        const int row0 = u.pm * BM + wr * 64 + fr;
        float rsv[8];
#pragma unroll
        for (int i = 0; i < 8; ++i) rsv[i] = rsq[(size_t)(row0 + (i >> 2) * HALF + (i & 3) * 16) * 2 + 1];
#pragma unroll
        for (int ai = 0; ai < 2; ++ai)
#pragma unroll
            for (int m = 0; m < 4; ++m) { const int row = row0 + ai * HALF + m * 16; const float rs = __builtin_amdgcn_rsqf(rsv[ai * 4 + m] * (1.f / 256.f) + EPS);
#pragma unroll
                for (int bj = 0; bj < 2; ++bj) { const f32x4 v0 = acc[ai][bj][m][0] * rs, v1 = acc[ai][bj][m][1] * rs;
                    u32x4 w; w.x = cvt_pk_bf16(v0[0], v0[1]); w.y = cvt_pk_bf16(v0[2], v0[3]); w.z = cvt_pk_bf16(v1[0], v1[1]); w.w = cvt_pk_bf16(v1[2], v1[3]);
                    *(u32x4*)((bj ? VM : KN) + (size_t)row * 512 + u.pn * 128 + wc * 32 + 8 * fq) = w; }
                asm volatile("" ::: "memory"); }
    }
};
template <class Epi>
__device__ __forceinline__ void run(LAS unsigned char* lds, const Gemm g, int nM, int nN, int G, int c, const Epi& E, int tid, int nMs = 0, int ksplit = 1) {
    TileOrder S; S.init(nM, nN, G, c, g.K / BK, nMs, ksplit);
    gemm_phase<Epi, TileOrder, true>(lds, g, S, E, tid);
}
}


namespace att {
constexpr int SHM_V = 64 * 128 * 2;
#define SBAR() __builtin_amdgcn_sched_barrier(0)
__device__ __forceinline__ int crow(int r, int hi) { return (r & 3) + 8 * (r >> 2) + 4 * hi; }
__device__ __forceinline__ void partialSM(f32x16& p0, f32x16& p1, float& m_reg, float& mn, float& alpha, float C, float thr_raw) {
    float pmax = p0[0];
#pragma unroll
    for (int r = 1; r < 16; ++r) pmax = fmaxf(pmax, p0[r]);
#pragma unroll
    for (int r = 0; r < 16; ++r) pmax = fmaxf(pmax, p1[r]);
    { auto rr = __builtin_amdgcn_permlane32_swap(__float_as_uint(pmax), __float_as_uint(pmax), false, false); pmax = fmaxf(__uint_as_float(rr[0]), __uint_as_float(rr[1])); }
    if (__builtin_expect(__all(pmax - m_reg <= thr_raw), 1)) { mn = m_reg; alpha = 1.f; }
    else { mn = fmaxf(m_reg, pmax); alpha = __builtin_amdgcn_exp2f((m_reg - mn) * C); m_reg = mn; }
    const float mnC = -mn * C;
#pragma unroll
    for (int r = 0; r < 16; ++r) p0[r] = fmaf(p0[r], C, mnC);
#pragma unroll
    for (int r = 0; r < 16; ++r) p1[r] = fmaf(p1[r], C, mnC);
#pragma unroll
    for (int r = 0; r < 16; ++r) p0[r] = __builtin_amdgcn_exp2f(p0[r]);
}
__device__ __forceinline__ void finishSM(f32x16& p0, f32x16& p1, float alpha, float& l_reg, bf16x8& pa0, bf16x8& pa1, bf16x8& pa2, bf16x8& pa3) {
#pragma unroll
    for (int r = 0; r < 16; ++r) p1[r] = __builtin_amdgcn_exp2f(p1[r]);
    float ps = 0.f;
#pragma unroll
    for (int r = 0; r < 16; ++r) ps += p0[r];
#pragma unroll
    for (int r = 0; r < 16; ++r) ps += p1[r];
    { auto rr = __builtin_amdgcn_permlane32_swap(__float_as_uint(ps), __float_as_uint(ps), false, false); ps = __uint_as_float(rr[0]) + __uint_as_float(rr[1]); }
    l_reg = l_reg * alpha + ps;
#define PK4(P_, BASE, OUT) do { unsigned a0 = cvt_pk_bf16(P_[BASE + 0], P_[BASE + 1]), a1 = cvt_pk_bf16(P_[BASE + 2], P_[BASE + 3]);   \
    unsigned b0 = cvt_pk_bf16(P_[BASE + 4], P_[BASE + 5]), b1 = cvt_pk_bf16(P_[BASE + 6], P_[BASE + 7]);                              \
    auto r0 = __builtin_amdgcn_permlane32_swap(a0, b0, false, false); auto r1 = __builtin_amdgcn_permlane32_swap(a1, b1, false, false); \
    u32x4 w = {r0[0], r1[0], r0[1], r1[1]}; OUT = *reinterpret_cast<bf16x8*>(&w); } while (0)
    PK4(p0, 0, pa0); PK4(p0, 8, pa1); PK4(p1, 0, pa2); PK4(p1, 8, pa3);
#undef PK4
}
template <int NDQ> __device__ __forceinline__ int kaddr(int row, int cb) { return row * (32 * NDQ) + (cb ^ (((row >> 1) & 7) << 4)); }
template <int NDQ, int NQR>
__device__ __forceinline__ void qkt(f32x16& p0, f32x16& p1, const char* Ks, const bf16x8* qr, const char* ql, int r32, int hi) {
    p0 = f32x16{}; p1 = f32x16{};
#pragma unroll
    for (int d0 = 0; d0 < NDQ; ++d0) { const int cb = d0 * 32 + hi * 16;
        const bf16x8 b0 = *reinterpret_cast<const bf16x8*>(Ks + kaddr<NDQ>(r32, cb));
        const bf16x8 b1 = *reinterpret_cast<const bf16x8*>(Ks + kaddr<NDQ>(32 + r32, cb));
        bf16x8 q; if (d0 < NQR) q = qr[d0]; else q = *reinterpret_cast<const bf16x8*>(ql + (d0 - NQR) * 1024);
        p0 = __builtin_amdgcn_mfma_f32_32x32x16_bf16(b0, q, p0, 0, 0, 0);
        p1 = __builtin_amdgcn_mfma_f32_32x32x16_bf16(b1, q, p1, 0, 0, 0); }
}
__device__ __forceinline__ int v_st(int k, int c) { const int kk = (k & ~0xC) | ((k & 4) << 1) | ((k & 8) >> 1); return ((kk >> 3) * 4 + (c >> 5)) * 512 + ((kk & 7) * 32 + (c & 31)) * 2; }
__device__ __forceinline__ int v_rd_base(int lane) { return ((lane & 3) << 3) | (((lane >> 2) & 3) << 6) | (((lane >> 4) & 1) << 5) | (((lane >> 5) & 1) << 8); }
constexpr int v_rd_off(int d0, int ks, int half) { return d0 * 512 + ks * 4096 + half * 2048; }
template <int OFF> __device__ __forceinline__ s16x4 tr_read(int vb) { s16x4 r; asm volatile("ds_read_b64_tr_b16 %0, %1 offset:%2" : "=&v"(r) : "v"(vb), "i"(OFF) : "memory"); return r; }
template <int D0> __device__ __forceinline__ void pv_one(f32x16& od, int vb, bf16x8 pa0, bf16x8 pa1, bf16x8 pa2, bf16x8 pa3) {
    const s16x4 l0 = tr_read<v_rd_off(D0, 0, 0)>(vb), h0 = tr_read<v_rd_off(D0, 0, 1)>(vb), l1 = tr_read<v_rd_off(D0, 1, 0)>(vb), h1 = tr_read<v_rd_off(D0, 1, 1)>(vb);
    const s16x4 l2 = tr_read<v_rd_off(D0, 2, 0)>(vb), h2 = tr_read<v_rd_off(D0, 2, 1)>(vb), l3 = tr_read<v_rd_off(D0, 3, 0)>(vb), h3 = tr_read<v_rd_off(D0, 3, 1)>(vb);
    asm volatile("s_waitcnt lgkmcnt(0)" ::: "memory"); SBAR();
#define PKV(L_, H_) (bf16x8){L_[0], L_[1], L_[2], L_[3], H_[0], H_[1], H_[2], H_[3]}
    od = __builtin_amdgcn_mfma_f32_32x32x16_bf16(pa0, PKV(l0, h0), od, 0, 0, 0);
    od = __builtin_amdgcn_mfma_f32_32x32x16_bf16(pa1, PKV(l1, h1), od, 0, 0, 0);
    od = __builtin_amdgcn_mfma_f32_32x32x16_bf16(pa2, PKV(l2, h2), od, 0, 0, 0);
    od = __builtin_amdgcn_mfma_f32_32x32x16_bf16(pa3, PKV(l3, h3), od, 0, 0, 0);
#undef PKV
}
__device__ __forceinline__ void pv_d0(f32x16* o, int vb, bf16x8 pa0, bf16x8 pa1, bf16x8 pa2, bf16x8 pa3) {
    pv_one<0>(o[0], vb, pa0, pa1, pa2, pa3); pv_one<1>(o[1], vb, pa0, pa1, pa2, pa3); pv_one<2>(o[2], vb, pa0, pa1, pa2, pa3); pv_one<3>(o[3], vb, pa0, pa1, pa2, pa3);
}
template <int NDQ, int SD>
__device__ __forceinline__ void attn_body(const bf16_t* __restrict__ Qw, int ldq, const bf16_t* __restrict__ Kg, int ldk, const bf16_t* __restrict__ Krg, const bf16_t* __restrict__ Vg, int ldv,
                                          int xrow0, int nxt, int crow0, int NT, float C, char* lds, int tid, f32x16 (&o)[4], float (&rli)[16]) {
    constexpr int SHM_K = 64 * 32 * NDQ;
    const int wid = tid >> 6, lane = tid & 63, r32 = lane & 31, hi = lane >> 5;
    char* V_lds = lds; char* K_lds = lds + 2 * SHM_V;
    float* wsf = (float*)(lds + 2 * SHM_V + 2 * SHM_K) + wid * 64; float* li_l = wsf; float* al_l = wsf + 32;
    const float thr_raw = 8.f * 1.4426950408889634f / C;
    constexpr int NQR = (NDQ > 8) ? 6 : NDQ;
    char* ql = lds + 2 * SHM_V + 2 * SHM_K + 2048 + wid * ((NDQ - NQR) * 1024) + lane * 16;
    float m_reg = -1e30f, l_reg = 0.f; bf16x8 qr[NQR];
#pragma unroll
    for (int d0 = 0; d0 < 4; ++d0) o[d0] = f32x16{};
    const bf16_t* Ql = Qw + (size_t)r32 * ldq + hi * 8;
    __syncthreads();
#pragma unroll
    for (int d0 = 0; d0 < NDQ; ++d0) { const bf16x8 q = *reinterpret_cast<const bf16x8*>(Ql + d0 * 16); if (d0 < NQR) qr[d0] = q; else *reinterpret_cast<bf16x8*>(ql + (d0 - NQR) * 1024) = q; }
    const int sr = tid >> 4, sc = (tid & 15) * 8, vst0 = v_st(sr, sc), vst1 = v_st(32 + sr, sc);
    const int k8r = tid >> 3, k8c = (tid & 7) * 8;
    const int vb0 = (int)(uintptr_t)V_lds + v_rd_base(lane);
    bf16x8 vsA0, vsA1, ksA0, ksA1, ksA2, vsB0, vsB1, ksB0, ksB1, ksB2;
#define KROW(j) ((j) < nxt ? xrow0 + 64 * (j) : crow0 + 64 * ((j) - nxt))
#define SLOAD(S_, j) do { const int row0_ = KROW(j); \
        vs##S_##0 = *reinterpret_cast<const bf16x8*>(Vg + (size_t)(row0_ + sr) * ldv + sc); vs##S_##1 = *reinterpret_cast<const bf16x8*>(Vg + (size_t)(row0_ + 32 + sr) * ldv + sc); \
        if constexpr (NDQ == 4) { ks##S_##0 = *reinterpret_cast<const bf16x8*>(Kg + (size_t)(row0_ + k8r) * ldk + k8c); } \
        else { ks##S_##0 = *reinterpret_cast<const bf16x8*>(Kg + (size_t)(row0_ + sr) * ldk + sc); ks##S_##1 = *reinterpret_cast<const bf16x8*>(Kg + (size_t)(row0_ + 32 + sr) * ldk + sc); \
               ks##S_##2 = *reinterpret_cast<const bf16x8*>(Krg + (size_t)(row0_ + k8r) * 64 + k8c); } } while (0)
#define SWRITE(b, S_) do { *(bf16x8*)(V_lds + (b) * SHM_V + vst0) = vs##S_##0; *(bf16x8*)(V_lds + (b) * SHM_V + vst1) = vs##S_##1; \
        if constexpr (NDQ == 4) { *(bf16x8*)(K_lds + (b) * SHM_K + kaddr<NDQ>(k8r, k8c * 2)) = ks##S_##0; } \
        else { *(bf16x8*)(K_lds + (b) * SHM_K + kaddr<NDQ>(sr, sc * 2)) = ks##S_##0; *(bf16x8*)(K_lds + (b) * SHM_K + kaddr<NDQ>(32 + sr, sc * 2)) = ks##S_##1; \
               *(bf16x8*)(K_lds + (b) * SHM_K + kaddr<NDQ>(k8r, 256 + k8c * 2)) = ks##S_##2; } } while (0)
#define SLOAD_B(j) do { if constexpr (SD == 2) SLOAD(B, j); else SLOAD(A, j); } while (0)
#define SWRITE_B(b) do { if constexpr (SD == 2) SWRITE(b, B); else SWRITE(b, A); } while (0)
#define SWAIT() do { if constexpr (SD == 1) asm volatile("s_waitcnt vmcnt(0)" ::: "memory"); else if constexpr (NDQ == 4) asm volatile("s_waitcnt vmcnt(3)" ::: "memory"); else asm volatile("s_waitcnt vmcnt(5)" ::: "memory"); } while (0)
#define RESC(a) do { if (__any((a) < 1.f)) { if (hi == 0) al_l[r32] = (a); asm volatile("s_waitcnt lgkmcnt(0)" ::: "memory"); \
        _Pragma("unroll") for (int d = 0; d < 4; ++d) _Pragma("unroll") for (int r = 0; r < 16; ++r) o[d][r] *= al_l[crow(r, hi)]; } } while (0)
    f32x16 pA0, pA1, pB0, pB1; float mnA, mnB, alA, alB; bf16x8 pa0, pa1, pa2, pa3;
    SLOAD(A, 0); asm volatile("s_waitcnt vmcnt(0)" ::: "memory"); SWRITE(0, A); __syncthreads();
    qkt<NDQ, NQR>(pA0, pA1, K_lds, qr, ql, r32, hi); partialSM(pA0, pA1, m_reg, mnA, alA, C, thr_raw);
    SLOAD_B(1); if constexpr (SD == 2) { if (2 < NT) SLOAD(A, 2); }
    SWAIT(); SWRITE_B(1); __syncthreads();
    for (int j = 1; j + 1 < NT; j += 2) {
        SBAR(); qkt<NDQ, NQR>(pB0, pB1, K_lds + SHM_K, qr, ql, r32, hi);
        finishSM(pA0, pA1, alA, l_reg, pa0, pa1, pa2, pa3); SBAR();
        SLOAD_B(j + SD); SBAR();
        pv_d0(o, vb0, pa0, pa1, pa2, pa3); partialSM(pB0, pB1, m_reg, mnB, alB, C, thr_raw);
        __syncthreads(); SWAIT(); SWRITE(0, A);
        RESC(alB); __syncthreads();
        SBAR(); qkt<NDQ, NQR>(pA0, pA1, K_lds, qr, ql, r32, hi);
        finishSM(pB0, pB1, alB, l_reg, pa0, pa1, pa2, pa3); SBAR();
        if (SD == 1 || j + 3 < NT) SLOAD(A, j + 1 + SD); SBAR();
        pv_d0(o, vb0 + SHM_V, pa0, pa1, pa2, pa3); partialSM(pA0, pA1, m_reg, mnA, alA, C, thr_raw);
        __syncthreads(); SWAIT(); SWRITE_B(1);
        RESC(alA); __syncthreads();
    }
    SBAR(); qkt<NDQ, NQR>(pB0, pB1, K_lds + SHM_K, qr, ql, r32, hi);
    finishSM(pA0, pA1, alA, l_reg, pa0, pa1, pa2, pa3); SBAR();
    pv_d0(o, vb0, pa0, pa1, pa2, pa3); partialSM(pB0, pB1, m_reg, mnB, alB, C, thr_raw);
    __syncthreads(); RESC(alB);
    finishSM(pB0, pB1, alB, l_reg, pa0, pa1, pa2, pa3); SBAR();
    pv_d0(o, vb0 + SHM_V, pa0, pa1, pa2, pa3);
    if (hi == 0) li_l[r32] = l_reg; asm volatile("s_waitcnt lgkmcnt(0)" ::: "memory");
#pragma unroll
    for (int r = 0; r < 16; ++r) rli[r] = __builtin_amdgcn_rcpf(li_l[crow(r, hi)]);
#undef KROW
#undef SLOAD
#undef SWRITE
#undef SWAIT
#undef SLOAD_B
#undef SWRITE_B
#undef RESC
}
__device__ __forceinline__ void unit_diff(KP kp, unsigned char* ws, int l, int b, int h, int qrow0, int isc, char* lds, int tid, float* scratch) {
    const int wid = tid >> 6, lane = tid & 63, r32 = lane & 31, hi = lane >> 5;
    const bf16_t* Z = (const bf16_t*)(ws + WS_Z); bf16_t* MIX = (bf16_t*)(ws + WS_MIX);
    const int xrow0 = b * SEQ, nxt = isc ? 0 : SEQ / 64, crow0 = RX + b * CTX, NT = nxt + CTX / 64;
    const float C = 0.125f * 1.4426950408889634f;
    const float lam_init = (l == 0) ? 0.2f : 0.35550906759096907f;
    float* myscr = scratch + (size_t)wid * 64 * 64 + lane;
    f32x16 o[4]; float rli[16];
    attn_body<4, 2>(Z + (size_t)(qrow0 + wid * 32) * ZLD + Z_Q + h * 128, ZLD, Z + Z_K + h * 128, ZLD, nullptr, Z + Z_V + h * 128, ZLD, xrow0, nxt, crow0, NT, C, lds, tid, o, rli);
#pragma unroll
    for (int d0 = 0; d0 < 4; ++d0)
#pragma unroll
        for (int r = 0; r < 16; ++r) myscr[(d0 * 16 + r) * 64] = o[d0][r] * rli[r];
    attn_body<4, 2>(Z + (size_t)(qrow0 + wid * 32) * ZLD + Z_Q + h * 128 + 64, ZLD, Z + Z_K + h * 128 + 64, ZLD, nullptr, Z + Z_V + h * 128, ZLD, xrow0, nxt, crow0, NT, C, lds, tid, o, rli);
    size_t so = 0; asm volatile("" : "+v"(so) :: "memory"); const float* rdscr = myscr + so;
    const float* lamp = kp->in[IN_DIFFLAM] + l * 256;
    float l1 = lamp[lane] * lamp[64 + lane], l2 = lamp[128 + lane] * lamp[192 + lane]; l1 = wsum(l1, lane); l2 = wsum(l2, lane);
    const float lam = expf(l1) - expf(l2) + lam_init;
    const float* subg = kp->in[IN_SUBLN] + l * 128; const float post = 1.f - lam_init;
    float sg[4];
#pragma unroll
    for (int d0 = 0; d0 < 4; ++d0) sg[d0] = subg[d0 * 32 + r32] * post;
#pragma unroll
    for (int r = 0; r < 16; ++r) {
        float dv[4], ss = 0.f;
#pragma unroll
        for (int d0 = 0; d0 < 4; ++d0) { dv[d0] = rdscr[(d0 * 16 + r) * 64] - lam * (o[d0][r] * rli[r]); ss += dv[d0] * dv[d0]; }
        ss += sx(ss, 1, lane); ss += sx(ss, 2, lane); ss += sx(ss, 4, lane); ss += sx(ss, 8, lane); ss += sx(ss, 16, lane);
        const float rs = 1.0f / sqrtf(ss * (1.f / 128.f) + EPS);
        bf16_t* mp = MIX + (size_t)(qrow0 + wid * 32 + crow(r, hi)) * D + 512 + h * 128 + r32;
#pragma unroll
        for (int d0 = 0; d0 < 4; ++d0) mp[d0 * 32] = f2bf(dv[d0] * rs * sg[d0]);
    }
}
__device__ __forceinline__ void unit_mla(unsigned char* ws, int b, int h, int qrow0, int isc, char* lds, int tid) {
    const int wid = tid >> 6, lane = tid & 63, r32 = lane & 31, hi = lane >> 5;
    const bf16_t* QM = (const bf16_t*)(ws + WS_QM); const bf16_t* KN = (const bf16_t*)(ws + WS_KN); const bf16_t* KR = (const bf16_t*)(ws + WS_KR); const bf16_t* VM = (const bf16_t*)(ws + WS_VM);
    bf16_t* MIX = (bf16_t*)(ws + WS_MIX);
    const int xrow0 = b * SEQ, nxt = isc ? 0 : SEQ / 64, crow0 = RX + b * CTX, NT = nxt + CTX / 64;
    const float C = 0.07216878364870322f * 1.4426950408889634f;
    f32x16 o[4]; float rli[16];
    attn_body<12, 1>(QM + (size_t)(qrow0 + wid * 32) * 768 + h * 192, 768, KN + h * 128, 512, KR, VM + h * 128, 512, xrow0, nxt, crow0, NT, C, lds, tid, o, rli);
#pragma unroll
    for (int r = 0; r < 16; ++r) { bf16_t* mp = MIX + (size_t)(qrow0 + wid * 32 + crow(r, hi)) * D + 1024 + h * 128 + r32;
#pragma unroll
        for (int d0 = 0; d0 < 4; ++d0) mp[d0 * 32] = f2bf(o[d0][r] * rli[r]); }
}
__device__ __forceinline__ void phase_attn(KP kp, unsigned char* ws, int tid, int l, char* lds, int vcu, int G, int bx) {
    const int nunits = (l == 0) ? 288 : 256;
    float* scratch = (float*)(ws + WS_O1) + (size_t)bx * (8 * 64 * 64);
    for (int k = 0; k * G < nunits; ++k) {
        const int u = k * G + ((vcu + k * 128) % G); if (u >= nunits) continue;
        int tidu = tid; asm volatile("" : "+v"(tidu));
        size_t wo = 0; asm volatile("" : "+s"(wo)); unsigned char* wsu = kp->ws + wo; int lu = l; asm volatile("" : "+s"(lu));
        const bool isc = (u >= 256); const int v = isc ? (u - 256) & 15 : (u & 127);
        const bool mla = isc ? (u >= 272) : (u >= 128);
        const int b = isc ? (v >> 2) : (v >> 5), h = isc ? (v & 3) : ((v >> 3) & 3), q0 = isc ? RX + b * CTX : b * SEQ + (v & 7) * 256;
        if (!mla) unit_diff(kp, wsu, lu, b, h, q0, isc ? 1 : 0, lds, tidu, scratch);
        else unit_mla(wsu, b, h, q0, isc ? 1 : 0, lds, tidu);
    }
}
#undef SBAR
}


#define XB_TMO      128
#define XB_XCNT(j)  (256  + 64 * (j))
#define XB_XSUB(j)  (1280 + 64 * (j))
#define XB_XGEN(j)  (2304 + 64 * (j))
#define XB_TOP      3328
#define XB_TOPGEN   3392
#define XCD_BAR_WORDS 3456
#define XB_SPIN_CAP (1u << 18)
__device__ __forceinline__ unsigned xb_ld(unsigned* p)              { return __hip_atomic_load(p, __ATOMIC_RELAXED, __HIP_MEMORY_SCOPE_AGENT); }
__device__ __forceinline__ unsigned xb_add(unsigned* p, unsigned v) { return __hip_atomic_fetch_add(p, v, __ATOMIC_RELAXED, __HIP_MEMORY_SCOPE_AGENT); }
__device__ __forceinline__ unsigned xb_xcc_id() { return (unsigned)__builtin_amdgcn_s_getreg((3 << 11) | 20) & 0xFu; }
#define XB_SPIN(cond, bar) do { unsigned _sp = 0; while (cond) { __builtin_amdgcn_s_sleep(1); \
    if ((++_sp & 255u) == 0u) { if (xb_ld(&(bar)[XB_TMO])) break; if (_sp > XB_SPIN_CAP) { atomicAdd(&(bar)[XB_TMO], 1u); break; } } } } while (0)
__device__ __forceinline__ void xcd_barrier_complete(unsigned* bar, unsigned x, unsigned G, unsigned& nloc, unsigned& nx) {
    unsigned sum, cnt, mine, sp = 0u;
    for (;;) {
        sum = 0u; cnt = 0u; mine = 0u;
#pragma unroll
        for (unsigned j = 0; j < 16; ++j) { const unsigned c = xb_ld(&bar[XB_XCNT(j)]); sum += c; cnt += (c > 0u) ? 1u : 0u; mine = (j == x) ? c : mine; }
        if (sum == G) break;
        __builtin_amdgcn_s_sleep(1);
        if ((++sp & 255u) == 0u) { if (xb_ld(&bar[XB_TMO])) break; if (sp > XB_SPIN_CAP) { atomicAdd(&bar[XB_TMO], 1u); break; } }
    }
    nloc = mine > 0u ? mine : 1u; nx = cnt > 0u ? cnt : 1u;
}
__device__ __forceinline__ void xcd_barrier(unsigned* bar, volatile LAS unsigned* st, int tid, unsigned G) {
    asm volatile("s_waitcnt vmcnt(0)" ::: "memory");
    __syncthreads();
    if (tid == 0) {
        const unsigned x = xb_xcc_id();
        __builtin_amdgcn_s_waitcnt(0);
        unsigned nloc = st[0], nx = st[1];
        if (nloc == 0u) { xcd_barrier_complete(bar, x, G, nloc, nx); st[0] = nloc; st[1] = nx; }
        const unsigned qv = xb_ld((unsigned*)((char*)bar + (WS_CVQ - WS_BAR)));
        const unsigned old = xb_add(&bar[XB_XSUB(x)], 1u);
        const unsigned gen = old / nloc;
        if (old + 1u == (gen + 1u) * nloc) {
            __builtin_amdgcn_fence(__ATOMIC_RELEASE, "agent");
            asm volatile("s_waitcnt vmcnt(0)" ::: "memory");
            const unsigned og = xb_add(&bar[XB_TOP], 1u);
            const unsigned tg = og / nx;
            if (og + 1u == (tg + 1u) * nx) xb_add(&bar[XB_TOPGEN], 1u);
            else XB_SPIN(xb_ld(&bar[XB_TOPGEN]) == tg, bar);
            __builtin_amdgcn_fence(__ATOMIC_ACQUIRE, "agent");
            xb_add(&bar[XB_XGEN(x)], 1u);
            asm volatile("s_waitcnt vmcnt(0)" ::: "memory");
        } else {
            XB_SPIN(xb_ld(&bar[XB_XGEN(x)]) == gen, bar);
            __builtin_amdgcn_fence(__ATOMIC_ACQUIRE, "agent");
            asm volatile("s_waitcnt vmcnt(0)" ::: "memory");
        }
        if (qv > st[6]) st[6] = qv;
    }
    __syncthreads();
}

#ifdef PROBE_A
#define PH_STAMP(ph) do { if (bx0 == 0 && tid_ == 0) ((unsigned long long*)(ws + 32768))[ph] = __builtin_amdgcn_s_memrealtime(); } while (0)
#else
#define PH_STAMP(ph) do { } while (0)
#endif
#define PH_VARS(ph) \
    KP kp = kp0; asm volatile("" : "+s"(kp)); \
    int wv_ = wave0; asm volatile("" : "+s"(wv_)); unsigned z_ = 0u; asm volatile("" : "+s"(z_)); int tid_ = wv_ * 64 + (int)__builtin_amdgcn_mbcnt_hi(~0u, __builtin_amdgcn_mbcnt_lo(~0u, z_)); asm volatile("" : "+v"(tid_)); \
    size_t wsoff = 0; asm volatile("" : "+s"(wsoff)); unsigned char* ws = kp->ws + wsoff; \
    int G = G0, bx = bx0, vcu = vcu0; asm volatile("" : "+s"(G), "+s"(bx), "+s"(vcu)); \
    (void)bx; (void)vcu; (void)G;
#define XSYNC(ph) PH_VARS(ph) xcd_barrier((unsigned*)(ws + WS_BAR), (volatile LAS unsigned*)(lds + MISC_OFF), tid_, (unsigned)G); PH_STAMP(ph);
#define CSYNC(ph) cg::this_grid().sync(); PH_VARS(ph) PH_STAMP(ph);

template <int l>
__device__ __forceinline__ void layer_phases(KP kp0, LAS unsigned char* lds, char* lds_gen, int G0, int bx0, int vcu0, int wave0) {
    constexpr int pb = PH_L0 + l * PH_PER_LAYER;
    constexpr int nrM = (l == 1 ? RX : R) / 256;
    { XSYNC(pb + PHL_WIN)
      pg8::run(lds, pg8::Gemm{(const bf16_t*)(ws + WS_H), (const bf16_t*)(ws + WS_WIN) + (size_t)l * ZLD * D, D, D, D}, R / 256, ZLD / 256, G, bx, pg8::EpiZ{(bf16_t*)(ws + WS_Z), (float*)(ws + WS_RSQ) + (size_t)l * R * 2}, tid_);
#ifdef PROBE_G
      if (PROBE_G == pb + PHL_WIN && bx0 == 0 && tid_ == 0) { ((unsigned long long*)(ws + 32768))[28] = 0ull; ((unsigned long long*)(ws + 32768))[29] = *(volatile LAS unsigned long long*)(lds + MISC_OFF + 32); }
#endif

      if (bx >= (R / 256) * (ZLD / 256) - 2 * G) conv_fill(kp, ws, lds, tid_, 2); }
    { XSYNC(pb + PHL_PRE)
      { const float* rsq = (const float*)(ws + WS_RSQ) + (size_t)l * R * 2;
        pg8::run(lds, pg8::Gemm{(const bf16_t*)(ws + WS_Z) + Z_CQ, (const bf16_t*)(ws + WS_WUQ) + (size_t)l * 768 * 384, ZLD, 384, 384}, R / 256, 3, G, bx, pg8::EpiQ{(bf16_t*)(ws + WS_QM), rsq, (const float2*)(ws + WS_CS)}, tid_); }
      { int tid2 = tid_; asm volatile("" : "+v"(tid2)); size_t wsoff2 = 0; asm volatile("" : "+s"(wsoff2)); unsigned char* ws2 = kp->ws + wsoff2;
        pg8::run(lds, pg8::Gemm{(const bf16_t*)(ws2 + WS_Z) + Z_CKV, (const bf16_t*)(ws2 + WS_WUKV) + (size_t)l * 1024 * 256, ZLD, 256, 256}, R / 256, 4, G, (bx + G - 108) % G, pg8::EpiKV{(bf16_t*)(ws2 + WS_KN), (bf16_t*)(ws2 + WS_VM), (const float*)(ws2 + WS_RSQ) + (size_t)l * R * 2}, tid2); }
#ifdef PROBE_G
      if (PROBE_G == pb + PHL_PRE && bx0 == 0 && tid_ == 0) { ((unsigned long long*)(ws + 32768))[28] = 0ull; ((unsigned long long*)(ws + 32768))[29] = *(volatile LAS unsigned long long*)(lds + MISC_OFF + 32); }
#endif
#ifdef PROBE_A
      if (l == 0) { __syncthreads(); if (bx0 == 0 && tid_ == 0) { ((unsigned long long*)(ws + 32768))[24] = ((unsigned long long*)(ws + 32768))[pb + PHL_PRE]; ((unsigned long long*)(ws + 32768))[25] = __builtin_amdgcn_s_memrealtime(); } }
#endif
      if (G == 256) { if (bx >= 108) pre_rope(kp, ws, tid_, bx - 108, G - 108); }
      else pre_rope(kp, ws, tid_, vcu, G);
#ifdef PROBE_A
      if (l == 0) { __syncthreads(); if (bx0 == 0 && tid_ == 0) ((unsigned long long*)(ws + 32768))[26] = __builtin_amdgcn_s_memrealtime(); }
#endif
      if (G != 256) pre_pool(kp, ws, tid_, l, vcu, G);
#ifdef PROBE_A
      if (l == 0) { __syncthreads(); if (bx0 == 0 && tid_ == 0) ((unsigned long long*)(ws + 32768))[27] = __builtin_amdgcn_s_memrealtime(); }
#endif
      if (G != 256) pre_conv(kp, ws, tid_, l, vcu, G);
#ifdef PROBE_PRE
      if (l == 0) { __syncthreads(); if (tid_ == 0) ((unsigned long long*)(ws + 32768))[128 + bx0] = __builtin_amdgcn_s_memrealtime(); }
#endif
    }
    { XSYNC(pb + PHL_ATTN)
      att::phase_attn(kp, ws, tid_, l, lds_gen, vcu, G, bx);
      constexpr int em0 = (l == 0) ? 160 : 128;
      if (G == 256 && vcu >= em0) {
        int tid3 = tid_; asm volatile("" : "+v"(tid3)); size_t wsoff3 = 0; asm volatile("" : "+s"(wsoff3)); unsigned char* ws3 = kp->ws + wsoff3;
        pre_pool(kp, ws3, tid3, l, vcu - em0, 256 - em0); pre_conv(kp, ws3, tid3, l, vcu - em0, 256 - em0); }
#ifdef PROBE_ATT
      if (l == PROBE_ATT - 1) { __syncthreads(); if (tid_ == 0) ((unsigned long long*)(ws + 32768))[128 + vcu0] = __builtin_amdgcn_s_memrealtime(); }
#endif
      if (G != 256 || (vcu >= 128 && (l == 1 || vcu < 160))) conv_drain(kp, ws, lds, tid_, l == 0 ? CV_E1 : CV_E5); }
    { XSYNC(pb + PHL_WOUT)
      pg8::run(lds, pg8::Gemm{(const bf16_t*)(ws + WS_MIX), (const bf16_t*)(ws + WS_WOUT) + (size_t)l * D * D, D, D, D}, RX / 256, D / 256, G, bx, pg8::EpiY{(bf16_t*)(ws + WS_Y), (float*)(ws + WS_YP), RX / 256, (size_t)RC * D}, tid_, l == 0 ? RC / 256 : 0, 4);
      if (l == 0 && G == 256 && bx >= 128) conv_fill(kp, ws, lds, tid_, 1); }
    { XSYNC(pb + PHL_ROWB)
      phase_rowpass(kp, ws, lds, tid_, 1, l, vcu, G);
      conv_drain(kp, ws, lds, tid_, l == 0 ? CV_E2 : CV_E6); }
    { XSYNC(pb + PHL_UP)
      pg8::run(lds, pg8::Gemm{(const bf16_t*)(ws + WS_H), (const bf16_t*)(ws + WS_WUP) + (size_t)l * UFF * D, D, D, D}, nrM, UFF / 256, G, bx, pg8::EpiAct{(bf16_t*)(ws + WS_ACT), (bf16_t*)(ws + WS_EDGE), kp->in[IN_FFNCONVW] + (size_t)l * 3 * UFF, (LAS float*)(lds + pg8::STAGE_BYTES)
                  }, tid_);
#ifdef PROBE_G
      if (PROBE_G == pb + PHL_UP && bx0 == 0 && tid_ == 0) { ((unsigned long long*)(ws + 32768))[28] = 0ull; ((unsigned long long*)(ws + 32768))[29] = *(volatile LAS unsigned long long*)(lds + MISC_OFF + 32); }
#endif

      if (bx >= (nrM * (UFF / 256)) % G) conv_fill(kp, ws, lds, tid_, 2); }
    { XSYNC(pb + PHL_ACT)
      phase_act_edges(kp, ws, tid_, l, vcu, G);
      conv_drain(kp, ws, lds, tid_, l == 0 ? CV_E3 : CV_E7); }
    { XSYNC(pb + PHL_DOWN)
      pg8::run(lds, pg8::Gemm{(const bf16_t*)(ws + WS_ACT), (const bf16_t*)(ws + WS_WDOWN) + (size_t)l * D * DFF, DFF, DFF, DFF}, RX / 256, D / 256, G, bx, pg8::EpiY{(bf16_t*)(ws + WS_Y), (float*)(ws + WS_YP), RX / 256, (size_t)RC * D}, tid_, l == 0 ? RC / 256 : 0, 4);
#ifdef PROBE_G
      if (PROBE_G == pb + PHL_DOWN && bx0 == 0 && tid_ == 0) { ((unsigned long long*)(ws + 32768))[28] = 0ull; ((unsigned long long*)(ws + 32768))[29] = *(volatile LAS unsigned long long*)(lds + MISC_OFF + 32); }
#endif
 }
    { XSYNC(pb + PHL_ROWC)
      phase_rowpass(kp, ws, lds, tid_, 2, l, vcu, G);
      if (l == 0) conv_drain(kp, ws, lds, tid_, CV_E4); }
}

__global__ void __launch_bounds__(NTHR, 2) mk_fwd(Params P) {
    extern __shared__ __attribute__((aligned(16))) unsigned char lds_raw[];
    LAS unsigned char* lds = (LAS unsigned char*)lds_raw;
    KP kp0 = (KP)__builtin_amdgcn_kernarg_segment_ptr();
    const int G0 = gridDim.x, bx0 = blockIdx.x;
    const int wave0 = __builtin_amdgcn_readfirstlane((int)__builtin_amdgcn_workitem_id_x() >> 6);
    const int vcu0 = (G0 % 8 == 0) ? (bx0 % 8) * (G0 / 8) + bx0 / 8 : bx0;
    if (kp0->pad == 0x7fffffff) cg::this_grid().sync();
    { PH_VARS(PH_PRO) PH_STAMP(PH_PRO);
      if (tid_ < 2) ((volatile LAS unsigned*)(lds + MISC_OFF))[tid_] = 0u;
      if (tid_ == 2) ((volatile LAS unsigned*)(lds + MISC_OFF))[6] = 0u;
      if (tid_ == 0) (void)xb_add((unsigned*)(ws + WS_BAR) + XB_XCNT(xb_xcc_id()), 1u);
      __syncthreads();
      phase_prologue(kp, ws, tid_, lds, vcu, G); }
    { XSYNC(PH_ROWA)
      phase_rowpass(kp, ws, lds, tid_, 0, 0, vcu, G); }
    layer_phases<0>(kp0, lds, (char*)lds_raw, G0, bx0, vcu0, wave0);
    layer_phases<1>(kp0, lds, (char*)lds_raw, G0, bx0, vcu0, wave0);
#ifdef PROBE_ACT
    { XSYNC(PH_TOTAL)
      phase_act(kp, ws, tid_, 1, vcu, G, WS_END); }
    { XSYNC(PH_TOTAL)
      const bf16_t* A1 = (const bf16_t*)(ws + WS_ACT); const bf16_t* A2 = (const bf16_t*)(ws + WS_END); float mx = 0.f;
      for (size_t i = (size_t)vcu * NTHR + tid_; i < (size_t)RX * DFF / 8; i += (size_t)G * NTHR) { float a[8], b[8]; unpack8(ld16(A1 + i * 8), a); unpack8(ld16(A2 + i * 8), b);
#pragma unroll
          for (int e = 0; e < 8; ++e) mx = fmaxf(mx, fabsf(a[e] - b[e])); }
      atomicMax((unsigned*)(ws + 40960), __float_as_uint(mx)); }
    { XSYNC(PH_TOTAL)
      if (bx0 == 0 && tid_ == 0) kp->out[0] += 0.3f + __uint_as_float(*(volatile unsigned*)(ws + 40960)); }
#endif
#ifdef PROBE_A
#ifdef PROBE_SYNC
    { XSYNC(PH_TOTAL)
      unsigned long long t0 = __builtin_amdgcn_s_memrealtime();
      for (int i = 0; i < 10; ++i) xcd_barrier((unsigned*)(ws + WS_BAR), (volatile LAS unsigned*)(lds + MISC_OFF), tid_, (unsigned)G);
      unsigned long long t1 = __builtin_amdgcn_s_memrealtime();
      if (bx0 == 0 && tid_ == 0) kp->out[0] += 0.3f + (float)(t1 - t0) * (0.01f / 800.f); }
#else
    { XSYNC(PH_TOTAL)
      if (bx0 == 0) {
        unsigned long long* ts = (unsigned long long*)(ws + 32768);
        __syncthreads();
#ifdef PROBE_ATT
        unsigned long long mq = 0, mk = 0; const unsigned long long t0_ = ts[PH_L0 + (PROBE_ATT - 1) * PH_PER_LAYER + PHL_ATTN];
        for (int i = 0; i < 128; ++i) { const unsigned long long d = ts[128 + i] - t0_; mq = d > mq ? d : mq; } for (int i = 128; i < 256; ++i) { const unsigned long long d = ts[128 + i] - t0_; mk = d > mk ? d : mk; }
        const float ta = (float)mq * (0.01f / 800.f), tb = (float)mk * (0.01f / 800.f);
#elif defined(PROBE_PRE)
        unsigned long long mq = 0, mk = 0; for (int i = 0; i < 108; ++i) { const unsigned long long d = ts[128 + i] - ts[3]; mq = d > mq ? d : mq; } for (int i = 108; i < 256; ++i) { const unsigned long long d = ts[128 + i] - ts[3]; mk = d > mk ? d : mk; }
        const float ta = (float)mq * (0.01f / 800.f), tb = (float)mk * (0.01f / 800.f);
#else
        const float ta = (float)(ts[PROBE_A + 1] - ts[PROBE_A]) * (0.01f / 800.f), tb = (float)(ts[PROBE_B + 1] - ts[PROBE_B]) * (0.01f / 800.f);
#endif
        if (tid_ == 0) kp->out[0] += 0.3f + ta;
        for (int i = 1 + tid_; i <= 65536; i += NTHR) kp->out[i] += tb;
      } }
#endif
#endif
}

extern "C" void kernel_launch(void* const* d_in, const int* in_sizes, int n_in, void* d_out, int out_size, void* d_ws, size_t ws_size, hipStream_t stream) {
    static int grid = 0;
    if (grid == 0) {
        if (n_in != 24 || ws_size < WS_END) { fprintf(stderr, "kernel_launch: bad args n_in %d ws %zu (need %zu)\n", n_in, ws_size, (size_t)WS_END); grid = -1; return; }
        if (hipFuncSetAttribute((const void*)mk_fwd, hipFuncAttributeMaxDynamicSharedMemorySize, LDS_BYTES) != hipSuccess) { fprintf(stderr, "hipFuncSetAttribute failed\n"); grid = -1; return; }
        int dev = 0, cus = 0, per_cu = 0;
        if (hipGetDevice(&dev) != hipSuccess || hipDeviceGetAttribute(&cus, hipDeviceAttributeMultiprocessorCount, dev) != hipSuccess) { grid = -1; return; }
        if (hipOccupancyMaxActiveBlocksPerMultiprocessor(&per_cu, (const void*)mk_fwd, NTHR, LDS_BYTES) != hipSuccess || per_cu < 1) { fprintf(stderr, "occupancy query failed (%d)\n", per_cu); grid = -1; return; }
        grid = cus * per_cu;
    }
    if (grid < 0) return;
    unsigned char* ws = (unsigned char*)d_ws;
    (void)hipMemsetAsync(ws + WS_CTL, 0, 256 * 1024, stream);
    Params P{};
    for (int i = 0; i < 24; ++i) P.in[i] = (const float*)d_in[i];
    P.out = (float*)d_out; P.ws = ws; P.ph_lo = 0; P.ph_hi = PH_TOTAL; P.mask = 15; P.pad = 0;
    void* args[] = {&P};
    const hipError_t e = hipLaunchCooperativeKernel((const void*)mk_fwd, dim3(grid), dim3(NTHR), args, LDS_BYTES, stream);
    if (e != hipSuccess) fprintf(stderr, "cooperative launch failed: %s (grid %d)\n", hipGetErrorString(e), grid);
}
```

```cpp
#include <hip/hip_runtime.h>
#include <hip/hip_cooperative_groups.h>
#include <cstdint>
#include <cstdio>
#include <cmath>
namespace cg = cooperative_groups;

#define LAS __attribute__((address_space(3)))
typedef unsigned short bf16_t;
typedef short bf16x8 __attribute__((ext_vector_type(8)));
typedef short s16x4 __attribute__((ext_vector_type(4)));
typedef float f32x4 __attribute__((ext_vector_type(4)));
typedef float f32x2 __attribute__((ext_vector_type(2)));
typedef float f32x16 __attribute__((ext_vector_type(16)));
typedef unsigned u32x4 __attribute__((ext_vector_type(4)));
typedef unsigned u32x2 __attribute__((ext_vector_type(2)));

constexpr int D = 2048, NB = 4, SEQ = 2048, CTX = 256, GRIDW = 64;
constexpr int RX = NB * SEQ, RC = NB * CTX, R = RX + RC;
constexpr int INC = 4288, ZLD = 4352, DFF = 5632, UFF = 2 * DFF, MODW = 6 * D;
constexpr float EPS = 1e-6f;
constexpr int Z_POOL = 0, Z_Q = 512, Z_K = 1024, Z_V = 1536, Z_CQ = 2048, Z_CKV = 2432, Z_KR = 2688, Z_GB = 2752, Z_GC = 3264, Z_H = 3776;
constexpr int NWAVES = 8, NTHR = 512;
constexpr int LDS_BYTES = 147456, MISC_OFF = LDS_BYTES - 64;

constexpr size_t MiB = 1u << 20;
constexpr size_t WS_CTL = 0, CTL_BYTES = 1 * MiB;
constexpr size_t WS_BAR = 0;
constexpr size_t WS_CVQ = 48 * 1024;
constexpr size_t WS_RSQ = 64 * 1024;
constexpr size_t WS_MOD = 1 * MiB;
constexpr size_t WS_CS = 2 * MiB;
constexpr size_t WS_POOLW = 3 * MiB;
constexpr size_t WS_WUQ = 4 * MiB;
constexpr size_t WS_WUKV = 6 * MiB;
constexpr size_t WS_WIN = 8 * MiB;
constexpr size_t WS_WOUT = 42 * MiB;
constexpr size_t WS_WUP = 58 * MiB;
constexpr size_t WS_WDOWN = 146 * MiB;
constexpr size_t WS_XR = 190 * MiB;
constexpr size_t WS_H = 262 * MiB;
constexpr size_t WS_BIG = 298 * MiB;
constexpr size_t WS_Z = WS_BIG;
constexpr size_t WS_QM = WS_BIG + 77 * MiB;
constexpr size_t WS_KN = WS_BIG + 91 * MiB;
constexpr size_t WS_VM = WS_BIG + 100 * MiB;
constexpr size_t WS_KR = WS_BIG + 109 * MiB;
constexpr size_t WS_MIX = WS_BIG + 111 * MiB;
constexpr size_t WS_Y = WS_BIG + 147 * MiB;
constexpr size_t WS_U = WS_BIG;
constexpr size_t WS_ACT = WS_BIG + 219 * MiB;
constexpr size_t WS_O1 = WS_ACT + 99 * MiB;
constexpr size_t WS_YP = WS_O1 + 32 * MiB;
constexpr size_t WS_EDGE = WS_YP + 24 * MiB;
constexpr size_t WS_END = WS_EDGE + 4 * MiB;
static_assert(WS_U + (size_t)R * UFF * 2 <= WS_ACT, "U overlay");
static_assert(WS_RSQ + (size_t)2 * R * 2 * 4 <= 256 * 1024, "control words inside the per-call memset");

struct Params {
    const float* in[24];
    float* out;
    unsigned char* ws;
    int ph_lo, ph_hi;
    int mask, pad;
};
typedef const __attribute__((address_space(4))) Params* KP;
enum { IN_X = 0, IN_C, IN_CTX, IN_CCTX, IN_ADAW, IN_ADAB, IN_GPREMIX, IN_GPOSTMIX, IN_GPREFFN, IN_GPOSTFFN, IN_WIN, IN_POOLW, IN_POOLSCALE, IN_DIFFLAM, IN_SUBLN,
       IN_GQ, IN_WUQ, IN_GKV, IN_WUKV, IN_CONVW, IN_WOUT, IN_WUP, IN_FFNCONVW, IN_WDOWN };
enum { PH_PRO = 0, PH_ROWA = 1, PH_L0 = 2, PHL_WIN = 0, PHL_PRE = 1, PHL_ATTN = 2, PHL_WOUT = 3, PHL_ROWB = 4, PHL_UP = 5, PHL_ACT = 6, PHL_DOWN = 7, PHL_ROWC = 8, PH_PER_LAYER = 9, PH_TOTAL = 2 + 2 * 9 };

__device__ __forceinline__ void rowinfo(int r, int& b, int& t, int& L, int& isc) {
    if (r < RX) { b = r / SEQ; t = r % SEQ; L = SEQ; isc = 0; } else { const int rc = r - RX; b = rc / CTX; t = rc % CTX; L = CTX; isc = 1; }
}
__device__ __forceinline__ float wave_sum(float v) {
#pragma unroll
    for (int o = 1; o < 64; o <<= 1) v += __shfl_xor(v, o);
    return v;
}
__device__ __forceinline__ float wave_max(float v) {
#pragma unroll
    for (int o = 1; o < 64; o <<= 1) v = fmaxf(v, __shfl_xor(v, o));
    return v;
}
__device__ __forceinline__ float sx(float v, int o, int lane) { return __int_as_float(__builtin_amdgcn_ds_bpermute((lane ^ o) << 2, __float_as_int(v))); }
__device__ __forceinline__ float wsum(float v, int lane) {
#pragma unroll
    for (int o = 1; o < 64; o <<= 1) v += sx(v, o, lane);
    return v;
}
typedef __bf16 bf16x2_t __attribute__((ext_vector_type(2)));
__device__ __forceinline__ unsigned cvt_pk_bf16(float lo, float hi) { const f32x2 v = {lo, hi}; const bf16x2_t b = __builtin_convertvector(v, bf16x2_t); return __builtin_bit_cast(unsigned, b); }
__device__ __forceinline__ bf16_t f2bf(float f) { return (bf16_t)(cvt_pk_bf16(f, 0.f) & 0xffffu); }
__device__ __forceinline__ float bf2f(bf16_t h) { return __uint_as_float(((unsigned)h) << 16); }
__device__ __forceinline__ void unpack8(const u32x4 w, float* f) {
    f[0] = __uint_as_float(w.x << 16); f[1] = __uint_as_float(w.x & 0xffff0000u); f[2] = __uint_as_float(w.y << 16); f[3] = __uint_as_float(w.y & 0xffff0000u);
    f[4] = __uint_as_float(w.z << 16); f[5] = __uint_as_float(w.z & 0xffff0000u); f[6] = __uint_as_float(w.w << 16); f[7] = __uint_as_float(w.w & 0xffff0000u);
}
__device__ __forceinline__ u32x4 pack8(const float* f) { u32x4 w; w.x = cvt_pk_bf16(f[0], f[1]); w.y = cvt_pk_bf16(f[2], f[3]); w.z = cvt_pk_bf16(f[4], f[5]); w.w = cvt_pk_bf16(f[6], f[7]); return w; }
__device__ __forceinline__ u32x4 ld16(const bf16_t* p) { return *(const u32x4*)p; }
__device__ __forceinline__ void st16(bf16_t* p, u32x4 v) { *(u32x4*)p = v; }

__host__ __device__ __forceinline__ int uq_pos(int n) { const int h = n / 192, j = n % 192; if (j < 128) return (h >> 1) * 256 + (h & 1) * 128 + j; const int jj = j - 128; return jj < 32 ? 512 + h * 32 + jj : 640 + h * 32 + (jj - 32); }

__host__ __device__ __forceinline__ int up_pos(int n) { const int m = n < DFF ? n : n - DFF; return (m >> 7) * 256 + (n < DFF ? 0 : 128) + (m & 127); }
template <int MAP>
__device__ __forceinline__ void tr_item(const float* __restrict__ W, int K, int N, bf16_t* __restrict__ WT, int ldt, const float* __restrict__ ks, const float* __restrict__ ns, LAS float* scr, int item, int lane) {
    const int nblk = N / 32, kb = item / nblk, nb = item % nblk, k0 = 64 * kb, n0 = 32 * nb;
    const float nsv = ns ? ns[n0 + (lane & 31)] : 1.f;
    float wv[32];
#pragma unroll
    for (int i = 0; i < 32; ++i) wv[i] = __builtin_nontemporal_load(&W[(size_t)(k0 + 2 * i + (lane >> 5)) * N + n0 + (lane & 31)]);
#pragma unroll
    for (int i = 0; i < 32; ++i) { const int kk = 2 * i + (lane >> 5); float v = wv[i]; if (ks) v *= ks[k0 + kk]; scr[kk * 33 + (lane & 31)] = v * nsv; }
    asm volatile("s_waitcnt lgkmcnt(0)" ::: "memory");
    const int c = lane & 7;
#pragma unroll
    for (int j = 0; j < 4; ++j) { const int n = (lane >> 3) + 8 * j; const LAS float* s = scr + (8 * c) * 33 + n;
        u32x4 o; o.x = cvt_pk_bf16(s[0 * 33], s[1 * 33]); o.y = cvt_pk_bf16(s[2 * 33], s[3 * 33]); o.z = cvt_pk_bf16(s[4 * 33], s[5 * 33]); o.w = cvt_pk_bf16(s[6 * 33], s[7 * 33]);
        const int nn = n0 + n; const int dst = (MAP == 1) ? uq_pos(nn) : (MAP == 2) ? up_pos(nn) : nn;
        *(u32x4*)(WT + (size_t)dst * ldt + k0 + 8 * c) = o; }
    asm volatile("s_waitcnt lgkmcnt(0)" ::: "memory");
}

__device__ __forceinline__ void tr_item_poolfold(const float* __restrict__ W  , const float* __restrict__ pw  , const float* __restrict__ psc  ,
                                                 bf16_t* __restrict__ WT, LAS float* scr, int item, int lane) {
    const int kb = item / 16, nb = item % 16, k0 = 64 * kb, n0 = 32 * nb, g = n0 >> 7, d0 = n0 & 127, kg = lane >> 5, nl = lane & 31;
    const float* wa = W + (size_t)(k0 + nl) * INC + g * 128 + kg * 8;
    const float* pb = pw + (size_t)g * 128 * 128 + (size_t)(kg * 8) * 128 + d0 + nl;
    f32x4 av[8][4]; float bv[8][8];
#pragma unroll
    for (int ks = 0; ks < 8; ++ks) {
        av[ks][0] = *(const f32x4*)(wa + ks * 16); av[ks][1] = *(const f32x4*)(wa + ks * 16 + 4);
        av[ks][2] = *(const f32x4*)(wa + (size_t)32 * INC + ks * 16); av[ks][3] = *(const f32x4*)(wa + (size_t)32 * INC + ks * 16 + 4);
        if (ks < 4) {
#pragma unroll
            for (int j = 0; j < 8; ++j) bv[ks][j] = pb[(size_t)(ks * 16 + j) * 128]; } }
    __builtin_amdgcn_sched_barrier(0);
#pragma unroll
    for (int ks = 4; ks < 8; ++ks)
#pragma unroll
        for (int j = 0; j < 8; ++j) bv[ks][j] = pb[(size_t)(ks * 16 + j) * 128];
    f32x16 acc0, acc1;
#pragma unroll
    for (int i = 0; i < 16; ++i) { acc0[i] = 0.f; acc1[i] = 0.f; }
#pragma unroll
    for (int ks = 0; ks < 8; ++ks) {
        u32x4 A0, A1, B;
        A0.x = cvt_pk_bf16(av[ks][0].x, av[ks][0].y); A0.y = cvt_pk_bf16(av[ks][0].z, av[ks][0].w); A0.z = cvt_pk_bf16(av[ks][1].x, av[ks][1].y); A0.w = cvt_pk_bf16(av[ks][1].z, av[ks][1].w);
        A1.x = cvt_pk_bf16(av[ks][2].x, av[ks][2].y); A1.y = cvt_pk_bf16(av[ks][2].z, av[ks][2].w); A1.z = cvt_pk_bf16(av[ks][3].x, av[ks][3].y); A1.w = cvt_pk_bf16(av[ks][3].z, av[ks][3].w);
        B.x = cvt_pk_bf16(bv[ks][0], bv[ks][1]); B.y = cvt_pk_bf16(bv[ks][2], bv[ks][3]); B.z = cvt_pk_bf16(bv[ks][4], bv[ks][5]); B.w = cvt_pk_bf16(bv[ks][6], bv[ks][7]);
        acc0 = __builtin_amdgcn_mfma_f32_32x32x16_bf16(__builtin_bit_cast(bf16x8, A0), __builtin_bit_cast(bf16x8, B), acc0, 0, 0, 0);
        acc1 = __builtin_amdgcn_mfma_f32_32x32x16_bf16(__builtin_bit_cast(bf16x8, A1), __builtin_bit_cast(bf16x8, B), acc1, 0, 0, 0);
    }
    const float sc = psc[n0 + nl];
    bf16_t* wt = WT + (size_t)(n0 + nl) * D + k0 + 4 * kg;
#pragma unroll
    for (int q = 0; q < 4; ++q) {
        u32x2 o0, o1;
        o0.x = cvt_pk_bf16(acc0[4 * q] * sc, acc0[4 * q + 1] * sc); o0.y = cvt_pk_bf16(acc0[4 * q + 2] * sc, acc0[4 * q + 3] * sc);
        o1.x = cvt_pk_bf16(acc1[4 * q] * sc, acc1[4 * q + 1] * sc); o1.y = cvt_pk_bf16(acc1[4 * q + 2] * sc, acc1[4 * q + 3] * sc);
        *(u32x2*)(wt + 8 * q) = o0; *(u32x2*)(wt + 32 + 8 * q) = o1; }
}
constexpr int CV_IN = 32 * 134, CV_OUT = 32 * 64, CV_UP = 32 * 352, CV_DOWN = 88 * 64, CV_UQ = 6 * 24, CV_UKV = 4 * 32, CV_POOL = 0;
constexpr int CV_SEG0 = CV_UQ + CV_UKV + CV_POOL + CV_IN;
constexpr int CV_E1 = CV_OUT, CV_E2 = CV_E1 + CV_UP, CV_E3 = CV_E2 + CV_DOWN, CV_E4 = CV_E3 + CV_SEG0, CV_E5 = CV_E4 + CV_OUT, CV_E6 = CV_E5 + CV_UP, CV_E7 = CV_E6 + CV_DOWN;
__device__ __forceinline__ void conv_item0(KP kp, unsigned char* ws, int l, int r, LAS float* scr, int lane) {
    if (r < CV_UQ) { tr_item<1>(kp->in[IN_WUQ] + (size_t)l * 384 * 768, 384, 768, (bf16_t*)(ws + WS_WUQ) + (size_t)l * 768 * 384, 384, kp->in[IN_GQ] + l * 384, nullptr, scr, r, lane); return; } r -= CV_UQ;
    if (r < CV_UKV) { tr_item<0>(kp->in[IN_WUKV] + (size_t)l * 256 * 1024, 256, 1024, (bf16_t*)(ws + WS_WUKV) + (size_t)l * 1024 * 256, 256, kp->in[IN_GKV] + l * 256, nullptr, scr, r, lane); return; } r -= CV_UKV;
    if (r < CV_POOL) { const int g = r / 8, rr = r % 8;
        tr_item<0>(kp->in[IN_POOLW] + ((size_t)l * 4 + g) * 128 * 128, 128, 128, (bf16_t*)(ws + WS_POOLW) + ((size_t)l * 4 + g) * 128 * 128, 128, nullptr, kp->in[IN_POOLSCALE] + l * 512 + g * 128, scr, rr, lane); return; } r -= CV_POOL;
    if (r % 134 < 16) { tr_item_poolfold(kp->in[IN_WIN] + (size_t)l * D * INC, kp->in[IN_POOLW] + (size_t)l * 4 * 128 * 128, kp->in[IN_POOLSCALE] + l * 512, (bf16_t*)(ws + WS_WIN) + (size_t)l * ZLD * D, scr, (r / 134) * 16 + r % 134, lane); return; }
    tr_item<0>(kp->in[IN_WIN] + (size_t)l * D * INC, D, INC, (bf16_t*)(ws + WS_WIN) + (size_t)l * ZLD * D, D, nullptr, nullptr, scr, r, lane);
}
__device__ __forceinline__ void phase_prologue(KP kp, unsigned char* ws, int tid_, LAS unsigned char* lds, int vcu, int G) {
    const int tid = tid_, lane = tid & 63, wave = tid >> 6;
    {
        LAS float* red = (LAS float*)lds;
        LAS float* sil = (LAS float*)(lds + 32768);
        float* MOD = (float*)(ws + WS_MOD);
        for (int i = tid; i < 5 * D; i += NTHR) { const int row = i / D, k = i % D; const float v = (row < 4) ? kp->in[IN_C][row * D + k] : kp->in[IN_CCTX][k]; sil[i] = v / (1.f + __expf(-v)); }
        __syncthreads();
        for (int cb = vcu; cb < 256; cb += G) {
            const int gn0 = cb * 96, l = gn0 / MODW, n0 = gn0 % MODW;
            if (tid < 384) {
                const int cq = tid % 24, kg = tid / 24;
                const float* w = kp->in[IN_ADAW] + ((size_t)l * D + kg * 128) * MODW + n0 + cq * 4;
                f32x4 acc[5];
#pragma unroll
                for (int i = 0; i < 5; ++i) acc[i] = (f32x4){0.f, 0.f, 0.f, 0.f};
#pragma unroll 1
                for (int k0 = 0; k0 < 128; k0 += 16) { f32x4 wv[16];
#pragma unroll
                    for (int k = 0; k < 16; ++k) wv[k] = __builtin_nontemporal_load((const f32x4*)(w + (size_t)(k0 + k) * MODW));
#pragma unroll
                    for (int k = 0; k < 16; ++k) { const int kk = kg * 128 + k0 + k;
#pragma unroll
                        for (int i = 0; i < 5; ++i) acc[i] += wv[k] * sil[i * D + kk]; } }
#pragma unroll
                for (int i = 0; i < 5; ++i)
#pragma unroll
                    for (int e = 0; e < 4; ++e) red[(kg * 5 + i) * 96 + cq * 4 + e] = acc[i][e];
            }
            __syncthreads();
            if (tid < 480) { const int i = tid / 96, cn = tid % 96; float s = kp->in[IN_ADAB][l * MODW + n0 + cn];
#pragma unroll
                for (int kg = 0; kg < 16; ++kg) s += red[(kg * 5 + i) * 96 + cn];
                MOD[((size_t)l * 5 + i) * MODW + n0 + cn] = s; }
            __syncthreads();
        }
    }
    {
        float2* cs = (float2*)(ws + WS_CS);
        for (int idx = vcu * NTHR + tid; idx < SEQ * 32; idx += G * NTHR) {
            const int t = idx / 32, i = idx % 32, f = i & 15;
            const float base = ((f & 3) == 0) ? 1.0f : ((f & 3) == 1) ? 0.5623413251903491f : ((f & 3) == 2) ? 0.31622776601683794f : 0.1778279410038923f;
            const float dec = ((f >> 2) == 0) ? 1.0f : ((f >> 2) == 1) ? 0.1f : ((f >> 2) == 2) ? 0.01f : 0.001f;
            const float pos = (i < 16) ? (float)(t / GRIDW) : (float)(t % GRIDW);
            const float ang = pos * (base * dec);
            cs[idx] = make_float2(__cosf(ang), __sinf(ang));
        }
    }
    {
        for (int idx = vcu * NTHR + tid; idx < 2 * 64 * 256; idx += G * NTHR) { const int l = idx / (64 * 256), rem = idx % (64 * 256), row = INC + rem / 256, ch = rem % 256;
            *(u32x4*)((bf16_t*)(ws + WS_WIN) + ((size_t)l * ZLD + row) * D + ch * 8) = (u32x4){0u, 0u, 0u, 0u}; }
    }
    {
        LAS float* scr = (LAS float*)(lds + 32768) + wave * (64 * 33);
        const int gw = vcu * NWAVES + wave, NGW = G * NWAVES;
        for (int it = gw; it < CV_SEG0; it += NGW) conv_item0(kp, ws, 0, it, scr, lane);
    }
}

__device__ __forceinline__ void conv_itemq(KP kp, unsigned char* ws, int it, LAS float* scr, int lane) {
    if (it < CV_E1) { tr_item<0>(kp->in[IN_WOUT], D, D, (bf16_t*)(ws + WS_WOUT), D, nullptr, nullptr, scr, it, lane); return; }
    if (it < CV_E2) { tr_item<2>(kp->in[IN_WUP], D, UFF, (bf16_t*)(ws + WS_WUP), D, nullptr, nullptr, scr, it - CV_E1, lane); return; }
    if (it < CV_E3) { tr_item<0>(kp->in[IN_WDOWN], DFF, D, (bf16_t*)(ws + WS_WDOWN), DFF, nullptr, nullptr, scr, it - CV_E2, lane); return; }
    if (it < CV_E4) { conv_item0(kp, ws, 1, it - CV_E3, scr, lane); return; }
    if (it < CV_E5) { tr_item<0>(kp->in[IN_WOUT] + (size_t)D * D, D, D, (bf16_t*)(ws + WS_WOUT) + (size_t)D * D, D, nullptr, nullptr, scr, it - CV_E4, lane); return; }
    if (it < CV_E6) { tr_item<2>(kp->in[IN_WUP] + (size_t)D * UFF, D, UFF, (bf16_t*)(ws + WS_WUP) + (size_t)UFF * D, D, nullptr, nullptr, scr, it - CV_E5, lane); return; }
    tr_item<0>(kp->in[IN_WDOWN] + (size_t)DFF * D, DFF, D, (bf16_t*)(ws + WS_WDOWN) + (size_t)D * DFF, DFF, nullptr, nullptr, scr, it - CV_E6, lane);
}
constexpr int CV_CHUNK = 32;
__device__ __forceinline__ int conv_claim_chunk(unsigned char* ws, LAS unsigned char* lds, int tid) {
    volatile LAS unsigned* slot = (volatile LAS unsigned*)(lds + MISC_OFF + 16);
    __syncthreads();
    if (tid == 0) { const unsigned b_ = __hip_atomic_fetch_add((unsigned*)(ws + WS_CVQ), (unsigned)CV_CHUNK, __ATOMIC_RELAXED, __HIP_MEMORY_SCOPE_AGENT); slot[0] = b_; slot[2] = b_ + (unsigned)CV_CHUNK; }
    __syncthreads();
    return (int)__builtin_amdgcn_readfirstlane(slot[0]);
}
__device__ __forceinline__ void conv_chunk(KP kp, unsigned char* ws, LAS unsigned char* lds, int tid, int base) {
    const int lane = tid & 63, wave = tid >> 6; LAS float* scr = (LAS float*)(lds + 32768) + wave * (64 * 33);
    for (int j = wave; j < CV_CHUNK; j += NWAVES) { const int it = base + j; if (it < CV_E7) conv_itemq(kp, ws, it, scr, lane); }
}
__device__ __forceinline__ void conv_drain(KP kp, unsigned char* ws, LAS unsigned char* lds, int tid, int limit) {
    volatile LAS unsigned* slot = (volatile LAS unsigned*)(lds + MISC_OFF + 16);
    if ((int)__builtin_amdgcn_readfirstlane(slot[2]) >= limit) return;
    for (;;) {
        __syncthreads();
        if (tid == 0) { const unsigned v_ = __hip_atomic_load((unsigned*)(ws + WS_CVQ), __ATOMIC_RELAXED, __HIP_MEMORY_SCOPE_AGENT); slot[1] = v_; slot[2] = v_; }
        __syncthreads();
        if ((int)__builtin_amdgcn_readfirstlane(slot[1]) >= limit) break;
        const int base = conv_claim_chunk(ws, lds, tid); conv_chunk(kp, ws, lds, tid, base);
    }
}
__device__ __forceinline__ void conv_fill(KP kp, unsigned char* ws, LAS unsigned char* lds, int tid, int nchunks) {
    for (int n = 0; n < nchunks; ++n) { const int base = conv_claim_chunk(ws, lds, tid); if (base >= CV_E7) break; conv_chunk(kp, ws, lds, tid, base); }
}

constexpr int RP_GA = 0, RP_NB = 5 * D, RP_SH = 10 * D;
__device__ __forceinline__ void rowpass_row(const float* __restrict__ xin, const bf16_t* __restrict__ xinb, const bf16_t* __restrict__ y, const float* __restrict__ yp, float* __restrict__ xout, bf16_t* __restrict__ xoutb, bf16_t* __restrict__ hout,
                                            const LAS float* tab, int lane) {
    f32x4 xv[8];
    if (xinb) {
#pragma unroll
        for (int j = 0; j < 8; ++j) { const u32x2 w = __builtin_nontemporal_load((const u32x2*)(xinb + j * 256 + lane * 4)); xv[j] = (f32x4){__uint_as_float(w.x << 16), __uint_as_float(w.x & 0xffff0000u), __uint_as_float(w.y << 16), __uint_as_float(w.y & 0xffff0000u)}; }
    } else {
#pragma unroll
        for (int j = 0; j < 8; ++j) xv[j] = __builtin_nontemporal_load((const f32x4*)(xin + j * 256 + lane * 4));
    }
    if (y) {
        f32x4 yv[8]; float ss = 0.f;
#pragma unroll
        for (int j = 0; j < 8; ++j) { const u32x2 yw = *(const u32x2*)(y + j * 256 + lane * 4);
            yv[j] = (f32x4){__uint_as_float(yw.x << 16), __uint_as_float(yw.x & 0xffff0000u), __uint_as_float(yw.y << 16), __uint_as_float(yw.y & 0xffff0000u)};
            if (yp) {
                const bf16_t* ypb = (const bf16_t*)yp;
#pragma unroll
                for (int p = 0; p < 3; ++p) { const u32x2 pw = *(const u32x2*)(ypb + (size_t)p * RC * D + j * 256 + lane * 4);
                    yv[j] += (f32x4){__uint_as_float(pw.x << 16), __uint_as_float(pw.x & 0xffff0000u), __uint_as_float(pw.y << 16), __uint_as_float(pw.y & 0xffff0000u)}; } }
            ss += (yv[j].x * yv[j].x + yv[j].y * yv[j].y) + (yv[j].z * yv[j].z + yv[j].w * yv[j].w); }
        ss = wsum(ss, lane); const float rs = 1.0f / sqrtf(ss * (1.f / D) + EPS);
#pragma unroll
        for (int j = 0; j < 8; ++j) { const f32x4 ga = *(const LAS f32x4*)(tab + RP_GA + j * 256 + lane * 4); xv[j] += ga * (yv[j] * rs); }
    }
    if (xout) {
#pragma unroll
        for (int j = 0; j < 8; ++j) __builtin_nontemporal_store(xv[j], (f32x4*)(xout + j * 256 + lane * 4));
    }
    if (xoutb) {
#pragma unroll
        for (int j = 0; j < 8; ++j) { u32x2 w; w.x = cvt_pk_bf16(xv[j].x, xv[j].y); w.y = cvt_pk_bf16(xv[j].z, xv[j].w); __builtin_nontemporal_store(w, (u32x2*)(xoutb + j * 256 + lane * 4)); }
    }
    if (hout) {
        float ss = 0.f;
#pragma unroll
        for (int j = 0; j < 8; ++j) ss += (xv[j].x * xv[j].x + xv[j].y * xv[j].y) + (xv[j].z * xv[j].z + xv[j].w * xv[j].w);
        ss = wsum(ss, lane); const float rs = 1.0f / sqrtf(ss * (1.f / D) + EPS);
#pragma unroll
        for (int j = 0; j < 8; ++j) { const f32x4 nb = *(const LAS f32x4*)(tab + RP_NB + j * 256 + lane * 4), sh = *(const LAS f32x4*)(tab + RP_SH + j * 256 + lane * 4);
            const f32x4 o = (xv[j] * rs) * nb + sh; u32x2 w; w.x = cvt_pk_bf16(o.x, o.y); w.y = cvt_pk_bf16(o.z, o.w);
            *(u32x2*)(hout + j * 256 + lane * 4) = w; }
    }
}
__device__ __forceinline__ void phase_rowpass(KP kp, unsigned char* ws, LAS unsigned char* lds, int tid_, int kind, int l, int vcu, int G) {
    const int lane = tid_ & 63, wave = __builtin_amdgcn_readfirstlane(tid_ >> 6);
    const float* MOD = (const float*)(ws + WS_MOD);
    float* XR = (float*)(ws + WS_XR); const bf16_t* Y = (const bf16_t*)(ws + WS_Y); bf16_t* H = (bf16_t*)(ws + WS_H);
    const bool last = (l == 1);
    const int nrows = (kind == 0) ? R : (last ? RX : R);
    LAS float* T = (LAS float*)lds;
    {
        const int ln = (kind == 2 && !last) ? 1 : l;
        const float* ygain = (kind == 1) ? kp->in[IN_GPOSTMIX] + l * D : kp->in[IN_GPOSTFFN] + l * D;
        const float* ngain = (kind == 0) ? kp->in[IN_GPREMIX] : (kind == 1 ? kp->in[IN_GPREFFN] + l * D : kp->in[IN_GPREMIX] + 1 * D);
        const int goff = (kind == 1) ? 2 * D : 5 * D, shoff = (kind == 1) ? 3 * D : 0, scoff = (kind == 1) ? 4 * D : 1 * D;
        __syncthreads();
        for (int idx = tid_; idx < 5 * (D / 4); idx += NTHR) { const int b = idx / (D / 4), c4 = (idx % (D / 4)) * 4;
            const float* m = MOD + ((size_t)l * 5 + b) * MODW; const float* mn = MOD + ((size_t)ln * 5 + b) * MODW;
            if (kind != 0) *(LAS f32x4*)(T + RP_GA + b * D + c4) = *(const f32x4*)(m + goff + c4) * *(const f32x4*)(ygain + c4);
            if (!(kind == 2 && last)) { *(LAS f32x4*)(T + RP_NB + b * D + c4) = *(const f32x4*)(ngain + c4) * (*(const f32x4*)(mn + scoff + c4) + 1.f);
                                        *(LAS f32x4*)(T + RP_SH + b * D + c4) = *(const f32x4*)(mn + shoff + c4); } }
        __syncthreads();
    }
    for (int r = vcu * NWAVES + wave; r < nrows; r += G * NWAVES) {
        int b, t, L, isc; rowinfo(r, b, t, L, isc); const int mi = isc ? 4 : b;
        int ln = lane; asm volatile("" : "+v"(ln));
        size_t zo = 0; asm volatile("" : "+s"(zo));
        const LAS float* tab = T + mi * D;
        const float* ypr = (isc && l == 0) ? (const float*)((const bf16_t*)(ws + WS_YP) + (size_t)(r - RX) * D + zo) : nullptr;
        const float* xin0 = (isc ? kp->in[IN_CTX] + (size_t)(r - RX) * D : kp->in[IN_X] + (size_t)r * D) + zo;
        bf16_t* XB = (bf16_t*)XR;
        if (kind == 0) rowpass_row(xin0, nullptr, nullptr, nullptr, nullptr, nullptr, H + (size_t)r * D, tab, ln);
        else if (kind == 1) rowpass_row(xin0, (l == 0) ? nullptr : XB + (size_t)r * D + zo, Y + (size_t)r * D, ypr, nullptr, XB + (size_t)r * D, H + (size_t)r * D, tab, ln);
        else if (!last) rowpass_row(nullptr, XB + (size_t)r * D + zo, Y + (size_t)r * D, ypr, nullptr, XB + (size_t)r * D, H + (size_t)r * D, tab, ln);
        else rowpass_row(nullptr, XB + (size_t)r * D + zo, Y + (size_t)r * D, nullptr, kp->out + (size_t)r * D, nullptr, nullptr, tab, ln);
    }
    __syncthreads();
}

__device__ __forceinline__ void pre_rope(KP kp, unsigned char* ws, int tid_, int vcu, int G) {
    bf16_t* Z = (bf16_t*)(ws + WS_Z); bf16_t* KR = (bf16_t*)(ws + WS_KR); const float2* cs = (const float2*)(ws + WS_CS);
    const int gt = vcu * NTHR + tid_, NGT = G * NTHR;
    for (int idx0 = gt; idx0 < RX * 68; idx0 += 2 * NGT) {
        u32x4 q1[2], q2[2]; f32x4 cq[2][4]; bf16_t* dst[2]; bool ok[2];
#pragma unroll
        for (int k = 0; k < 2; ++k) { const int idx = idx0 + k * NGT; ok[k] = idx < RX * 68; const int id = ok[k] ? idx : gt;
            const int ic = id & 3, v = (id >> 2) % 17, r = id / 68, t = r % SEQ; const int col = (v < 16) ? Z_Q + v * 64 : Z_KR;
            const bf16_t* src = Z + (size_t)r * ZLD + col + ic * 8; q1[k] = ld16(src); q2[k] = ld16(src + 32);
            const f32x4* cp = (const f32x4*)(cs + t * 32 + ic * 8);
#pragma unroll
            for (int q = 0; q < 4; ++q) cq[k][q] = cp[q];
            dst[k] = (v < 16) ? Z + (size_t)r * ZLD + col + ic * 8 : KR + (size_t)r * 64 + ic * 8; }
#pragma unroll
        for (int k = 0; k < 2; ++k) { float x1[8], x2[8], o1[8], o2[8]; unpack8(q1[k], x1); unpack8(q2[k], x2);
#pragma unroll
            for (int q = 0; q < 4; ++q) { const f32x4 c2 = cq[k][q];
                o1[2 * q] = x1[2 * q] * c2.x - x2[2 * q] * c2.y; o2[2 * q] = x1[2 * q] * c2.y + x2[2 * q] * c2.x;
                o1[2 * q + 1] = x1[2 * q + 1] * c2.z - x2[2 * q + 1] * c2.w; o2[2 * q + 1] = x1[2 * q + 1] * c2.w + x2[2 * q + 1] * c2.z; }
            if (ok[k]) { st16(dst[k], pack8(o1)); st16(dst[k] + 32, pack8(o2)); } }
    }
    for (int idx = gt; idx < RC * 8; idx += NGT) { const int r = RX + idx / 8, ch = idx % 8; st16(KR + (size_t)r * 64 + ch * 8, ld16(Z + (size_t)r * ZLD + Z_KR + ch * 8)); }
}
__device__ __forceinline__ void pre_conv(KP kp, unsigned char* ws, int tid_, int l, int vcu, int G) {
    const bf16_t* Z = (const bf16_t*)(ws + WS_Z); bf16_t* MIX = (bf16_t*)(ws + WS_MIX);
    const float* cw = kp->in[IN_CONVW] + (size_t)l * 3 * 512;
    const int gt = vcu * NTHR + tid_, NGT = G * NTHR;
    for (int idx0 = gt; idx0 < R * 64; idx0 += 2 * NGT) {
        u32x4 gcq[2][3], hq[2][3], gbq[2]; int rr[2], cc[2]; bool ok[2];
#pragma unroll
        for (int k = 0; k < 2; ++k) { const int idx = idx0 + k * NGT; ok[k] = idx < R * 64; const int id = ok[k] ? idx : gt;
            const int ch = id & 63, r = id >> 6, c0 = ch * 8; int b, t, L, isc; rowinfo(r, b, t, L, isc); rr[k] = r; cc[k] = c0;
#pragma unroll
            for (int j = 0; j < 3; ++j) { const int tt = t + j - 1; const bool in = (tt >= 0 && tt < L); const bf16_t* zr = Z + (size_t)(in ? r + j - 1 : r) * ZLD;
                gcq[k][j] = in ? ld16(zr + Z_GC + c0) : (u32x4){0u, 0u, 0u, 0u}; hq[k][j] = ld16(zr + Z_H + c0); }
            gbq[k] = ld16(Z + (size_t)r * ZLD + Z_GB + c0); }
#pragma unroll
        for (int k = 0; k < 2; ++k) { float s[8];
#pragma unroll
            for (int e = 0; e < 8; ++e) s[e] = 0.f;
#pragma unroll
            for (int j = 0; j < 3; ++j) { float gc[8], hh[8]; unpack8(gcq[k][j], gc); unpack8(hq[k][j], hh);
                const f32x4 w0 = *(const f32x4*)(cw + j * 512 + cc[k]), w1 = *(const f32x4*)(cw + j * 512 + cc[k] + 4);
                s[0] += w0.x * gc[0] * hh[0]; s[1] += w0.y * gc[1] * hh[1]; s[2] += w0.z * gc[2] * hh[2]; s[3] += w0.w * gc[3] * hh[3];
                s[4] += w1.x * gc[4] * hh[4]; s[5] += w1.y * gc[5] * hh[5]; s[6] += w1.z * gc[6] * hh[6]; s[7] += w1.w * gc[7] * hh[7]; }
            float gb[8]; unpack8(gbq[k], gb);
#pragma unroll
            for (int e = 0; e < 8; ++e) s[e] *= gb[e];
            if (ok[k]) st16(MIX + (size_t)rr[k] * D + 1536 + cc[k], pack8(s)); }
    }
}
__device__ __forceinline__ void pre_pool(KP kp, unsigned char* ws, int tid_, int l, int vcu, int G) {
    const bf16_t* Z = (const bf16_t*)(ws + WS_Z); bf16_t* MIX = (bf16_t*)(ws + WS_MIX);
    const int gt = vcu * NTHR + tid_, NGT = G * NTHR;
    for (int idx = gt; idx < (R / 8) * 64; idx += NGT) {
        const int ch = idx & 63, strip = idx >> 6, r0 = strip * 8, c0 = ch * 8, g = c0 >> 7, half = 1 << g; int b, t0, L, isc; rowinfo(r0, b, t0, L, isc);
        u32x4 q[24];
#pragma unroll
        for (int i = 0; i < 24; ++i) { const int tt = t0 - 8 + i; const bool ok = (tt >= 0 && tt < L && i >= 8 - half && i < 16 + half);
            q[i] = ok ? ld16(Z + (size_t)(r0 - 8 + i) * ZLD + Z_POOL + c0) : (u32x4){0u, 0u, 0u, 0u}; }
        float sum[8];
#pragma unroll
        for (int e = 0; e < 8; ++e) sum[e] = 0.f;
#pragma unroll
        for (int i = 0; i < 16; ++i) { if (i >= 8 - half && i < 8 + half) { float v[8]; unpack8(q[i], v);
#pragma unroll
                for (int e = 0; e < 8; ++e) sum[e] += v[e]; } }
#pragma unroll
        for (int j = 0; j < 8; ++j) {
            const int t = t0 + j; int lo = t - half; if (lo < 0) lo = 0; int hi = t + half; if (hi > L) hi = L;
            const float inv = 1.0f / (float)(hi - lo);
            float self[8], o[8]; unpack8(q[8 + j], self);
#pragma unroll
            for (int e = 0; e < 8; ++e) o[e] = sum[e] * inv - self[e];
            st16(MIX + (size_t)(r0 + j) * D + c0, pack8(o));
            if (j < 7) {
                float dv[8], av[8];
                const u32x4 dq = (half == 1) ? q[7 + j] : (half == 2) ? q[6 + j] : (half == 4) ? q[4 + j] : q[j];
                const u32x4 aq = (half == 1) ? q[9 + j] : (half == 2) ? q[10 + j] : (half == 4) ? q[12 + j] : q[16 + j];
                unpack8(dq, dv); unpack8(aq, av);
#pragma unroll
                for (int e = 0; e < 8; ++e) sum[e] += av[e] - dv[e]; }
        }
    }
}
__device__ __forceinline__ void phase_act(KP kp, unsigned char* ws, int tid_, int l, int vcu, int G, size_t out_off = WS_ACT) {
    const bf16_t* U = (const bf16_t*)(ws + WS_U); bf16_t* ACT = (bf16_t*)(ws + out_off);
    const float* cw = kp->in[IN_FFNCONVW] + (size_t)l * 3 * UFF;
    const int nrows = (l == 1) ? RX : R;
    const int gt = vcu * NTHR + tid_, NGT = G * NTHR;
    for (int idx = gt; idx < (nrows / 8) * 704; idx += NGT) {
        const int chn = idx % 704, strip = idx / 704, r0 = strip * 8, j0 = chn * 8; int b, t0, L, isc; rowinfo(r0, b, t0, L, isc);
        const bf16_t* ub = U + (size_t)r0 * UFF + j0;
        u32x4 gq[10], vq[10];
#pragma unroll
        for (int i = 0; i < 10; ++i) { const int tt = t0 + i - 1; const bool ok = (tt >= 0 && tt < L);
            gq[i] = ok ? ld16(ub + (ptrdiff_t)(i - 1) * UFF) : (u32x4){0u, 0u, 0u, 0u}; vq[i] = ok ? ld16(ub + (ptrdiff_t)(i - 1) * UFF + DFF) : (u32x4){0u, 0u, 0u, 0u}; }
        float wg[3][8], wv[3][8];
#pragma unroll
        for (int k = 0; k < 3; ++k) { const f32x4 a0 = *(const f32x4*)(cw + k * UFF + j0), a1 = *(const f32x4*)(cw + k * UFF + j0 + 4), b0 = *(const f32x4*)(cw + k * UFF + DFF + j0), b1 = *(const f32x4*)(cw + k * UFF + DFF + j0 + 4);
            wg[k][0] = a0.x; wg[k][1] = a0.y; wg[k][2] = a0.z; wg[k][3] = a0.w; wg[k][4] = a1.x; wg[k][5] = a1.y; wg[k][6] = a1.z; wg[k][7] = a1.w;
            wv[k][0] = b0.x; wv[k][1] = b0.y; wv[k][2] = b0.z; wv[k][3] = b0.w; wv[k][4] = b1.x; wv[k][5] = b1.y; wv[k][6] = b1.z; wv[k][7] = b1.w; }
#pragma unroll
        for (int i = 0; i < 8; ++i) {
            float pg[8], cg_[8], ng[8], pv[8], cv[8], nv[8], o[8];
            unpack8(gq[i], pg); unpack8(gq[i + 1], cg_); unpack8(gq[i + 2], ng); unpack8(vq[i], pv); unpack8(vq[i + 1], cv); unpack8(vq[i + 2], nv);
#pragma unroll
            for (int e = 0; e < 8; ++e) { const float gsum = wg[0][e] * pg[e] + wg[1][e] * cg_[e] + wg[2][e] * ng[e]; const float vsum = wv[0][e] * pv[e] + wv[1][e] * cv[e] + wv[2][e] * nv[e];
                o[e] = gsum * __builtin_amdgcn_rcpf(1.f + __expf(-gsum)) * vsum; }
            st16(ACT + (size_t)(r0 + i) * DFF + j0, pack8(o));
        }
    }
}

__device__ __forceinline__ void phase_act_edges(KP kp, unsigned char* ws, int tid_, int l, int vcu, int G) {
    const bf16_t* EDGE = (const bf16_t*)(ws + WS_EDGE); bf16_t* ACT = (bf16_t*)(ws + WS_ACT);
    const float* cw = kp->in[IN_FFNCONVW] + (size_t)l * 3 * UFF;
    const int ntile = ((l == 1) ? RX : R) / 256;
    const int gt = vcu * NTHR + tid_, NGT = G * NTHR;
    for (int idx = gt; idx < ntile * 2 * 704; idx += NGT) {
        const int chn = idx % 704, which = (idx / 704) & 1, pm = idx / 1408, j0 = chn * 8;
        const bool seq_first = (pm >= RX / 256) || (pm % (SEQ / 256) == 0), seq_last = (pm >= RX / 256) || (pm % (SEQ / 256) == SEQ / 256 - 1);
        const bf16_t* e0 = EDGE + (size_t)pm * 4 * UFF + j0;
        const bf16_t* pr = which == 0 ? (seq_first ? nullptr : e0 - (size_t)4 * UFF + (size_t)3 * UFF) : e0 + (size_t)2 * UFF;
        const bf16_t* cu = which == 0 ? e0 : e0 + (size_t)3 * UFF;
        const bf16_t* nx = which == 0 ? e0 + (size_t)1 * UFF : (seq_last ? nullptr : e0 + (size_t)4 * UFF);
        float pg[8], pv[8], cg_[8], cv[8], ng[8], nv[8], o[8];
        if (pr) { unpack8(ld16(pr), pg); unpack8(ld16(pr + DFF), pv); } else {
#pragma unroll
            for (int e = 0; e < 8; ++e) { pg[e] = 0.f; pv[e] = 0.f; } }
        unpack8(ld16(cu), cg_); unpack8(ld16(cu + DFF), cv);
        if (nx) { unpack8(ld16(nx), ng); unpack8(ld16(nx + DFF), nv); } else {
#pragma unroll
            for (int e = 0; e < 8; ++e) { ng[e] = 0.f; nv[e] = 0.f; } }
#pragma unroll
        for (int e = 0; e < 8; ++e) { const float gsum = cw[0 * UFF + j0 + e] * pg[e] + cw[1 * UFF + j0 + e] * cg_[e] + cw[2 * UFF + j0 + e] * ng[e];
            const float vsum = cw[0 * UFF + DFF + j0 + e] * pv[e] + cw[1 * UFF + DFF + j0 + e] * cv[e] + cw[2 * UFF + DFF + j0 + e] * nv[e];
            o[e] = gsum * __builtin_amdgcn_rcpf(1.f + __expf(-gsum)) * vsum; }
        st16(ACT + (size_t)(pm * 256 + (which ? 255 : 0)) * DFF + j0, pack8(o));
    }
}

namespace pg8 {
constexpr int BM = 256, BK = 64, HALF = 128, HTB = HALF * BK * 2, STAGE_BYTES = 8 * HTB, NXCD = 8, WGM = 8;
__host__ __device__ __forceinline__ int lds_byte(int r, int c) { const int st = (r >> 4) * 2 + (c >> 5), rr = r & 15, cc = c & 31, ob = rr * 64 + cc * 2; return st * 1024 + (ob ^ (((ob >> 9) & 1) << 5)); }
__host__ __device__ __forceinline__ void stage_rc(int b, int& R_, int& C_) { const int st = b / 1024, sb = b % 1024, swz = sb ^ (((sb >> 9) & 1) << 5); R_ = (st >> 1) * 16 + swz / 64; C_ = (st & 1) * 32 + (swz % 64) / 2; }
__host__ __device__ __forceinline__ int perm32(int rho) { const int n = rho >> 4, i = rho & 15; return 8 * (i >> 2) + 4 * n + (i & 3); }
struct Unit { int pm, pn, kt0, nkt, part; };
struct Gemm { const bf16_t* A; const bf16_t* Bt; int lda, ldb, K; };
struct TileOrder {
    int nM, nN, nwg, G, c, nt, nMs, ksplit;
    __device__ void init(int nM_, int nN_, int G_, int c_, int nt_, int nMs_ = 0, int ksplit_ = 1) { nM = nM_; nN = nN_; nwg = nM * nN; G = G_; c = c_; nt = nt_; nMs = nMs_; ksplit = ksplit_; }
    __device__ __forceinline__ bool next(int i, Unit& u) const {
        const int L = i * G + c; const int nsp = nMs * nN * ksplit; if (L >= nwg + nsp) return false;
        const bool sp = (L >= nwg);
        const int j = sp ? L - nwg : 0, part = j % ksplit, t = j / ksplit, nk = nt / ksplit;
        int wgid = sp ? 0 : L; { const int q = nwg / NXCD, r = nwg % NXCD, xcd = wgid % NXCD, off = wgid / NXCD; wgid = (xcd < r ? xcd * (q + 1) : r * (q + 1) + (xcd - r) * q) + off; }
        const int nig = WGM * nN, gid = wgid / nig, fm = gid * WGM, gsz = (nM - fm) < WGM ? (nM - fm) : WGM;
        const int pm0 = fm + ((wgid % nig) % gsz), pn0 = (wgid % nig) / gsz;
        u.pm = sp ? nM + t / nN : pm0; u.pn = sp ? t % nN : pn0; u.kt0 = sp ? part * nk : 0; u.nkt = sp ? nk : nt; u.part = sp ? part : 0;
        return true;
    }
};
typedef f32x4 Acc[2][2][4][2];
template <class T, class = void> struct epi_aperm { static constexpr bool value = false; };
template <class T> struct epi_aperm<T, decltype((void)T::APERM)> { static constexpr bool value = true; };
template <class T, class = void> struct epi_prefetch { static constexpr bool value = false; };
template <class T> struct epi_prefetch<T, decltype((void)T::PREFETCH)> { static constexpr bool value = true; };
template <class Epi, class Sched, bool ALIGN_EPI>
__device__ __forceinline__ void gemm_phase(LAS unsigned char* lds, const Gemm g, const Sched& S, const Epi& E, int tid) {
    const int wid = __builtin_amdgcn_readfirstlane(tid >> 6), lane = tid & 63, wr = wid >> 2, wc = wid & 3, fr = lane & 15, fq = lane >> 4;
    unsigned voffA[2], voffB[2];
#pragma unroll
    for (int i = 0; i < 2; ++i) { int R_, C_; stage_rc(tid * 16 + i * 8192, R_, C_); const int Rb = Epi::PERM ? ((R_ & ~31) + perm32(R_ & 31)) : R_;
        const int Ra = epi_aperm<Epi>::value ? ((R_ & ~63) + ((R_ & 15) << 2) + ((R_ >> 4) & 3)) : R_;
        voffA[i] = (unsigned)(Ra * g.lda + C_) * 2u; voffB[i] = (unsigned)(Rb * g.ldb + C_) * 2u; }
    const size_t kstep = (size_t)(BK * 2);
    const size_t hstepA = (size_t)HALF * g.lda * 2, hstepB = (size_t)HALF * g.ldb * 2;
    const size_t tstepA = 2 * hstepA, tstepB = 2 * hstepB;
    const unsigned ldsw = (unsigned)wid * 1024u;
    const int aoff = lds_byte(wr * 64 + fr, fq * 8), boff = lds_byte(wc * 32 + fr, fq * 8);
#define PG8_SA(b, h) (((b) * 2 + (h)) * HTB)
#define PG8_SB(b, h) ((4 + (b) * 2 + (h)) * HTB)
#define PG8_STAGE(bufoff, gbase, voff) do { _Pragma("unroll") for (int _i = 0; _i < 2; ++_i) \
        __builtin_amdgcn_global_load_lds((const unsigned*)((const char*)(gbase) + (voff)[_i]), (LAS unsigned*)(lds + (bufoff) + ldsw + _i * 8192), 16, 0, 0); } while (0)
#define PG8_LDA(dst, b, h) do { _Pragma("unroll") for (int m = 0; m < 4; ++m) _Pragma("unroll") for (int k = 0; k < 2; ++k) dst[m][k] = *(const LAS bf16x8*)(lds + PG8_SA(b, h) + aoff + m * 2048 + k * 1024); } while (0)
#define PG8_LDB(dst, b, h) do { _Pragma("unroll") for (int n = 0; n < 2; ++n) _Pragma("unroll") for (int k = 0; k < 2; ++k) dst[n][k] = *(const LAS bf16x8*)(lds + PG8_SB(b, h) + boff + n * 2048 + k * 1024); } while (0)
#define PG8_MMA(ai, bj, At, Bt) do { __builtin_amdgcn_s_setprio(1); _Pragma("unroll") for (int m = 0; m < 4; ++m) _Pragma("unroll") for (int n = 0; n < 2; ++n) _Pragma("unroll") for (int k = 0; k < 2; ++k) \
        acc[ai][bj][m][n] = __builtin_amdgcn_mfma_f32_16x16x32_bf16(Bt[n][k], At[m][k], acc[ai][bj][m][n], 0, 0, 0); __builtin_amdgcn_s_setprio(0); } while (0)
#define PG8_WAIT_V(n) asm volatile("s_waitcnt vmcnt(" #n ")" ::: "memory")
#define PG8_WAIT_L(n) asm volatile("s_waitcnt lgkmcnt(" #n ")" ::: "memory")
#define PG8_BAR __builtin_amdgcn_s_barrier()
#define PG8_SCHED __builtin_amdgcn_sched_barrier(0)
    Unit cur, nxt; int ui = 0;
    if (!S.next(0, cur)) return;
#ifdef PROBE_G
    unsigned long long pe_tot = 0;
#endif
    f32x4 acc[2][2][4][2];
#pragma unroll
    for (int a = 0; a < 2; ++a)
#pragma unroll
        for (int b = 0; b < 2; ++b)
#pragma unroll
            for (int m = 0; m < 4; ++m)
#pragma unroll
                for (int n = 0; n < 2; ++n) acc[a][b][m][n] = (f32x4){0.f, 0.f, 0.f, 0.f};
    bf16x8 At[4][2], B0[2][2], B1[2][2];
    const char* cA = (const char*)g.A + (size_t)cur.pm * tstepA + (size_t)cur.kt0 * kstep; const char* cB = (const char*)g.Bt + (size_t)cur.pn * tstepB + (size_t)cur.kt0 * kstep;
    int nt = cur.nkt;
    if constexpr (epi_prefetch<Epi>::value) E.prefetch(cur, 0, wid, lane);
    PG8_STAGE(PG8_SB(0, 0), cB, voffB); PG8_STAGE(PG8_SB(0, 1), cB + hstepB, voffB); PG8_STAGE(PG8_SA(0, 0), cA, voffA); PG8_STAGE(PG8_SA(0, 1), cA + hstepA, voffA);
    if (wr == 1) PG8_BAR;
    PG8_WAIT_V(2); PG8_BAR;
    PG8_STAGE(PG8_SB(1, 0), cB + kstep, voffB); PG8_STAGE(PG8_SA(1, 0), cA + kstep, voffA); PG8_STAGE(PG8_SB(1, 1), cB + hstepB + kstep, voffB);
    PG8_WAIT_V(6); PG8_BAR;
    for (;;) {
        const bool has_next = S.next(ui + 1, nxt);
        const char* nA = has_next ? (const char*)g.A + (size_t)nxt.pm * tstepA + (size_t)nxt.kt0 * kstep : cA; const char* nB = has_next ? (const char*)g.Bt + (size_t)nxt.pn * tstepB + (size_t)nxt.kt0 * kstep : cB;
#pragma unroll 1
        for (int t = 0; t < nt; t += 2) {
            const bool last = (t == nt - 2);
            const char* a1 = cA + (size_t)(t + 1) * kstep;
            const char* a2 = last ? nA : cA + (size_t)(t + 2) * kstep; const char* b2 = last ? nB : cB + (size_t)(t + 2) * kstep;
            const char* a3 = a2 + kstep; const char* b3 = b2 + kstep;
            PG8_LDB(B0, 0, 0); PG8_LDB(B1, 0, 1); PG8_SCHED; PG8_LDA(At, 0, 0); PG8_STAGE(PG8_SA(1, 1), a1 + hstepA, voffA);
            PG8_WAIT_V(8); PG8_WAIT_L(0); PG8_BAR; PG8_MMA(0, 0, At, B0); PG8_MMA(0, 1, At, B1); PG8_BAR; PG8_SCHED;
            PG8_LDA(At, 0, 1); PG8_STAGE(PG8_SB(0, 0), b2, voffB); PG8_STAGE(PG8_SB(0, 1), b2 + hstepB, voffB); PG8_STAGE(PG8_SA(0, 0), a2, voffA);
            PG8_WAIT_V(8); PG8_WAIT_L(0); PG8_BAR; PG8_MMA(1, 0, At, B0); PG8_MMA(1, 1, At, B1); PG8_BAR; PG8_SCHED;
            PG8_LDB(B0, 1, 0); PG8_LDB(B1, 1, 1); PG8_SCHED; PG8_LDA(At, 1, 0); PG8_STAGE(PG8_SA(0, 1), a2 + hstepA, voffA);
            PG8_WAIT_V(8); PG8_WAIT_L(0); PG8_BAR; PG8_MMA(0, 0, At, B0); PG8_MMA(0, 1, At, B1); PG8_BAR; PG8_SCHED;
            PG8_LDA(At, 1, 1); PG8_STAGE(PG8_SB(1, 0), b3, voffB); PG8_STAGE(PG8_SB(1, 1), b3 + hstepB, voffB); PG8_STAGE(PG8_SA(1, 0), a3, voffA);
            PG8_WAIT_V(8); PG8_WAIT_L(0); PG8_BAR; PG8_MMA(1, 0, At, B0); PG8_MMA(1, 1, At, B1); PG8_BAR; PG8_SCHED;
        }
        if constexpr (ALIGN_EPI) { if (wr == 0) PG8_BAR; }
#ifdef PROBE_G
        const unsigned long long pe0 = __builtin_amdgcn_s_memrealtime();
#endif
        if constexpr (epi_prefetch<Epi>::value) E.run(acc, cur, wr, wc, fr, fq, ui & 1); else E(acc, cur, wr, wc, fr, fq);
#ifdef PROBE_G
        pe_tot += __builtin_amdgcn_s_memrealtime() - pe0;
#endif
        if (!has_next) break;
#pragma unroll
        for (int a = 0; a < 2; ++a)
#pragma unroll
            for (int b = 0; b < 2; ++b)
#pragma unroll
                for (int m = 0; m < 4; ++m)
#pragma unroll
                    for (int n = 0; n < 2; ++n) acc[a][b][m][n] = (f32x4){0.f, 0.f, 0.f, 0.f};
        if constexpr (epi_prefetch<Epi>::value) E.prefetch(nxt, (ui + 1) & 1, wid, lane);
        cur = nxt; cA = nA; cB = nB; nt = cur.nkt; ++ui;
        if constexpr (ALIGN_EPI) { if (wr == 1) PG8_BAR; }
    }
    PG8_WAIT_V(0);
    if constexpr (!ALIGN_EPI) { if (wr == 0) PG8_BAR; }
    PG8_BAR;
#ifdef PROBE_G
    if (tid == 0) *(volatile LAS unsigned long long*)(lds + MISC_OFF + 32) = pe_tot;
#endif
#undef PG8_SA
#undef PG8_SB
#undef PG8_STAGE
#undef PG8_LDA
#undef PG8_LDB
#undef PG8_MMA
#undef PG8_WAIT_V
#undef PG8_WAIT_L
#undef PG8_BAR
#undef PG8_SCHED
}

struct EpiF32 {
    static constexpr bool PERM = false;
    float* C; int ldc; float* Cp; int pm_split; size_t part_stride;
    __device__ __forceinline__ void operator()(const Acc& acc, const Unit& u, int wr, int wc, int fr, int fq) const {
        const int col0 = u.pn * BM + wc * 32 + 4 * fq;
        float* base = C; int row0 = u.pm * BM + wr * 64 + fr;
        if (u.part > 0) { base = Cp + (size_t)(u.part - 1) * part_stride; row0 -= pm_split * BM; }
#pragma unroll
        for (int ai = 0; ai < 2; ++ai)
#pragma unroll
            for (int m = 0; m < 4; ++m) { float* rowp = base + (size_t)(row0 + ai * HALF + m * 16) * ldc + col0;
#pragma unroll
                for (int bj = 0; bj < 2; ++bj)
#pragma unroll
                    for (int n = 0; n < 2; ++n) *(f32x4*)(rowp + bj * HALF + n * 16) = acc[ai][bj][m][n]; }
    }
};
struct EpiY {
    static constexpr bool PERM = true;
    bf16_t* Y; float* Cp; int pm_split; size_t part_stride;
    __device__ __forceinline__ void operator()(const Acc& acc, const Unit& u, int wr, int wc, int fr, int fq) const {
        const int row0 = u.pm * BM + wr * 64 + fr, col0 = u.pn * BM + wc * 32 + 8 * fq;
        if (u.part > 0) {
            bf16_t* base = (bf16_t*)Cp + (size_t)(u.part - 1) * part_stride;
#pragma unroll
            for (int ai = 0; ai < 2; ++ai)
#pragma unroll
                for (int m = 0; m < 4; ++m) { bf16_t* rowp = base + (size_t)(row0 - pm_split * BM + ai * HALF + m * 16) * D + col0;
#pragma unroll
                    for (int bj = 0; bj < 2; ++bj) { const f32x4 v0 = acc[ai][bj][m][0], v1 = acc[ai][bj][m][1];
                        u32x4 w; w.x = cvt_pk_bf16(v0[0], v0[1]); w.y = cvt_pk_bf16(v0[2], v0[3]); w.z = cvt_pk_bf16(v1[0], v1[1]); w.w = cvt_pk_bf16(v1[2], v1[3]);
                        *(u32x4*)(rowp + bj * HALF) = w; } }
        } else if (u.part == 0) {
#pragma unroll
            for (int ai = 0; ai < 2; ++ai)
#pragma unroll
                for (int m = 0; m < 4; ++m) { bf16_t* rowp = Y + (size_t)(row0 + ai * HALF + m * 16) * D + col0;
#pragma unroll
                    for (int bj = 0; bj < 2; ++bj) { const f32x4 v0 = acc[ai][bj][m][0], v1 = acc[ai][bj][m][1];
                        u32x4 w; w.x = cvt_pk_bf16(v0[0], v0[1]); w.y = cvt_pk_bf16(v0[2], v0[3]); w.z = cvt_pk_bf16(v1[0], v1[1]); w.w = cvt_pk_bf16(v1[2], v1[3]);
                        *(u32x4*)(rowp + bj * HALF) = w; } }
        } else {
            float* base = Cp + (size_t)(u.part - 1) * part_stride;
#pragma unroll
            for (int ai = 0; ai < 2; ++ai)
#pragma unroll
                for (int m = 0; m < 4; ++m) { float* rowp = base + (size_t)(row0 - pm_split * BM + ai * HALF + m * 16) * D + col0;
#pragma unroll
                    for (int bj = 0; bj < 2; ++bj) { *(f32x4*)(rowp + bj * HALF) = acc[ai][bj][m][0]; *(f32x4*)(rowp + bj * HALF + 4) = acc[ai][bj][m][1]; } }
        }
    }
};
struct EpiAct {
    static constexpr bool PERM = true;
    bf16_t* ACT; bf16_t* EDGE; const float* cw; LAS float* hl;
    static constexpr bool PREFETCH = true;
    static constexpr bool APERM = true;
    __device__ __forceinline__ void prefetch(const Unit& u, int slot, int wid, int lane) const {
        if (wid < 3) __builtin_amdgcn_global_load_lds((const unsigned*)(cw + (size_t)wid * UFF + (lane >> 5) * DFF + u.pn * 128 + 4 * (lane & 31)), (LAS unsigned*)(hl + 2048 + slot * 768 + wid * 256), 16, 0, 0);
    }
    __device__ __forceinline__ void run(const Acc& acc, const Unit& u, int wr, int wc, int fr, int fq, int slot) const {
        const LAS float* wl = hl + 2048 + slot * 768;
        const int ch0 = u.pn * 128 + wc * 32 + 8 * fq;
        const int colh = wc * 32 + 8 * fq;
#pragma unroll
        for (int ai = 0; ai < 2; ++ai) { const int blk = ai * 2 + wr;
            if (fr == 0) {
#pragma unroll
                for (int bj = 0; bj < 2; ++bj)
#pragma unroll
                    for (int n = 0; n < 2; ++n) *(LAS f32x4*)(hl + (blk * 2 + 0) * 256 + bj * 128 + colh + 4 * n) = acc[ai][bj][0][n]; }
            if (fr == 15) {
#pragma unroll
                for (int bj = 0; bj < 2; ++bj)
#pragma unroll
                    for (int n = 0; n < 2; ++n) *(LAS f32x4*)(hl + (blk * 2 + 1) * 256 + bj * 128 + colh + 4 * n) = acc[ai][bj][3][n]; } }
        asm volatile("s_waitcnt lgkmcnt(0)" ::: "memory"); __builtin_amdgcn_s_barrier(); asm volatile("" ::: "memory");
        const int rowt = u.pm * BM;
#pragma unroll
        for (int ai = 0; ai < 2; ++ai) { const int blk = ai * 2 + wr;
            float o[4][8];
#pragma unroll
            for (int n = 0; n < 2; ++n) {
#pragma unroll
                for (int bj = 0; bj < 2; ++bj) {
                    f32x4 W[3];
#pragma unroll
                    for (int k = 0; k < 3; ++k) W[k] = *(const LAS f32x4*)(wl + k * 256 + bj * 128 + colh + 4 * n);
                    const f32x4 HU = (blk > 0) ? *(const LAS f32x4*)(hl + ((blk - 1) * 2 + 1) * 256 + bj * 128 + colh + 4 * n) : (f32x4){0.f, 0.f, 0.f, 0.f};
                    const f32x4 HD = (blk < 3) ? *(const LAS f32x4*)(hl + ((blk + 1) * 2 + 0) * 256 + bj * 128 + colh + 4 * n) : (f32x4){0.f, 0.f, 0.f, 0.f};
#pragma unroll
                    for (int e = 0; e < 4; ++e) {
                        const float w0 = W[0][e], w1 = W[1][e], w2 = W[2][e];
                        const float v0 = acc[ai][bj][0][n][e], v1 = acc[ai][bj][1][n][e], v2 = acc[ai][bj][2][n][e], v3 = acc[ai][bj][3][n][e];
                        const float up0 = __int_as_float(__builtin_amdgcn_update_dpp(__float_as_int(HU[e]), __float_as_int(v3), 0x111, 0xf, 0xf, false));
                        const float dn3 = __int_as_float(__builtin_amdgcn_update_dpp(__float_as_int(HD[e]), __float_as_int(v0), 0x101, 0xf, 0xf, false));
                        float r_[4];
                        r_[0] = w0 * up0 + w1 * v0 + w2 * v1; r_[1] = w0 * v0 + w1 * v1 + w2 * v2; r_[2] = w0 * v1 + w1 * v2 + w2 * v3; r_[3] = w0 * v2 + w1 * v3 + w2 * dn3;
#pragma unroll
                        for (int m = 0; m < 4; ++m) { if (bj == 0) o[m][4 * n + e] = r_[m] * __builtin_amdgcn_rcpf(1.f + __expf(-r_[m])); else o[m][4 * n + e] *= r_[m]; }
                    }
                }
                __builtin_amdgcn_sched_barrier(0);
            }
#pragma unroll
            for (int m = 0; m < 4; ++m) { const int rl = ai * HALF + wr * 64 + 4 * fr + m;
                if (rl != 0 && rl != 255) *(u32x4*)(ACT + (size_t)(rowt + rl) * DFF + ch0) = pack8(o[m]); }
            __builtin_amdgcn_sched_barrier(0);
        }
#pragma unroll
        for (int ai = 0; ai < 2; ++ai) {
#pragma unroll
            for (int m = 0; m < 4; ++m) { const int rl = ai * HALF + wr * 64 + 4 * fr + m;
                const int ek = (rl == 0) ? 0 : (rl == 1) ? 1 : (rl == 254) ? 2 : (rl == 255) ? 3 : -1;
                if (ek >= 0) {
#pragma unroll
                    for (int bj = 0; bj < 2; ++bj) { const f32x4 v0 = acc[ai][bj][m][0], v1 = acc[ai][bj][m][1];
                        u32x4 w; w.x = cvt_pk_bf16(v0[0], v0[1]); w.y = cvt_pk_bf16(v0[2], v0[3]); w.z = cvt_pk_bf16(v1[0], v1[1]); w.w = cvt_pk_bf16(v1[2], v1[3]);
                        *(u32x4*)(EDGE + ((size_t)u.pm * 4 + ek) * UFF + bj * DFF + ch0) = w; } }
            }
        }
        asm volatile("s_waitcnt lgkmcnt(0)" ::: "memory");
    }
};
struct EpiBf16 {
    static constexpr bool PERM = true;
    bf16_t* O; int ldc;
    __device__ __forceinline__ void operator()(const Acc& acc, const Unit& u, int wr, int wc, int fr, int fq) const {
        const int row0 = u.pm * BM + wr * 64 + fr, col0 = u.pn * BM + wc * 32 + 8 * fq;
#pragma unroll
        for (int ai = 0; ai < 2; ++ai)
#pragma unroll
            for (int m = 0; m < 4; ++m) { bf16_t* rowp = O + (size_t)(row0 + ai * HALF + m * 16) * ldc + col0;
#pragma unroll
                for (int bj = 0; bj < 2; ++bj) { const f32x4 v0 = acc[ai][bj][m][0], v1 = acc[ai][bj][m][1];
                    u32x4 w; w.x = cvt_pk_bf16(v0[0], v0[1]); w.y = cvt_pk_bf16(v0[2], v0[3]); w.z = cvt_pk_bf16(v1[0], v1[1]); w.w = cvt_pk_bf16(v1[2], v1[3]);
                    *(u32x4*)(rowp + bj * HALF) = w; } }
    }
};
struct EpiZ {
    static constexpr bool PERM = true;
    bf16_t* Z; float* rsq;
    __device__ __forceinline__ void operator()(const Acc& acc, const Unit& u, int wr, int wc, int fr, int fq) const {
        const int row0 = u.pm * BM + wr * 64 + fr, col0 = u.pn * BM + wc * 32 + 8 * fq;
#pragma unroll
        for (int ai = 0; ai < 2; ++ai)
#pragma unroll
            for (int m = 0; m < 4; ++m) { bf16_t* rowp = Z + (size_t)(row0 + ai * HALF + m * 16) * ZLD + col0;
#pragma unroll
                for (int bj = 0; bj < 2; ++bj) { const f32x4 v0 = acc[ai][bj][m][0], v1 = acc[ai][bj][m][1];
                    u32x4 w; w.x = cvt_pk_bf16(v0[0], v0[1]); w.y = cvt_pk_bf16(v0[2], v0[3]); w.z = cvt_pk_bf16(v1[0], v1[1]); w.w = cvt_pk_bf16(v1[2], v1[3]);
                    *(u32x4*)(rowp + bj * HALF) = w; } }
        if (u.pn >= 8 && u.pn <= 10) {
#pragma unroll
            for (int bj = 0; bj < 2; ++bj) { const int cb = u.pn * BM + bj * HALF + wc * 32;
                const int region = (cb >= Z_CQ && cb < Z_CKV) ? 0 : ((cb >= Z_CKV && cb < Z_KR) ? 1 : -1);
                if (region >= 0) {
#pragma unroll
                    for (int ai = 0; ai < 2; ++ai)
#pragma unroll
                        for (int m = 0; m < 4; ++m) { const f32x4 v0 = acc[ai][bj][m][0], v1 = acc[ai][bj][m][1];
                            float s = (v0[0] * v0[0] + v0[1] * v0[1]) + (v0[2] * v0[2] + v0[3] * v0[3]) + (v1[0] * v1[0] + v1[1] * v1[1]) + (v1[2] * v1[2] + v1[3] * v1[3]);
                            s += sx(s, 16, fq * 16 + fr); s += sx(s, 32, fq * 16 + fr);
                            if (fq == 0) atomicAdd(rsq + (size_t)(row0 + ai * HALF + m * 16) * 2 + region, s); } } }
        }
    }
};
struct EpiQ {
    static constexpr bool PERM = true;
    bf16_t* QM; const float* rsq; const float2* cs;
    __device__ __forceinline__ void operator()(const Acc& acc, const Unit& u, int wr, int wc, int fr, int fq) const {
        const int row0 = u.pm * BM + wr * 64 + fr;
        float rsv[8];
#pragma unroll
        for (int i = 0; i < 8; ++i) rsv[i] = rsq[(size_t)(row0 + (i >> 2) * HALF + (i & 3) * 16) * 2];
        if (u.pn < 2) {
#pragma unroll
            for (int ai = 0; ai < 2; ++ai)
#pragma unroll
                for (int m = 0; m < 4; ++m) { const int row = row0 + ai * HALF + m * 16; const float rs = __builtin_amdgcn_rsqf(rsv[ai * 4 + m] * (1.f / 384.f) + EPS);
#pragma unroll
                    for (int bj = 0; bj < 2; ++bj) { const f32x4 v0 = acc[ai][bj][m][0] * rs, v1 = acc[ai][bj][m][1] * rs;
                        u32x4 w; w.x = cvt_pk_bf16(v0[0], v0[1]); w.y = cvt_pk_bf16(v0[2], v0[3]); w.z = cvt_pk_bf16(v1[0], v1[1]); w.w = cvt_pk_bf16(v1[2], v1[3]);
                        *(u32x4*)(QM + (size_t)row * 768 + (2 * u.pn + bj) * 192 + wc * 32 + 8 * fq) = w; }
                    asm volatile("" ::: "memory"); }
        } else {
            const bool rope = (u.pm < RX / BM);
            f32x4 cb[2][4];
            if (rope) { const f32x4* cp = (const f32x4*)(cs + (row0 % SEQ) * 32 + 8 * fq);
#pragma unroll
                for (int q = 0; q < 4; ++q) cb[0][q] = cp[q]; }
#pragma unroll
            for (int it = 0; it < 8; ++it) { const int ai = it >> 2, m = it & 3; const int row = row0 + ai * HALF + m * 16; const float rs = __builtin_amdgcn_rsqf(rsv[it] * (1.f / 384.f) + EPS);
                if (rope && it < 7) { const int rown = row0 + ((it + 1) >> 2) * HALF + ((it + 1) & 3) * 16; const f32x4* cp = (const f32x4*)(cs + (rown % SEQ) * 32 + 8 * fq);
#pragma unroll
                    for (int q = 0; q < 4; ++q) cb[(it + 1) & 1][q] = cp[q]; }
                float x1[8], x2[8], o1[8], o2[8];
#pragma unroll
                for (int e = 0; e < 4; ++e) { x1[e] = acc[ai][0][m][0][e] * rs; x1[4 + e] = acc[ai][0][m][1][e] * rs; x2[e] = acc[ai][1][m][0][e] * rs; x2[4 + e] = acc[ai][1][m][1][e] * rs; }
                if (rope) {
#pragma unroll
                    for (int q = 0; q < 4; ++q) { const f32x4 c2 = cb[it & 1][q];
                        o1[2 * q] = x1[2 * q] * c2.x - x2[2 * q] * c2.y; o2[2 * q] = x1[2 * q] * c2.y + x2[2 * q] * c2.x;
                        o1[2 * q + 1] = x1[2 * q + 1] * c2.z - x2[2 * q + 1] * c2.w; o2[2 * q + 1] = x1[2 * q + 1] * c2.w + x2[2 * q + 1] * c2.z; }
                } else {
#pragma unroll
                    for (int e = 0; e < 8; ++e) { o1[e] = x1[e]; o2[e] = x2[e]; } }
                bf16_t* dst = QM + (size_t)row * 768 + wc * 192 + 128 + 8 * fq;
                st16(dst, pack8(o1)); st16(dst + 32, pack8(o2));
                __builtin_amdgcn_sched_barrier(0); }
        }
    }
};
struct EpiKV {
    static constexpr bool PERM = true;
    bf16_t* KN; bf16_t* VM; const float* rsq;
    __device__ __forceinline__ void operator()(const Acc& acc, const Unit& u, int wr, int wc, int fr, int fq) const {
        const int row0 = u.pm * BM + wr * 64 + fr;
        float rsv[8];
#pragma unroll
        for (int i = 0; i < 8; ++i) rsv[i] = rsq[(size_t)(row0 + (i >> 2) * HALF + (i & 3) * 16) * 2 + 1];
#pragma unroll
        for (int ai = 0; ai < 2; ++ai)
#pragma unroll
            for (int m = 0; m < 4; ++m) { const int row = row0 + ai * HALF + m * 16; const float rs = __builtin_amdgcn_rsqf(rsv[ai * 4 + m] * (1.f / 256.f) + EPS);
#pragma unroll
                for (int bj = 0; bj < 2; ++bj) { const f32x4 v0 = acc[ai][bj][m][0] * rs, v1 = acc[ai][bj][m][1] * rs;
                    u32x4 w; w.x = cvt_pk_bf16(v0[0], v0[1]); w.y = cvt_pk_bf16(v0[2], v0[3]); w.z = cvt_pk_bf16(v1[0], v1[1]); w.w = cvt_pk_bf16(v1[2], v1[3]);
                    *(u32x4*)((bj ? VM : KN) + (size_t)row * 512 + u.pn * 128 + wc * 32 + 8 * fq) = w; }
                asm volatile("" ::: "memory"); }
    }
};
template <class Epi>
__device__ __forceinline__ void run(LAS unsigned char* lds, const Gemm g, int nM, int nN, int G, int c, const Epi& E, int tid, int nMs = 0, int ksplit = 1) {
    TileOrder S; S.init(nM, nN, G, c, g.K / BK, nMs, ksplit);
    gemm_phase<Epi, TileOrder, true>(lds, g, S, E, tid);
}
}


namespace att {
constexpr int SHM_V = 64 * 128 * 2;
#define SBAR() __builtin_amdgcn_sched_barrier(0)
__device__ __forceinline__ int crow(int r, int hi) { return (r & 3) + 8 * (r >> 2) + 4 * hi; }
__device__ __forceinline__ void partialSM(f32x16& p0, f32x16& p1, float& m_reg, float& mn, float& alpha, float C, float thr_raw) {
    float pmax = p0[0];
#pragma unroll
    for (int r = 1; r < 16; ++r) pmax = fmaxf(pmax, p0[r]);
#pragma unroll
    for (int r = 0; r < 16; ++r) pmax = fmaxf(pmax, p1[r]);
    { auto rr = __builtin_amdgcn_permlane32_swap(__float_as_uint(pmax), __float_as_uint(pmax), false, false); pmax = fmaxf(__uint_as_float(rr[0]), __uint_as_float(rr[1])); }
    if (__builtin_expect(__all(pmax - m_reg <= thr_raw), 1)) { mn = m_reg; alpha = 1.f; }
    else { mn = fmaxf(m_reg, pmax); alpha = __builtin_amdgcn_exp2f((m_reg - mn) * C); m_reg = mn; }
    const float mnC = -mn * C;
#pragma unroll
    for (int r = 0; r < 16; ++r) p0[r] = fmaf(p0[r], C, mnC);
#pragma unroll
    for (int r = 0; r < 16; ++r) p1[r] = fmaf(p1[r], C, mnC);
#pragma unroll
    for (int r = 0; r < 16; ++r) p0[r] = __builtin_amdgcn_exp2f(p0[r]);
}
__device__ __forceinline__ void finishSM(f32x16& p0, f32x16& p1, float alpha, float& l_reg, bf16x8& pa0, bf16x8& pa1, bf16x8& pa2, bf16x8& pa3) {
#pragma unroll
    for (int r = 0; r < 16; ++r) p1[r] = __builtin_amdgcn_exp2f(p1[r]);
    float ps = 0.f;
#pragma unroll
    for (int r = 0; r < 16; ++r) ps += p0[r];
#pragma unroll
    for (int r = 0; r < 16; ++r) ps += p1[r];
    { auto rr = __builtin_amdgcn_permlane32_swap(__float_as_uint(ps), __float_as_uint(ps), false, false); ps = __uint_as_float(rr[0]) + __uint_as_float(rr[1]); }
    l_reg = l_reg * alpha + ps;
#define PK4(P_, BASE, OUT) do { unsigned a0 = cvt_pk_bf16(P_[BASE + 0], P_[BASE + 1]), a1 = cvt_pk_bf16(P_[BASE + 2], P_[BASE + 3]);   \
    unsigned b0 = cvt_pk_bf16(P_[BASE + 4], P_[BASE + 5]), b1 = cvt_pk_bf16(P_[BASE + 6], P_[BASE + 7]);                              \
    auto r0 = __builtin_amdgcn_permlane32_swap(a0, b0, false, false); auto r1 = __builtin_amdgcn_permlane32_swap(a1, b1, false, false); \
    u32x4 w = {r0[0], r1[0], r0[1], r1[1]}; OUT = *reinterpret_cast<bf16x8*>(&w); } while (0)
    PK4(p0, 0, pa0); PK4(p0, 8, pa1); PK4(p1, 0, pa2); PK4(p1, 8, pa3);
#undef PK4
}
template <int NDQ> __device__ __forceinline__ int kaddr(int row, int cb) { return row * (32 * NDQ) + (cb ^ (((row >> 1) & 7) << 4)); }
template <int NDQ, int NQR>
__device__ __forceinline__ void qkt(f32x16& p0, f32x16& p1, const char* Ks, const bf16x8* qr, const char* ql, int r32, int hi) {
    p0 = f32x16{}; p1 = f32x16{};
#pragma unroll
    for (int d0 = 0; d0 < NDQ; ++d0) { const int cb = d0 * 32 + hi * 16;
        const bf16x8 b0 = *reinterpret_cast<const bf16x8*>(Ks + kaddr<NDQ>(r32, cb));
        const bf16x8 b1 = *reinterpret_cast<const bf16x8*>(Ks + kaddr<NDQ>(32 + r32, cb));
        bf16x8 q; if (d0 < NQR) q = qr[d0]; else q = *reinterpret_cast<const bf16x8*>(ql + (d0 - NQR) * 1024);
        p0 = __builtin_amdgcn_mfma_f32_32x32x16_bf16(b0, q, p0, 0, 0, 0);
        p1 = __builtin_amdgcn_mfma_f32_32x32x16_bf16(b1, q, p1, 0, 0, 0); }
}
__device__ __forceinline__ int v_st(int k, int c) { const int kk = (k & ~0xC) | ((k & 4) << 1) | ((k & 8) >> 1); return ((kk >> 3) * 4 + (c >> 5)) * 512 + ((kk & 7) * 32 + (c & 31)) * 2; }
__device__ __forceinline__ int v_rd_base(int lane) { return ((lane & 3) << 3) | (((lane >> 2) & 3) << 6) | (((lane >> 4) & 1) << 5) | (((lane >> 5) & 1) << 8); }
constexpr int v_rd_off(int d0, int ks, int half) { return d0 * 512 + ks * 4096 + half * 2048; }
template <int OFF> __device__ __forceinline__ s16x4 tr_read(int vb) { s16x4 r; asm volatile("ds_read_b64_tr_b16 %0, %1 offset:%2" : "=&v"(r) : "v"(vb), "i"(OFF) : "memory"); return r; }
template <int D0> __device__ __forceinline__ void pv_one(f32x16& od, int vb, bf16x8 pa0, bf16x8 pa1, bf16x8 pa2, bf16x8 pa3) {
    const s16x4 l0 = tr_read<v_rd_off(D0, 0, 0)>(vb), h0 = tr_read<v_rd_off(D0, 0, 1)>(vb), l1 = tr_read<v_rd_off(D0, 1, 0)>(vb), h1 = tr_read<v_rd_off(D0, 1, 1)>(vb);
    const s16x4 l2 = tr_read<v_rd_off(D0, 2, 0)>(vb), h2 = tr_read<v_rd_off(D0, 2, 1)>(vb), l3 = tr_read<v_rd_off(D0, 3, 0)>(vb), h3 = tr_read<v_rd_off(D0, 3, 1)>(vb);
    asm volatile("s_waitcnt lgkmcnt(0)" ::: "memory"); SBAR();
#define PKV(L_, H_) (bf16x8){L_[0], L_[1], L_[2], L_[3], H_[0], H_[1], H_[2], H_[3]}
    od = __builtin_amdgcn_mfma_f32_32x32x16_bf16(pa0, PKV(l0, h0), od, 0, 0, 0);
    od = __builtin_amdgcn_mfma_f32_32x32x16_bf16(pa1, PKV(l1, h1), od, 0, 0, 0);
    od = __builtin_amdgcn_mfma_f32_32x32x16_bf16(pa2, PKV(l2, h2), od, 0, 0, 0);
    od = __builtin_amdgcn_mfma_f32_32x32x16_bf16(pa3, PKV(l3, h3), od, 0, 0, 0);
#undef PKV
}
__device__ __forceinline__ void pv_d0(f32x16* o, int vb, bf16x8 pa0, bf16x8 pa1, bf16x8 pa2, bf16x8 pa3) {
    pv_one<0>(o[0], vb, pa0, pa1, pa2, pa3); pv_one<1>(o[1], vb, pa0, pa1, pa2, pa3); pv_one<2>(o[2], vb, pa0, pa1, pa2, pa3); pv_one<3>(o[3], vb, pa0, pa1, pa2, pa3);
}
template <int NDQ, int SD>
__device__ __forceinline__ void attn_body(const bf16_t* __restrict__ Qw, int ldq, const bf16_t* __restrict__ Kg, int ldk, const bf16_t* __restrict__ Krg, const bf16_t* __restrict__ Vg, int ldv,
                                          int xrow0, int nxt, int crow0, int NT, float C, char* lds, int tid, f32x16 (&o)[4], float (&rli)[16]) {
    constexpr int SHM_K = 64 * 32 * NDQ;
    const int wid = tid >> 6, lane = tid & 63, r32 = lane & 31, hi = lane >> 5;
    char* V_lds = lds; char* K_lds = lds + 2 * SHM_V;
    float* wsf = (float*)(lds + 2 * SHM_V + 2 * SHM_K) + wid * 64; float* li_l = wsf; float* al_l = wsf + 32;
    const float thr_raw = 8.f * 1.4426950408889634f / C;
    constexpr int NQR = (NDQ > 8) ? 6 : NDQ;
    char* ql = lds + 2 * SHM_V + 2 * SHM_K + 2048 + wid * ((NDQ - NQR) * 1024) + lane * 16;
    float m_reg = -1e30f, l_reg = 0.f; bf16x8 qr[NQR];
#pragma unroll
    for (int d0 = 0; d0 < 4; ++d0) o[d0] = f32x16{};
    const bf16_t* Ql = Qw + (size_t)r32 * ldq + hi * 8;
    __syncthreads();
#pragma unroll
    for (int d0 = 0; d0 < NDQ; ++d0) { const bf16x8 q = *reinterpret_cast<const bf16x8*>(Ql + d0 * 16); if (d0 < NQR) qr[d0] = q; else *reinterpret_cast<bf16x8*>(ql + (d0 - NQR) * 1024) = q; }
    const int sr = tid >> 4, sc = (tid & 15) * 8, vst0 = v_st(sr, sc), vst1 = v_st(32 + sr, sc);
    const int k8r = tid >> 3, k8c = (tid & 7) * 8;
    const int vb0 = (int)(uintptr_t)V_lds + v_rd_base(lane);
    bf16x8 vsA0, vsA1, ksA0, ksA1, ksA2, vsB0, vsB1, ksB0, ksB1, ksB2;
#define KROW(j) ((j) < nxt ? xrow0 + 64 * (j) : crow0 + 64 * ((j) - nxt))
#define SLOAD(S_, j) do { const int row0_ = KROW(j); \
        vs##S_##0 = *reinterpret_cast<const bf16x8*>(Vg + (size_t)(row0_ + sr) * ldv + sc); vs##S_##1 = *reinterpret_cast<const bf16x8*>(Vg + (size_t)(row0_ + 32 + sr) * ldv + sc); \
        if constexpr (NDQ == 4) { ks##S_##0 = *reinterpret_cast<const bf16x8*>(Kg + (size_t)(row0_ + k8r) * ldk + k8c); } \
        else { ks##S_##0 = *reinterpret_cast<const bf16x8*>(Kg + (size_t)(row0_ + sr) * ldk + sc); ks##S_##1 = *reinterpret_cast<const bf16x8*>(Kg + (size_t)(row0_ + 32 + sr) * ldk + sc); \
               ks##S_##2 = *reinterpret_cast<const bf16x8*>(Krg + (size_t)(row0_ + k8r) * 64 + k8c); } } while (0)
#define SWRITE(b, S_) do { *(bf16x8*)(V_lds + (b) * SHM_V + vst0) = vs##S_##0; *(bf16x8*)(V_lds + (b) * SHM_V + vst1) = vs##S_##1; \
        if constexpr (NDQ == 4) { *(bf16x8*)(K_lds + (b) * SHM_K + kaddr<NDQ>(k8r, k8c * 2)) = ks##S_##0; } \
        else { *(bf16x8*)(K_lds + (b) * SHM_K + kaddr<NDQ>(sr, sc * 2)) = ks##S_##0; *(bf16x8*)(K_lds + (b) * SHM_K + kaddr<NDQ>(32 + sr, sc * 2)) = ks##S_##1; \
               *(bf16x8*)(K_lds + (b) * SHM_K + kaddr<NDQ>(k8r, 256 + k8c * 2)) = ks##S_##2; } } while (0)
#define SLOAD_B(j) do { if constexpr (SD == 2) SLOAD(B, j); else SLOAD(A, j); } while (0)
#define SWRITE_B(b) do { if constexpr (SD == 2) SWRITE(b, B); else SWRITE(b, A); } while (0)
#define SWAIT() do { if constexpr (SD == 1) asm volatile("s_waitcnt vmcnt(0)" ::: "memory"); else if constexpr (NDQ == 4) asm volatile("s_waitcnt vmcnt(3)" ::: "memory"); else asm volatile("s_waitcnt vmcnt(5)" ::: "memory"); } while (0)
#define RESC(a) do { if (__any((a) < 1.f)) { if (hi == 0) al_l[r32] = (a); asm volatile("s_waitcnt lgkmcnt(0)" ::: "memory"); \
        _Pragma("unroll") for (int d = 0; d < 4; ++d) _Pragma("unroll") for (int r = 0; r < 16; ++r) o[d][r] *= al_l[crow(r, hi)]; } } while (0)
    f32x16 pA0, pA1, pB0, pB1; float mnA, mnB, alA, alB; bf16x8 pa0, pa1, pa2, pa3;
    SLOAD(A, 0); asm volatile("s_waitcnt vmcnt(0)" ::: "memory"); SWRITE(0, A); __syncthreads();
    qkt<NDQ, NQR>(pA0, pA1, K_lds, qr, ql, r32, hi); partialSM(pA0, pA1, m_reg, mnA, alA, C, thr_raw);
    SLOAD_B(1); if constexpr (SD == 2) { if (2 < NT) SLOAD(A, 2); }
    SWAIT(); SWRITE_B(1); __syncthreads();
    for (int j = 1; j + 1 < NT; j += 2) {
        SBAR(); qkt<NDQ, NQR>(pB0, pB1, K_lds + SHM_K, qr, ql, r32, hi);
        finishSM(pA0, pA1, alA, l_reg, pa0, pa1, pa2, pa3); SBAR();
        SLOAD_B(j + SD); SBAR();
        pv_d0(o, vb0, pa0, pa1, pa2, pa3); partialSM(pB0, pB1, m_reg, mnB, alB, C, thr_raw);
        __syncthreads(); SWAIT(); SWRITE(0, A);
        RESC(alB); __syncthreads();
        SBAR(); qkt<NDQ, NQR>(pA0, pA1, K_lds, qr, ql, r32, hi);
        finishSM(pB0, pB1, alB, l_reg, pa0, pa1, pa2, pa3); SBAR();
        if (SD == 1 || j + 3 < NT) SLOAD(A, j + 1 + SD); SBAR();
        pv_d0(o, vb0 + SHM_V, pa0, pa1, pa2, pa3); partialSM(pA0, pA1, m_reg, mnA, alA, C, thr_raw);
        __syncthreads(); SWAIT(); SWRITE_B(1);
        RESC(alA); __syncthreads();
    }
    SBAR(); qkt<NDQ, NQR>(pB0, pB1, K_lds + SHM_K, qr, ql, r32, hi);
    finishSM(pA0, pA1, alA, l_reg, pa0, pa1, pa2, pa3); SBAR();
    pv_d0(o, vb0, pa0, pa1, pa2, pa3); partialSM(pB0, pB1, m_reg, mnB, alB, C, thr_raw);
    __syncthreads(); RESC(alB);
    finishSM(pB0, pB1, alB, l_reg, pa0, pa1, pa2, pa3); SBAR();
    pv_d0(o, vb0 + SHM_V, pa0, pa1, pa2, pa3);
    if (hi == 0) li_l[r32] = l_reg; asm volatile("s_waitcnt lgkmcnt(0)" ::: "memory");
#pragma unroll
    for (int r = 0; r < 16; ++r) rli[r] = __builtin_amdgcn_rcpf(li_l[crow(r, hi)]);
#undef KROW
#undef SLOAD
#undef SWRITE
#undef SWAIT
#undef SLOAD_B
#undef SWRITE_B
#undef RESC
}
__device__ __forceinline__ void unit_diff(KP kp, unsigned char* ws, int l, int b, int h, int qrow0, int isc, char* lds, int tid, float* scratch) {
    const int wid = tid >> 6, lane = tid & 63, r32 = lane & 31, hi = lane >> 5;
    const bf16_t* Z = (const bf16_t*)(ws + WS_Z); bf16_t* MIX = (bf16_t*)(ws + WS_MIX);
    const int xrow0 = b * SEQ, nxt = isc ? 0 : SEQ / 64, crow0 = RX + b * CTX, NT = nxt + CTX / 64;
    const float C = 0.125f * 1.4426950408889634f;
    const float lam_init = (l == 0) ? 0.2f : 0.35550906759096907f;
    float* myscr = scratch + (size_t)wid * 64 * 64 + lane;
    f32x16 o[4]; float rli[16];
    attn_body<4, 2>(Z + (size_t)(qrow0 + wid * 32) * ZLD + Z_Q + h * 128, ZLD, Z + Z_K + h * 128, ZLD, nullptr, Z + Z_V + h * 128, ZLD, xrow0, nxt, crow0, NT, C, lds, tid, o, rli);
#pragma unroll
    for (int d0 = 0; d0 < 4; ++d0)
#pragma unroll
        for (int r = 0; r < 16; ++r) myscr[(d0 * 16 + r) * 64] = o[d0][r] * rli[r];
    attn_body<4, 2>(Z + (size_t)(qrow0 + wid * 32) * ZLD + Z_Q + h * 128 + 64, ZLD, Z + Z_K + h * 128 + 64, ZLD, nullptr, Z + Z_V + h * 128, ZLD, xrow0, nxt, crow0, NT, C, lds, tid, o, rli);
    size_t so = 0; asm volatile("" : "+v"(so) :: "memory"); const float* rdscr = myscr + so;
    const float* lamp = kp->in[IN_DIFFLAM] + l * 256;
    float l1 = lamp[lane] * lamp[64 + lane], l2 = lamp[128 + lane] * lamp[192 + lane]; l1 = wsum(l1, lane); l2 = wsum(l2, lane);
    const float lam = expf(l1) - expf(l2) + lam_init;
    const float* subg = kp->in[IN_SUBLN] + l * 128; const float post = 1.f - lam_init;
    float sg[4];
#pragma unroll
    for (int d0 = 0; d0 < 4; ++d0) sg[d0] = subg[d0 * 32 + r32] * post;
#pragma unroll
    for (int r = 0; r < 16; ++r) {
        float dv[4], ss = 0.f;
#pragma unroll
        for (int d0 = 0; d0 < 4; ++d0) { dv[d0] = rdscr[(d0 * 16 + r) * 64] - lam * (o[d0][r] * rli[r]); ss += dv[d0] * dv[d0]; }
        ss += sx(ss, 1, lane); ss += sx(ss, 2, lane); ss += sx(ss, 4, lane); ss += sx(ss, 8, lane); ss += sx(ss, 16, lane);
        const float rs = 1.0f / sqrtf(ss * (1.f / 128.f) + EPS);
        bf16_t* mp = MIX + (size_t)(qrow0 + wid * 32 + crow(r, hi)) * D + 512 + h * 128 + r32;
#pragma unroll
        for (int d0 = 0; d0 < 4; ++d0) mp[d0 * 32] = f2bf(dv[d0] * rs * sg[d0]);
    }
}
__device__ __forceinline__ void unit_mla(unsigned char* ws, int b, int h, int qrow0, int isc, char* lds, int tid) {
    const int wid = tid >> 6, lane = tid & 63, r32 = lane & 31, hi = lane >> 5;
    const bf16_t* QM = (const bf16_t*)(ws + WS_QM); const bf16_t* KN = (const bf16_t*)(ws + WS_KN); const bf16_t* KR = (const bf16_t*)(ws + WS_KR); const bf16_t* VM = (const bf16_t*)(ws + WS_VM);
    bf16_t* MIX = (bf16_t*)(ws + WS_MIX);
    const int xrow0 = b * SEQ, nxt = isc ? 0 : SEQ / 64, crow0 = RX + b * CTX, NT = nxt + CTX / 64;
    const float C = 0.07216878364870322f * 1.4426950408889634f;
    f32x16 o[4]; float rli[16];
    attn_body<12, 1>(QM + (size_t)(qrow0 + wid * 32) * 768 + h * 192, 768, KN + h * 128, 512, KR, VM + h * 128, 512, xrow0, nxt, crow0, NT, C, lds, tid, o, rli);
#pragma unroll
    for (int r = 0; r < 16; ++r) { bf16_t* mp = MIX + (size_t)(qrow0 + wid * 32 + crow(r, hi)) * D + 1024 + h * 128 + r32;
#pragma unroll
        for (int d0 = 0; d0 < 4; ++d0) mp[d0 * 32] = f2bf(o[d0][r] * rli[r]); }
}
__device__ __forceinline__ void phase_attn(KP kp, unsigned char* ws, int tid, int l, char* lds, int vcu, int G, int bx) {
    const int nunits = (l == 0) ? 288 : 256;
    float* scratch = (float*)(ws + WS_O1) + (size_t)bx * (8 * 64 * 64);
    for (int k = 0; k * G < nunits; ++k) {
        const int u = k * G + ((vcu + k * 128) % G); if (u >= nunits) continue;
        int tidu = tid; asm volatile("" : "+v"(tidu));
        size_t wo = 0; asm volatile("" : "+s"(wo)); unsigned char* wsu = kp->ws + wo; int lu = l; asm volatile("" : "+s"(lu));
        const bool isc = (u >= 256); const int v = isc ? (u - 256) & 15 : (u & 127);
        const bool mla = isc ? (u >= 272) : (u >= 128);
        const int b = isc ? (v >> 2) : (v >> 5), h = isc ? (v & 3) : ((v >> 3) & 3), q0 = isc ? RX + b * CTX : b * SEQ + (v & 7) * 256;
        if (!mla) unit_diff(kp, wsu, lu, b, h, q0, isc ? 1 : 0, lds, tidu, scratch);
        else unit_mla(wsu, b, h, q0, isc ? 1 : 0, lds, tidu);
    }
}
#undef SBAR
}


#define XB_TMO      128
#define XB_XCNT(j)  (256  + 64 * (j))
#define XB_XSUB(j)  (1280 + 64 * (j))
#define XB_XGEN(j)  (2304 + 64 * (j))
#define XB_TOP      3328
#define XB_TOPGEN   3392
#define XCD_BAR_WORDS 3456
#define XB_SPIN_CAP (1u << 18)
__device__ __forceinline__ unsigned xb_ld(unsigned* p)              { return __hip_atomic_load(p, __ATOMIC_RELAXED, __HIP_MEMORY_SCOPE_AGENT); }
__device__ __forceinline__ unsigned xb_add(unsigned* p, unsigned v) { return __hip_atomic_fetch_add(p, v, __ATOMIC_RELAXED, __HIP_MEMORY_SCOPE_AGENT); }
__device__ __forceinline__ unsigned xb_xcc_id() { return (unsigned)__builtin_amdgcn_s_getreg((3 << 11) | 20) & 0xFu; }
#define XB_SPIN(cond, bar) do { unsigned _sp = 0; while (cond) { __builtin_amdgcn_s_sleep(1); \
    if ((++_sp & 255u) == 0u) { if (xb_ld(&(bar)[XB_TMO])) break; if (_sp > XB_SPIN_CAP) { atomicAdd(&(bar)[XB_TMO], 1u); break; } } } } while (0)
__device__ __forceinline__ void xcd_barrier_complete(unsigned* bar, unsigned x, unsigned G, unsigned& nloc, unsigned& nx) {
    unsigned sum, cnt, mine, sp = 0u;
    for (;;) {
        sum = 0u; cnt = 0u; mine = 0u;
#pragma unroll
        for (unsigned j = 0; j < 16; ++j) { const unsigned c = xb_ld(&bar[XB_XCNT(j)]); sum += c; cnt += (c > 0u) ? 1u : 0u; mine = (j == x) ? c : mine; }
        if (sum == G) break;
        __builtin_amdgcn_s_sleep(1);
        if ((++sp & 255u) == 0u) { if (xb_ld(&bar[XB_TMO])) break; if (sp > XB_SPIN_CAP) { atomicAdd(&bar[XB_TMO], 1u); break; } }
    }
    nloc = mine > 0u ? mine : 1u; nx = cnt > 0u ? cnt : 1u;
}
__device__ __forceinline__ void xcd_barrier(unsigned* bar, volatile LAS unsigned* st, int tid, unsigned G) {
    asm volatile("s_waitcnt vmcnt(0)" ::: "memory");
    __syncthreads();
    if (tid == 0) {
        const unsigned x = xb_xcc_id();
        __builtin_amdgcn_s_waitcnt(0);
        unsigned nloc = st[0], nx = st[1];
        if (nloc == 0u) { xcd_barrier_complete(bar, x, G, nloc, nx); st[0] = nloc; st[1] = nx; }
        const unsigned qv = xb_ld((unsigned*)((char*)bar + (WS_CVQ - WS_BAR)));
        const unsigned old = xb_add(&bar[XB_XSUB(x)], 1u);
        const unsigned gen = old / nloc;
        if (old + 1u == (gen + 1u) * nloc) {
            __builtin_amdgcn_fence(__ATOMIC_RELEASE, "agent");
            asm volatile("s_waitcnt vmcnt(0)" ::: "memory");
            const unsigned og = xb_add(&bar[XB_TOP], 1u);
            const unsigned tg = og / nx;
            if (og + 1u == (tg + 1u) * nx) xb_add(&bar[XB_TOPGEN], 1u);
            else XB_SPIN(xb_ld(&bar[XB_TOPGEN]) == tg, bar);
            __builtin_amdgcn_fence(__ATOMIC_ACQUIRE, "agent");
            xb_add(&bar[XB_XGEN(x)], 1u);
            asm volatile("s_waitcnt vmcnt(0)" ::: "memory");
        } else {
            XB_SPIN(xb_ld(&bar[XB_XGEN(x)]) == gen, bar);
            __builtin_amdgcn_fence(__ATOMIC_ACQUIRE, "agent");
            asm volatile("s_waitcnt vmcnt(0)" ::: "memory");
        }
        if (qv > st[6]) st[6] = qv;
    }
    __syncthreads();
}

#ifdef PROBE_A
#define PH_STAMP(ph) do { if (bx0 == 0 && tid_ == 0) ((unsigned long long*)(ws + 32768))[ph] = __builtin_amdgcn_s_memrealtime(); } while (0)
#else
#define PH_STAMP(ph) do { } while (0)
#endif
#define PH_VARS(ph) \
    KP kp = kp0; asm volatile("" : "+s"(kp)); \
    int wv_ = wave0; asm volatile("" : "+s"(wv_)); unsigned z_ = 0u; asm volatile("" : "+s"(z_)); int tid_ = wv_ * 64 + (int)__builtin_amdgcn_mbcnt_hi(~0u, __builtin_amdgcn_mbcnt_lo(~0u, z_)); asm volatile("" : "+v"(tid_)); \
    size_t wsoff = 0; asm volatile("" : "+s"(wsoff)); unsigned char* ws = kp->ws + wsoff; \
    int G = G0, bx = bx0, vcu = vcu0; asm volatile("" : "+s"(G), "+s"(bx), "+s"(vcu)); \
    (void)bx; (void)vcu; (void)G;
#define XSYNC(ph) PH_VARS(ph) xcd_barrier((unsigned*)(ws + WS_BAR), (volatile LAS unsigned*)(lds + MISC_OFF), tid_, (unsigned)G); PH_STAMP(ph);
#define CSYNC(ph) cg::this_grid().sync(); PH_VARS(ph) PH_STAMP(ph);

template <int l>
__device__ __forceinline__ void layer_phases(KP kp0, LAS unsigned char* lds, char* lds_gen, int G0, int bx0, int vcu0, int wave0) {
    constexpr int pb = PH_L0 + l * PH_PER_LAYER;
    constexpr int nrM = (l == 1 ? RX : R) / 256;
    { XSYNC(pb + PHL_WIN)
      pg8::run(lds, pg8::Gemm{(const bf16_t*)(ws + WS_H), (const bf16_t*)(ws + WS_WIN) + (size_t)l * ZLD * D, D, D, D}, R / 256, ZLD / 256, G, bx, pg8::EpiZ{(bf16_t*)(ws + WS_Z), (float*)(ws + WS_RSQ) + (size_t)l * R * 2}, tid_);
#ifdef PROBE_G
      if (PROBE_G == pb + PHL_WIN && bx0 == 0 && tid_ == 0) { ((unsigned long long*)(ws + 32768))[28] = 0ull; ((unsigned long long*)(ws + 32768))[29] = *(volatile LAS unsigned long long*)(lds + MISC_OFF + 32); }
#endif

      if (bx >= (R / 256) * (ZLD / 256) - 2 * G) conv_fill(kp, ws, lds, tid_, 2); }
    { XSYNC(pb + PHL_PRE)
      { const float* rsq = (const float*)(ws + WS_RSQ) + (size_t)l * R * 2;
        pg8::run(lds, pg8::Gemm{(const bf16_t*)(ws + WS_Z) + Z_CQ, (const bf16_t*)(ws + WS_WUQ) + (size_t)l * 768 * 384, ZLD, 384, 384}, R / 256, 3, G, bx, pg8::EpiQ{(bf16_t*)(ws + WS_QM), rsq, (const float2*)(ws + WS_CS)}, tid_); }
      { int tid2 = tid_; asm volatile("" : "+v"(tid2)); size_t wsoff2 = 0; asm volatile("" : "+s"(wsoff2)); unsigned char* ws2 = kp->ws + wsoff2;
        pg8::run(lds, pg8::Gemm{(const bf16_t*)(ws2 + WS_Z) + Z_CKV, (const bf16_t*)(ws2 + WS_WUKV) + (size_t)l * 1024 * 256, ZLD, 256, 256}, R / 256, 4, G, (bx + G - 108) % G, pg8::EpiKV{(bf16_t*)(ws2 + WS_KN), (bf16_t*)(ws2 + WS_VM), (const float*)(ws2 + WS_RSQ) + (size_t)l * R * 2}, tid2); }
#ifdef PROBE_G
      if (PROBE_G == pb + PHL_PRE && bx0 == 0 && tid_ == 0) { ((unsigned long long*)(ws + 32768))[28] = 0ull; ((unsigned long long*)(ws + 32768))[29] = *(volatile LAS unsigned long long*)(lds + MISC_OFF + 32); }
#endif
#ifdef PROBE_A
      if (l == 0) { __syncthreads(); if (bx0 == 0 && tid_ == 0) { ((unsigned long long*)(ws + 32768))[24] = ((unsigned long long*)(ws + 32768))[pb + PHL_PRE]; ((unsigned long long*)(ws + 32768))[25] = __builtin_amdgcn_s_memrealtime(); } }
#endif
      if (G == 256) { if (bx >= 108) pre_rope(kp, ws, tid_, bx - 108, G - 108); }
      else pre_rope(kp, ws, tid_, vcu, G);
#ifdef PROBE_A
      if (l == 0) { __syncthreads(); if (bx0 == 0 && tid_ == 0) ((unsigned long long*)(ws + 32768))[26] = __builtin_amdgcn_s_memrealtime(); }
#endif
      if (G != 256) pre_pool(kp, ws, tid_, l, vcu, G);
#ifdef PROBE_A
      if (l == 0) { __syncthreads(); if (bx0 == 0 && tid_ == 0) ((unsigned long long*)(ws + 32768))[27] = __builtin_amdgcn_s_memrealtime(); }
#endif
      if (G != 256) pre_conv(kp, ws, tid_, l, vcu, G);
#ifdef PROBE_PRE
      if (l == 0) { __syncthreads(); if (tid_ == 0) ((unsigned long long*)(ws + 32768))[128 + bx0] = __builtin_amdgcn_s_memrealtime(); }
#endif
    }
    { XSYNC(pb + PHL_ATTN)
      att::phase_attn(kp, ws, tid_, l, lds_gen, vcu, G, bx);
      constexpr int em0 = (l == 0) ? 160 : 128;
      if (G == 256 && vcu >= em0) {
        int tid3 = tid_; asm volatile("" : "+v"(tid3)); size_t wsoff3 = 0; asm volatile("" : "+s"(wsoff3)); unsigned char* ws3 = kp->ws + wsoff3;
        pre_pool(kp, ws3, tid3, l, vcu - em0, 256 - em0); pre_conv(kp, ws3, tid3, l, vcu - em0, 256 - em0); }
#ifdef PROBE_ATT
      if (l == PROBE_ATT - 1) { __syncthreads(); if (tid_ == 0) ((unsigned long long*)(ws + 32768))[128 + vcu0] = __builtin_amdgcn_s_memrealtime(); }
#endif
      if (G != 256 || (vcu >= 128 && (l == 1 || vcu < 160))) conv_drain(kp, ws, lds, tid_, l == 0 ? CV_E1 : CV_E5); }
    { XSYNC(pb + PHL_WOUT)
      pg8::run(lds, pg8::Gemm{(const bf16_t*)(ws + WS_MIX), (const bf16_t*)(ws + WS_WOUT) + (size_t)l * D * D, D, D, D}, RX / 256, D / 256, G, bx, pg8::EpiY{(bf16_t*)(ws + WS_Y), (float*)(ws + WS_YP), RX / 256, (size_t)RC * D}, tid_, l == 0 ? RC / 256 : 0, 4); }
    { XSYNC(pb + PHL_ROWB)
      phase_rowpass(kp, ws, lds, tid_, 1, l, vcu, G);
      conv_drain(kp, ws, lds, tid_, l == 0 ? CV_E2 : CV_E6); }
    { XSYNC(pb + PHL_UP)
      pg8::run(lds, pg8::Gemm{(const bf16_t*)(ws + WS_H), (const bf16_t*)(ws + WS_WUP) + (size_t)l * UFF * D, D, D, D}, nrM, UFF / 256, G, bx, pg8::EpiAct{(bf16_t*)(ws + WS_ACT), (bf16_t*)(ws + WS_EDGE), kp->in[IN_FFNCONVW] + (size_t)l * 3 * UFF, (LAS float*)(lds + pg8::STAGE_BYTES)
                  }, tid_);
#ifdef PROBE_G
      if (PROBE_G == pb + PHL_UP && bx0 == 0 && tid_ == 0) { ((unsigned long long*)(ws + 32768))[28] = 0ull; ((unsigned long long*)(ws + 32768))[29] = *(volatile LAS unsigned long long*)(lds + MISC_OFF + 32); }
#endif

      if (bx >= (nrM * (UFF / 256)) % G) conv_fill(kp, ws, lds, tid_, 2); }
    { XSYNC(pb + PHL_ACT)
      phase_act_edges(kp, ws, tid_, l, vcu, G);
      conv_drain(kp, ws, lds, tid_, l == 0 ? CV_E3 : CV_E7); }
    { XSYNC(pb + PHL_DOWN)
      pg8::run(lds, pg8::Gemm{(const bf16_t*)(ws + WS_ACT), (const bf16_t*)(ws + WS_WDOWN) + (size_t)l * D * DFF, DFF, DFF, DFF}, RX / 256, D / 256, G, bx, pg8::EpiY{(bf16_t*)(ws + WS_Y), (float*)(ws + WS_YP), RX / 256, (size_t)RC * D}, tid_, l == 0 ? RC / 256 : 0, 4);
#ifdef PROBE_G
      if (PROBE_G == pb + PHL_DOWN && bx0 == 0 && tid_ == 0) { ((unsigned long long*)(ws + 32768))[28] = 0ull; ((unsigned long long*)(ws + 32768))[29] = *(volatile LAS unsigned long long*)(lds + MISC_OFF + 32); }
#endif
 }
    { XSYNC(pb + PHL_ROWC)
      phase_rowpass(kp, ws, lds, tid_, 2, l, vcu, G);
      if (l == 0) conv_drain(kp, ws, lds, tid_, CV_E4); }
}

__global__ void __launch_bounds__(NTHR, 2) mk_fwd(Params P) {
    extern __shared__ __attribute__((aligned(16))) unsigned char lds_raw[];
    LAS unsigned char* lds = (LAS unsigned char*)lds_raw;
    KP kp0 = (KP)__builtin_amdgcn_kernarg_segment_ptr();
    const int G0 = gridDim.x, bx0 = blockIdx.x;
    const int wave0 = __builtin_amdgcn_readfirstlane((int)__builtin_amdgcn_workitem_id_x() >> 6);
    const int vcu0 = (G0 % 8 == 0) ? (bx0 % 8) * (G0 / 8) + bx0 / 8 : bx0;
    if (kp0->pad == 0x7fffffff) cg::this_grid().sync();
    { PH_VARS(PH_PRO) PH_STAMP(PH_PRO);
      if (tid_ < 2) ((volatile LAS unsigned*)(lds + MISC_OFF))[tid_] = 0u;
      if (tid_ == 2) ((volatile LAS unsigned*)(lds + MISC_OFF))[6] = 0u;
      if (tid_ == 0) (void)xb_add((unsigned*)(ws + WS_BAR) + XB_XCNT(xb_xcc_id()), 1u);
      __syncthreads();
      phase_prologue(kp, ws, tid_, lds, vcu, G); }
    { XSYNC(PH_ROWA)
      phase_rowpass(kp, ws, lds, tid_, 0, 0, vcu, G); }
    layer_phases<0>(kp0, lds, (char*)lds_raw, G0, bx0, vcu0, wave0);
    layer_phases<1>(kp0, lds, (char*)lds_raw, G0, bx0, vcu0, wave0);
#ifdef PROBE_ACT
    { XSYNC(PH_TOTAL)
      phase_act(kp, ws, tid_, 1, vcu, G, WS_END); }
    { XSYNC(PH_TOTAL)
      const bf16_t* A1 = (const bf16_t*)(ws + WS_ACT); const bf16_t* A2 = (const bf16_t*)(ws + WS_END); float mx = 0.f;
      for (size_t i = (size_t)vcu * NTHR + tid_; i < (size_t)RX * DFF / 8; i += (size_t)G * NTHR) { float a[8], b[8]; unpack8(ld16(A1 + i * 8), a); unpack8(ld16(A2 + i * 8), b);
#pragma unroll
          for (int e = 0; e < 8; ++e) mx = fmaxf(mx, fabsf(a[e] - b[e])); }
      atomicMax((unsigned*)(ws + 40960), __float_as_uint(mx)); }
    { XSYNC(PH_TOTAL)
      if (bx0 == 0 && tid_ == 0) kp->out[0] += 0.3f + __uint_as_float(*(volatile unsigned*)(ws + 40960)); }
#endif
#ifdef PROBE_A
#ifdef PROBE_SYNC
    { XSYNC(PH_TOTAL)
      unsigned long long t0 = __builtin_amdgcn_s_memrealtime();
      for (int i = 0; i < 10; ++i) xcd_barrier((unsigned*)(ws + WS_BAR), (volatile LAS unsigned*)(lds + MISC_OFF), tid_, (unsigned)G);
      unsigned long long t1 = __builtin_amdgcn_s_memrealtime();
      if (bx0 == 0 && tid_ == 0) kp->out[0] += 0.3f + (float)(t1 - t0) * (0.01f / 800.f); }
#else
    { XSYNC(PH_TOTAL)
      if (bx0 == 0) {
        unsigned long long* ts = (unsigned long long*)(ws + 32768);
        __syncthreads();
#ifdef PROBE_ATT
        unsigned long long mq = 0, mk = 0; const unsigned long long t0_ = ts[PH_L0 + (PROBE_ATT - 1) * PH_PER_LAYER + PHL_ATTN];
        for (int i = 0; i < 128; ++i) { const unsigned long long d = ts[128 + i] - t0_; mq = d > mq ? d : mq; } for (int i = 128; i < 256; ++i) { const unsigned long long d = ts[128 + i] - t0_; mk = d > mk ? d : mk; }
        const float ta = (float)mq * (0.01f / 800.f), tb = (float)mk * (0.01f / 800.f);
#elif defined(PROBE_PRE)
        unsigned long long mq = 0, mk = 0; for (int i = 0; i < 108; ++i) { const unsigned long long d = ts[128 + i] - ts[3]; mq = d > mq ? d : mq; } for (int i = 108; i < 256; ++i) { const unsigned long long d = ts[128 + i] - ts[3]; mk = d > mk ? d : mk; }
        const float ta = (float)mq * (0.01f / 800.f), tb = (float)mk * (0.01f / 800.f);
#else
        const float ta = (float)(ts[PROBE_A + 1] - ts[PROBE_A]) * (0.01f / 800.f), tb = (float)(ts[PROBE_B + 1] - ts[PROBE_B]) * (0.01f / 800.f);
#endif
        if (tid_ == 0) kp->out[0] += 0.3f + ta;
        for (int i = 1 + tid_; i <= 65536; i += NTHR) kp->out[i] += tb;
      } }
#endif
#endif
}

extern "C" void kernel_launch(void* const* d_in, const int* in_sizes, int n_in, void* d_out, int out_size, void* d_ws, size_t ws_size, hipStream_t stream) {
    static int grid = 0;
    if (grid == 0) {
        if (n_in != 24 || ws_size < WS_END) { fprintf(stderr, "kernel_launch: bad args n_in %d ws %zu (need %zu)\n", n_in, ws_size, (size_t)WS_END); grid = -1; return; }
        if (hipFuncSetAttribute((const void*)mk_fwd, hipFuncAttributeMaxDynamicSharedMemorySize, LDS_BYTES) != hipSuccess) { fprintf(stderr, "hipFuncSetAttribute failed\n"); grid = -1; return; }
        int dev = 0, cus = 0, per_cu = 0;
        if (hipGetDevice(&dev) != hipSuccess || hipDeviceGetAttribute(&cus, hipDeviceAttributeMultiprocessorCount, dev) != hipSuccess) { grid = -1; return; }
        if (hipOccupancyMaxActiveBlocksPerMultiprocessor(&per_cu, (const void*)mk_fwd, NTHR, LDS_BYTES) != hipSuccess || per_cu < 1) { fprintf(stderr, "occupancy query failed (%d)\n", per_cu); grid = -1; return; }
        grid = cus * per_cu;
    }
    if (grid < 0) return;
    unsigned char* ws = (unsigned char*)d_ws;
    (void)hipMemsetAsync(ws + WS_CTL, 0, 256 * 1024, stream);
    Params P{};
    for (int i = 0; i < 24; ++i) P.in[i] = (const float*)d_in[i];
    P.out = (float*)d_out; P.ws = ws; P.ph_lo = 0; P.ph_hi = PH_TOTAL; P.mask = 15; P.pad = 0;
    void* args[] = {&P};
    const hipError_t e = hipLaunchCooperativeKernel((const void*)mk_fwd, dim3(grid), dim3(NTHR), args, LDS_BYTES, stream);
    if (e != hipSuccess) fprintf(stderr, "cooperative launch failed: %s (grid %d)\n", hipGetErrorString(e), grid);
}
```
